# Optimizing an MI355X kernel written in HIP

```python
import jax, jax.numpy as jnp
from jax import lax
import numpy as np

D_MODEL = 1024
BATCH = 4
SEQ = 8192
DEPTH = 2

GRID_W = 64
CTX_LEN = 256

RET_HEADS = 4
RET_DK = 128
RET_DV = 128
RET_CHUNK = 128
RET_W = RET_HEADS * RET_DV
MLA_HEADS = 8
MLA_Q_LORA = 384
MLA_KV_LORA = 256
MLA_NOPE = 64
MLA_ROPE = 32
MLA_V = 64
MLA_QK = MLA_NOPE + MLA_ROPE
MLA_W = MLA_HEADS * MLA_V
ATTN_Q_BLOCK = 128
ROPE_THETA = 10000.0
GMLP_GROUPS = 4
GMLP_GROUP_W = 128
GMLP_W = GMLP_GROUPS * GMLP_GROUP_W
GMLP_CHUNK = 128

N_BRANCH = 3

N_EXPERTS = 64
TOP_K = 6
D_EXPERT = 256
D_SHARED = 256
ROUTED_SCALE = 2.5
MOE_BLOCK = 128

EPS = 1e-6

OFF_RET_Q = 0
OFF_RET_K = OFF_RET_Q + RET_HEADS * RET_DK
OFF_RET_V = OFF_RET_K + RET_HEADS * RET_DK
OFF_RET_G = OFF_RET_V + RET_W
OFF_MLA_CQ = OFF_RET_G + RET_W
OFF_MLA_CKV = OFF_MLA_CQ + MLA_Q_LORA
OFF_MLA_KR = OFF_MLA_CKV + MLA_KV_LORA
OFF_GMLP_UV = OFF_MLA_KR + MLA_ROPE
OFF_MERGE = OFF_GMLP_UV + 2 * GMLP_W
N_IN = OFF_MERGE + N_BRANCH * D_MODEL

kernel_name = 'hybrid_retention_mla_gmlp_moe_dit'


def _rmsnorm(x, g):
    x32 = x.astype(jnp.float32)
    y = x32 * lax.rsqrt(jnp.mean(x32 * x32, axis=-1, keepdims=True) + EPS)
    return (y * g.astype(jnp.float32)).astype(x.dtype)


def _layernorm(x, g, b):
    x32 = x.astype(jnp.float32)
    mu = jnp.mean(x32, axis=-1, keepdims=True)
    var = jnp.mean(jnp.square(x32 - mu), axis=-1, keepdims=True)
    y = (x32 - mu) * lax.rsqrt(var + EPS) * g.astype(jnp.float32) + b.astype(jnp.float32)
    return y.astype(x.dtype)


def _heads(t, n):
    B, L, _ = t.shape
    return t.reshape(B, L, n, -1).transpose(0, 2, 1, 3)


def _merge_heads(t):
    B, n, L, d = t.shape
    return t.transpose(0, 2, 1, 3).reshape(B, L, n * d)


def _flip(t):
    return jnp.flip(t, axis=2)


def _axial_rope_tables(L):
    rows = L // GRID_W
    half = MLA_ROPE // 2
    n_freq = half // 2
    inv = ROPE_THETA ** (-2.0 * jnp.arange(n_freq, dtype=jnp.float32) / half)
    ang_r = jnp.arange(rows, dtype=jnp.float32)[:, None, None] * inv
    ang_c = jnp.arange(GRID_W, dtype=jnp.float32)[None, :, None] * inv
    ang_r = jnp.broadcast_to(ang_r, (rows, GRID_W, n_freq)).reshape(L, n_freq)
    ang_c = jnp.broadcast_to(ang_c, (rows, GRID_W, n_freq)).reshape(L, n_freq)
    return (jnp.cos(ang_r), jnp.sin(ang_r), jnp.cos(ang_c), jnp.sin(ang_c))


def _rope_half(x, cos, sin):
    x1, x2 = jnp.split(x, 2, axis=-1)
    return jnp.concatenate([x1 * cos - x2 * sin, x1 * sin + x2 * cos], axis=-1)


def _apply_axial_rope(x, tables):
    cos_r, sin_r, cos_c, sin_c = tables
    xr, xc = jnp.split(x.astype(jnp.float32), 2, axis=-1)
    out = jnp.concatenate([_rope_half(xr, cos_r, sin_r), _rope_half(xc, cos_c, sin_c)], axis=-1)
    return out.astype(x.dtype)


def _retention_dir(q, k, v, log_g, s0, strict):
    B, H, L, dk = q.shape
    dv = v.shape[-1]
    n = L // RET_CHUNK
    qc = q.astype(jnp.float32).reshape(B, H, n, RET_CHUNK, dk)
    kc = k.astype(jnp.float32).reshape(B, H, n, RET_CHUNK, dk)
    vc = v.astype(jnp.float32).reshape(B, H, n, RET_CHUNK, dv)
    pos = jnp.arange(RET_CHUNK, dtype=jnp.float32)
    diff = pos[:, None] - pos[None, :]
    keep = diff > 0 if strict else diff >= 0
    dmat = jnp.where(keep, jnp.exp(log_g[:, None, None] * jnp.maximum(diff, 0.0)), 0.0)
    att = jnp.einsum('bhnid,bhnjd->bhnij', qc, kc) * dmat[None, :, None]
    intra = jnp.einsum('bhnij,bhnjv->bhniv', att, vc)
    k_dec = jnp.exp(log_g[:, None] * (RET_CHUNK - 1 - pos))
    q_dec = jnp.exp(log_g[:, None] * (pos + 1.0))
    chunk_kv = jnp.einsum('bhnjd,hj,bhnjv->nbhdv', kc, k_dec, vc)
    c_dec = jnp.exp(log_g * RET_CHUNK)[None, :, None, None]

    def step(s, kv):
        return s * c_dec + kv, s

    s_fin, s_prev = lax.scan(step, s0, chunk_kv)
    inter = jnp.einsum('bhnid,hi,nbhdv->bhniv', qc, q_dec, s_prev)
    return (intra + inter).reshape(B, H, L, dv), s_fin


def _retention_state(k, v, log_g):
    L = k.shape[2]
    dec = jnp.exp(log_g[:, None] * (L - 1 - jnp.arange(L, dtype=jnp.float32)))
    return jnp.einsum('bhjd,hj,bhjv->bhdv', k.astype(jnp.float32), dec, v.astype(jnp.float32))


def _retention_bidir(q, k, v, lg_f, lg_b, s0_f, s0_b):
    o_f, s_f = _retention_dir(q, k, v, lg_f, s0_f, False)
    o_b, s_b = _retention_dir(_flip(q), _flip(k), _flip(v), lg_b, s0_b, True)
    return o_f + _flip(o_b), s_f, s_b


def _retention_out(o, g, gn_g, gn_b, w_br):
    mu = jnp.mean(o, axis=-1, keepdims=True)
    var = jnp.mean(jnp.square(o - mu), axis=-1, keepdims=True)
    on = _merge_heads((o - mu) * lax.rsqrt(var + EPS))
    y = jax.nn.silu(g.astype(jnp.float32)) * (on * gn_g.astype(jnp.float32) + gn_b.astype(jnp.float32))
    return y.astype(g.dtype) @ w_br


def _mla_kv(ckv, kr, kva_g, w_ukv, kn_g, kr_g, tables):
    B, L, _ = ckv.shape
    kv = _heads(_rmsnorm(ckv, kva_g) @ w_ukv, MLA_HEADS)
    k_nope = _rmsnorm(kv[..., :MLA_NOPE], kn_g)
    v = kv[..., MLA_NOPE:]
    k_rope = _rmsnorm(kr, kr_g)[:, None]
    if tables is not None:
        k_rope = _apply_axial_rope(k_rope, tables)
    k = jnp.concatenate([k_nope, jnp.broadcast_to(k_rope, (B, MLA_HEADS, L, MLA_ROPE))], axis=-1)
    return k, v


def _mla_q(cq, qa_g, w_uq, qn_g, tables):
    q = _rmsnorm(_heads(_rmsnorm(cq, qa_g) @ w_uq, MLA_HEADS), qn_g)
    if tables is not None:
        q = jnp.concatenate([q[..., :MLA_NOPE], _apply_axial_rope(q[..., MLA_NOPE:], tables)], axis=-1)
    return q


def _attend(q, k, v):
    s = jnp.einsum('bhqd,bhkd->bhqk', q, k, preferred_element_type=jnp.float32) * (MLA_QK ** -0.5)
    p = jax.nn.softmax(s, axis=-1).astype(v.dtype)
    return jnp.einsum('bhqk,bhkv->bhqv', p, v)


def _attend_blocks(q, k, v):
    B, H, L, d = q.shape
    nb = L // ATTN_Q_BLOCK
    qb = q.reshape(B, H, nb, ATTN_Q_BLOCK, d).transpose(2, 0, 1, 3, 4)
    ob = lax.map(lambda t: _attend(t, k, v), qb)
    return ob.transpose(1, 2, 0, 3, 4).reshape(B, H, L, -1)


def _gmlp_branch(uv, ln_g, ln_b, ws, bs, w_br):
    z = jax.nn.gelu(uv)
    u, v = jnp.split(z, 2, axis=-1)
    B, L, _ = v.shape
    n = L // GMLP_CHUNK
    vn = _layernorm(v, ln_g, ln_b).reshape(B, n, GMLP_CHUNK, GMLP_GROUPS, GMLP_GROUP_W)
    sv = jnp.einsum('gij,bnjgc->bnigc', ws, vn) + bs.T[None, None, :, :, None]
    return (u * sv.reshape(B, L, GMLP_W)) @ w_br


def _gated_merge(gate_logits, y_a, y_b, y_c, w_out):
    g = jax.nn.sigmoid(gate_logits.astype(jnp.float32))
    y = (g[..., :D_MODEL] * y_a + g[..., D_MODEL:2 * D_MODEL] * y_b + g[..., 2 * D_MODEL:] * y_c)
    return y.astype(y_a.dtype) @ w_out


def _mixer(h, hc, tables, w_in, dec_f, dec_b, gn_g, gn_b, w_br_ret,
           qa_g, w_uq, kva_g, w_ukv, qn_g, kn_g, kr_g, w_br_mla,
           ln_g, ln_b, ws, bs, w_br_gmlp, w_out, ctx_out):
    B = h.shape[0]
    p = h @ w_in
    pc = hc @ w_in if ctx_out else None

    def lat(off, size):
        return p[..., off:off + size]

    def con(off, size):
        if ctx_out:
            return pc[..., off:off + size]
        return hc @ w_in[:, off:off + size]

    lg_f = jax.nn.log_sigmoid(dec_f.astype(jnp.float32))
    lg_b = jax.nn.log_sigmoid(dec_b.astype(jnp.float32))
    qk_w = RET_HEADS * RET_DK
    k_scale = RET_DK ** -0.5

    rk_c = _heads(con(OFF_RET_K, qk_w), RET_HEADS) * k_scale
    rv_c = _heads(con(OFF_RET_V, RET_W), RET_HEADS)
    if ctx_out:
        zero = jnp.zeros((B, RET_HEADS, RET_DK, RET_DV), jnp.float32)
        o_c, s_f, s_b = _retention_bidir(_heads(con(OFF_RET_Q, qk_w), RET_HEADS), rk_c, rv_c,
                                         lg_f, lg_b, zero, zero)
        yr_c = _retention_out(o_c, con(OFF_RET_G, RET_W), gn_g, gn_b, w_br_ret)
    else:
        s_f = _retention_state(rk_c, rv_c, lg_f)
        s_b = _retention_state(_flip(rk_c), _flip(rv_c), lg_b)
    o, _, _ = _retention_bidir(_heads(lat(OFF_RET_Q, qk_w), RET_HEADS),
                               _heads(lat(OFF_RET_K, qk_w), RET_HEADS) * k_scale,
                               _heads(lat(OFF_RET_V, RET_W), RET_HEADS),
                               lg_f, lg_b, s_f, s_b)
    yr = _retention_out(o, lat(OFF_RET_G, RET_W), gn_g, gn_b, w_br_ret)

    k_c, v_c = _mla_kv(con(OFF_MLA_CKV, MLA_KV_LORA), con(OFF_MLA_KR, MLA_ROPE),
                       kva_g, w_ukv, kn_g, kr_g, None)
    k_l, v_l = _mla_kv(lat(OFF_MLA_CKV, MLA_KV_LORA), lat(OFF_MLA_KR, MLA_ROPE),
                       kva_g, w_ukv, kn_g, kr_g, tables)
    q_l = _mla_q(lat(OFF_MLA_CQ, MLA_Q_LORA), qa_g, w_uq, qn_g, tables)
    o_m = _attend_blocks(q_l, jnp.concatenate([k_c, k_l], axis=2), jnp.concatenate([v_c, v_l], axis=2))
    ym = _merge_heads(o_m) @ w_br_mla

    yg = _gmlp_branch(lat(OFF_GMLP_UV, 2 * GMLP_W), ln_g, ln_b, ws, bs, w_br_gmlp)

    y = _gated_merge(lat(OFF_MERGE, N_BRANCH * D_MODEL), yr, ym, yg, w_out)
    if not ctx_out:
        return y, None
    q_c = _mla_q(con(OFF_MLA_CQ, MLA_Q_LORA), qa_g, w_uq, qn_g, None)
    ym_c = _merge_heads(_attend(q_c, k_c, v_c)) @ w_br_mla
    yg_c = _gmlp_branch(con(OFF_GMLP_UV, 2 * GMLP_W), ln_g, ln_b, ws, bs, w_br_gmlp)
    y_c = _gated_merge(con(OFF_MERGE, N_BRANCH * D_MODEL), yr_c, ym_c, yg_c, w_out)
    return y, y_c


def _routed_experts(t, idx, w, wg, wu, wd):
    N, D = t.shape
    A = N * TOP_K
    n_blocks = -(-(A + N_EXPERTS * (MOE_BLOCK - 1)) // MOE_BLOCK)
    n_rows = n_blocks * MOE_BLOCK
    flat_e = idx.reshape(-1)
    order = jnp.argsort(flat_e)
    e_sorted = flat_e[order]
    counts = jnp.zeros((N_EXPERTS,), jnp.int32).at[flat_e].add(1)
    padded = (counts + MOE_BLOCK - 1) // MOE_BLOCK * MOE_BLOCK
    pad_end = jnp.cumsum(padded)
    pad_start = pad_end - padded
    start = jnp.cumsum(counts) - counts
    dest = pad_start[e_sorted] + jnp.arange(A, dtype=jnp.int32) - start[e_sorted]
    row_tok = jnp.zeros((n_rows,), jnp.int32).at[dest].set((order // TOP_K).astype(jnp.int32))
    row_w = jnp.zeros((n_rows,), jnp.float32).at[dest].set(w.reshape(-1)[order])
    blk_e = jnp.minimum(jnp.searchsorted(pad_end, jnp.arange(n_blocks, dtype=jnp.int32) * MOE_BLOCK,
                                         side='right'), N_EXPERTS - 1)

    def step(acc, blk):
        tok_b, w_b, e = blk
        xb = t[tok_b]
        hb = jax.nn.silu(xb @ wg[e]) * (xb @ wu[e])
        yb = (hb @ wd[e]).astype(jnp.float32) * w_b[:, None]
        return acc.at[tok_b].add(yb), None

    acc, _ = lax.scan(step, jnp.zeros((N, D), jnp.float32),
                      (row_tok.reshape(n_blocks, MOE_BLOCK), row_w.reshape(n_blocks, MOE_BLOCK), blk_e))
    return acc.astype(t.dtype)


def _moe(t, router, bias, wg, wu, wd, sg, su, sd):
    scores = jax.nn.sigmoid((t @ router).astype(jnp.float32))
    _, idx = lax.top_k(scores + bias.astype(jnp.float32), TOP_K)
    w = jnp.take_along_axis(scores, idx, axis=-1)
    w = w / jnp.sum(w, axis=-1, keepdims=True) * ROUTED_SCALE
    shared = (jax.nn.silu(t @ sg) * (t @ su)) @ sd
    return _routed_experts(t, idx, w, wg, wu, wd) + shared


def setup_inputs(seed: int = 0) -> dict:
    key = jax.random.key(seed)
    kit = iter(jax.random.split(key, 40))
    f32 = jnp.float32
    D = D_MODEL

    def nrm(shape, scale):
        return jax.random.normal(next(kit), shape, f32) * scale

    def gain(shape):
        return 1.0 + 0.05 * jax.random.normal(next(kit), shape, f32)

    gam = 1.0 - 2.0 ** (-5.0 - jnp.arange(RET_HEADS, dtype=f32))
    decay_logit = jnp.log(gam) - jnp.log1p(-gam)
    x = nrm((BATCH, SEQ, D), 1.0)
    c = nrm((BATCH, D), 1.0)
    ctx = nrm((BATCH, CTX_LEN, D), 1.0)
    c_ctx = nrm((D,), 1.0)
    ada_w = nrm((DEPTH, D, 6 * D), 0.5 * D ** -0.5)
    ada_b = nrm((DEPTH, 6 * D), 0.02)
    norm1_g = gain((DEPTH, D))
    norm2_g = gain((DEPTH, D))
    w_in = nrm((DEPTH, D, N_IN), D ** -0.5)
    ret_decay_fwd = decay_logit + nrm((DEPTH, RET_HEADS), 0.1)
    ret_decay_bwd = decay_logit + nrm((DEPTH, RET_HEADS), 0.1)
    ret_gn_g = gain((DEPTH, RET_W))
    ret_gn_b = nrm((DEPTH, RET_W), 0.02)
    w_br_ret = nrm((DEPTH, RET_W, D), RET_W ** -0.5)
    mla_qa_g = gain((DEPTH, MLA_Q_LORA))
    mla_w_uq = nrm((DEPTH, MLA_Q_LORA, MLA_HEADS * MLA_QK), MLA_Q_LORA ** -0.5)
    mla_kva_g = gain((DEPTH, MLA_KV_LORA))
    mla_w_ukv = nrm((DEPTH, MLA_KV_LORA, MLA_HEADS * (MLA_NOPE + MLA_V)), MLA_KV_LORA ** -0.5)
    mla_qn_g = gain((DEPTH, MLA_QK))
    mla_kn_g = gain((DEPTH, MLA_NOPE))
    mla_kr_g = gain((DEPTH, MLA_ROPE))
    w_br_mla = nrm((DEPTH, MLA_W, D), MLA_W ** -0.5)
    gmlp_ln_g = gain((DEPTH, GMLP_W))
    gmlp_ln_b = nrm((DEPTH, GMLP_W), 0.02)
    gmlp_ws = nrm((DEPTH, GMLP_GROUPS, GMLP_CHUNK, GMLP_CHUNK), GMLP_CHUNK ** -0.5)
    gmlp_bs = gain((DEPTH, GMLP_GROUPS, GMLP_CHUNK))
    w_br_gmlp = nrm((DEPTH, GMLP_W, D), GMLP_W ** -0.5)
    w_out = nrm((DEPTH, D, D), D ** -0.5)
    moe_router = nrm((DEPTH, D, N_EXPERTS), D ** -0.5)
    moe_bias = nrm((DEPTH, N_EXPERTS), 0.01)
    moe_w_gate = nrm((DEPTH, N_EXPERTS, D, D_EXPERT), D ** -0.5)
    moe_w_up = nrm((DEPTH, N_EXPERTS, D, D_EXPERT), D ** -0.5)
    moe_w_down = nrm((DEPTH, N_EXPERTS, D_EXPERT, D), D_EXPERT ** -0.5)
    sh_w_gate = nrm((DEPTH, D, D_SHARED), D ** -0.5)
    sh_w_up = nrm((DEPTH, D, D_SHARED), D ** -0.5)
    sh_w_down = nrm((DEPTH, D_SHARED, D), D_SHARED ** -0.5)
    return {'x': x, 'c': c, 'ctx': ctx, 'c_ctx': c_ctx, 'ada_w': ada_w, 'ada_b': ada_b,
            'norm1_g': norm1_g, 'norm2_g': norm2_g, 'w_in': w_in,
            'ret_decay_fwd': ret_decay_fwd, 'ret_decay_bwd': ret_decay_bwd,
            'ret_gn_g': ret_gn_g, 'ret_gn_b': ret_gn_b, 'w_br_ret': w_br_ret,
            'mla_qa_g': mla_qa_g, 'mla_w_uq': mla_w_uq, 'mla_kva_g': mla_kva_g, 'mla_w_ukv': mla_w_ukv,
            'mla_qn_g': mla_qn_g, 'mla_kn_g': mla_kn_g, 'mla_kr_g': mla_kr_g, 'w_br_mla': w_br_mla,
            'gmlp_ln_g': gmlp_ln_g, 'gmlp_ln_b': gmlp_ln_b, 'gmlp_ws': gmlp_ws, 'gmlp_bs': gmlp_bs,
            'w_br_gmlp': w_br_gmlp, 'w_out': w_out,
            'moe_router': moe_router, 'moe_bias': moe_bias, 'moe_w_gate': moe_w_gate,
            'moe_w_up': moe_w_up, 'moe_w_down': moe_w_down,
            'sh_w_gate': sh_w_gate, 'sh_w_up': sh_w_up, 'sh_w_down': sh_w_down}


def reference(x, c, ctx, c_ctx, ada_w, ada_b, norm1_g, norm2_g, w_in,
              ret_decay_fwd, ret_decay_bwd, ret_gn_g, ret_gn_b, w_br_ret,
              mla_qa_g, mla_w_uq, mla_kva_g, mla_w_ukv, mla_qn_g, mla_kn_g, mla_kr_g, w_br_mla,
              gmlp_ln_g, gmlp_ln_b, gmlp_ws, gmlp_bs, w_br_gmlp, w_out,
              moe_router, moe_bias, moe_w_gate, moe_w_up, moe_w_down,
              sh_w_gate, sh_w_up, sh_w_down):
    B, L, D = x.shape
    tables = _axial_rope_tables(L)
    s_lat = jax.nn.silu(c)
    s_ctx = jax.nn.silu(c_ctx)
    cs = ctx
    for l in range(DEPTH):
        ctx_out = l < DEPTH - 1
        mod = (s_lat @ ada_w[l] + ada_b[l])[:, None, :]
        mod_c = s_ctx @ ada_w[l] + ada_b[l]
        shift_a, scale_a, gate_a, shift_f, scale_f, gate_f = jnp.split(mod, 6, axis=-1)
        shift_ac, scale_ac, gate_ac, shift_fc, scale_fc, gate_fc = jnp.split(mod_c, 6, axis=-1)

        h = _rmsnorm(x, norm1_g[l]) * (1.0 + scale_a) + shift_a
        hc = _rmsnorm(cs, norm1_g[l]) * (1.0 + scale_ac) + shift_ac
        y, y_c = _mixer(h, hc, tables, w_in[l], ret_decay_fwd[l], ret_decay_bwd[l],
                        ret_gn_g[l], ret_gn_b[l], w_br_ret[l],
                        mla_qa_g[l], mla_w_uq[l], mla_kva_g[l], mla_w_ukv[l],
                        mla_qn_g[l], mla_kn_g[l], mla_kr_g[l], w_br_mla[l],
                        gmlp_ln_g[l], gmlp_ln_b[l], gmlp_ws[l], gmlp_bs[l], w_br_gmlp[l],
                        w_out[l], ctx_out)
        x = x + gate_a * y
        h2 = _rmsnorm(x, norm2_g[l]) * (1.0 + scale_f) + shift_f
        moe_args = (moe_router[l], moe_bias[l], moe_w_gate[l], moe_w_up[l], moe_w_down[l],
                    sh_w_gate[l], sh_w_up[l], sh_w_down[l])
        if ctx_out:
            cs = cs + gate_ac * y_c
            h2c = _rmsnorm(cs, norm2_g[l]) * (1.0 + scale_fc) + shift_fc
            n_lat = B * L
            f = _moe(jnp.concatenate([h2.reshape(n_lat, D), h2c.reshape(-1, D)], axis=0), *moe_args)
            x = x + gate_f * f[:n_lat].reshape(B, L, D)
            cs = cs + gate_fc * f[n_lat:].reshape(cs.shape)
        else:
            x = x + gate_f * _moe(h2.reshape(B * L, D), *moe_args).reshape(B, L, D)
    return x
```

```cpp
#include <hip/hip_runtime.h>
#include <cstdio>
#include <cstdint>

constexpr int D = 1024, NB = 4, SEQ = 8192, CTX = 256, DEPTH = 2;
constexpr int ML = NB * SEQ;
constexpr int MC = NB * CTX;
constexpr int M = ML + MC;
constexpr int N_IN = 6816, OFF_CQ = 2048, OFF_CKV = 2432, OFF_KR = 2688, OFF_UV = 2720, OFF_MERGE = 3744;
constexpr int NEXP = 64, TOPK = 6, DEXP = 256;
constexpr int APAD = 219136;
constexpr float EPS = 1e-6f;
constexpr float QSCALE = 0.14724649622f;

constexpr size_t MiB = 1u << 20;
constexpr size_t WS_CTL = 0, CTL_ZERO_BYTES = 1 * MiB;
constexpr size_t WS_MOD = 1 * MiB;
constexpr size_t WS_ROPE = 2 * MiB;
constexpr size_t WS_XC = 4 * MiB;
constexpr size_t WS_IDX = 8 * MiB;
constexpr size_t WS_WTS = 9 * MiB;
constexpr size_t WS_SLOT = 10 * MiB;
constexpr size_t WS_INV = 11 * MiB;
constexpr size_t WS_ROWTOK = 12 * MiB;
constexpr size_t WS_BLKBASE = 13 * MiB;
constexpr size_t WS_WSM = 14 * MiB;
constexpr size_t SMW_WIN = 0, SMW_WG = SMW_WIN + (size_t)3840 * 2048, SMW_WUQ = SMW_WG + (size_t)3072 * 2048, SMW_WUKV = SMW_WUQ + (size_t)768 * 768,
                 SMW_WBR = SMW_WUKV + (size_t)1024 * 512, SMW_WOUT = SMW_WBR + (size_t)3 * 1024 * 1024, SMW_SHGU = SMW_WOUT + (size_t)1024 * 2048,
                 SMW_SHD = SMW_SHGU + (size_t)512 * 2048, SMW_L = SMW_SHD + (size_t)1024 * 512;
static_assert(WS_WSM + 2 * SMW_L <= 60 * MiB, "small weights");
constexpr size_t WS_MOEW = 126 * MiB;
constexpr size_t WS_SCR = 566 * MiB;
constexpr size_t WS_H = 60 * MiB;
constexpr size_t WS_RET = 126 * MiB;
constexpr size_t WS_CQ = 258 * MiB;
constexpr size_t WS_CKV = WS_CQ + (size_t)M * 384 * 2;
constexpr size_t WS_KR = WS_CKV + (size_t)M * 256 * 2;
constexpr size_t WS_AO = 258 * MiB;
constexpr size_t WS_UV = 302 * MiB;
constexpr size_t WS_Q = 368 * MiB;
constexpr size_t WS_K = WS_Q + (size_t)M * 768 * 2;
constexpr size_t WS_Y = 368 * MiB;
constexpr size_t WS_V = 467 * MiB;
constexpr size_t WS_ST = 500 * MiB;
constexpr size_t WS_HB = 222 * MiB;
constexpr size_t WS_HBS = 329 * MiB;
constexpr size_t WS_OUT = 346 * MiB;
constexpr size_t WS_END = 566 * MiB + 66 * MiB;
static_assert(WS_KR + (size_t)M * 32 * 2 <= WS_UV && WS_K + (size_t)M * 768 * 2 <= WS_V && WS_V + (size_t)M * 512 * 2 <= WS_ST, "ws map");
static_assert(WS_HB + (size_t)APAD * 256 * 2 <= WS_HBS && WS_HBS + (size_t)M * 256 * 2 <= WS_OUT && WS_OUT + (size_t)APAD * 512 * 2 <= WS_END, "ws map moe");
constexpr int CW_BAR = 4096;
constexpr int CW_CNT = 16384;

constexpr int NWAVES = 8, NTHR = 512;
constexpr int LDS_BYTES = 147456;
constexpr int MISC_OFF = 139264;

#define LAS __attribute__((address_space(3)))
typedef unsigned short bf16_t;
__device__ __forceinline__ unsigned f2bf(float f) { unsigned u = __builtin_bit_cast(unsigned, f); return (u + 0x7fffu + ((u >> 16) & 1u)) >> 16; }
__device__ __forceinline__ float bf2f(bf16_t h) { return __builtin_bit_cast(float, (unsigned)h << 16); }
__device__ __forceinline__ float sigmoidf_(float x) { return 1.0f / (1.0f + expf(-x)); }
__device__ __forceinline__ float siluf_(float x) { return x / (1.0f + expf(-x)); }
__device__ __forceinline__ float gelu_tanh(float x) { const float u = 0.7978845608028654f * (x + 0.044715f * x * x * x); return 0.5f * x * (1.0f + tanhf(u)); }
__device__ __forceinline__ float wave_sum(float v) {
#pragma unroll
    for (int o = 1; o < 64; o <<= 1) v += __shfl_xor(v, o);
    return v;
}

#define XB_TMO      128
#define XB_XCNT(j)  (256  + 64 * (j))
#define XB_XSUB(j)  (1280 + 64 * (j))
#define XB_XGEN(j)  (2304 + 64 * (j))
#define XB_TOP      3328
#define XB_TOPGEN   3392
#define XCD_BAR_WORDS 3456
#define XB_SPIN_CAP (1u << 22)
__device__ __forceinline__ unsigned xb_ld(unsigned* p)              { return __hip_atomic_load(p, __ATOMIC_RELAXED, __HIP_MEMORY_SCOPE_AGENT); }
__device__ __forceinline__ unsigned xb_add(unsigned* p, unsigned v) { return __hip_atomic_fetch_add(p, v, __ATOMIC_RELAXED, __HIP_MEMORY_SCOPE_AGENT); }
__device__ __forceinline__ unsigned xb_xcc_id() { return (unsigned)__builtin_amdgcn_s_getreg((3 << 11) | 20) & 0xFu; }
#define XB_SPIN(cond, bar) do { unsigned _sp = 0; while (cond) { __builtin_amdgcn_s_sleep(1); \
    if ((++_sp & 255u) == 0u) { if (xb_ld(&(bar)[XB_TMO])) break; if (_sp > XB_SPIN_CAP) { atomicAdd(&(bar)[XB_TMO], 1u); break; } } } } while (0)
struct XcdBarrier { unsigned* bar; unsigned x; volatile LAS unsigned* st; };
__device__ __forceinline__ XcdBarrier xcd_barrier_post(unsigned* bar, volatile LAS unsigned* st) {
    XcdBarrier b; b.bar = bar; b.x = xb_xcc_id(); b.st = st;
    if (threadIdx.x == 0) (void)xb_add(&bar[XB_XCNT(b.x)], 1u);
    return b;
}
__device__ __forceinline__ void xcd_barrier_complete(unsigned* bar, unsigned x, unsigned& nloc, unsigned& nx) {
    const unsigned G = gridDim.x * gridDim.y * gridDim.z;
    unsigned sum, cnt, mine, sp = 0u;
    for (;;) {
        sum = 0u; cnt = 0u; mine = 0u;
#pragma unroll
        for (unsigned j = 0; j < 16; ++j) { const unsigned c = xb_ld(&bar[XB_XCNT(j)]); sum += c; cnt += (c > 0u) ? 1u : 0u; mine = (j == x) ? c : mine; }
        if (sum == G) break;
        __builtin_amdgcn_s_sleep(1);
        if ((++sp & 255u) == 0u) { if (xb_ld(&bar[XB_TMO])) break; if (sp > XB_SPIN_CAP) { atomicAdd(&bar[XB_TMO], 1u); break; } }
    }
    nloc = mine > 0u ? mine : 1u; nx = cnt > 0u ? cnt : 1u;
}
__device__ __forceinline__ void xcd_barrier(const XcdBarrier& b) {
    asm volatile("s_waitcnt vmcnt(0)" ::: "memory");
    __syncthreads();
    if (threadIdx.x == 0) {
        unsigned* bar = b.bar;
        __builtin_amdgcn_s_waitcnt(0);
        unsigned nloc = b.st[0], nx = b.st[1];
        if (nloc == 0u) { xcd_barrier_complete(bar, b.x, nloc, nx); b.st[0] = nloc; b.st[1] = nx; }
        const unsigned old = xb_add(&bar[XB_XSUB(b.x)], 1u);
        const unsigned gen = old / nloc;
        if (old + 1u == (gen + 1u) * nloc) {
            __builtin_amdgcn_fence(__ATOMIC_RELEASE, "agent");
            asm volatile("s_waitcnt vmcnt(0)" ::: "memory");
            const unsigned og = xb_add(&bar[XB_TOP], 1u);
            const unsigned tg = og / nx;
            if (og + 1u == (tg + 1u) * nx) xb_add(&bar[XB_TOPGEN], 1u);
            else XB_SPIN(xb_ld(&bar[XB_TOPGEN]) == tg, bar);
            __builtin_amdgcn_fence(__ATOMIC_ACQUIRE, "agent");
            xb_add(&bar[XB_XGEN(b.x)], 1u);
            asm volatile("s_waitcnt vmcnt(0)" ::: "memory");
        } else {
            XB_SPIN(xb_ld(&bar[XB_XGEN(b.x)]) == gen, bar);
            __builtin_amdgcn_fence(__ATOMIC_ACQUIRE, "agent");
            asm volatile("s_waitcnt vmcnt(0)" ::: "memory");
        }
    }
    __syncthreads();
}

struct Args {
    const float* in[36]; float* out; unsigned char* ws; int ph_lo, ph_hi;
};
enum { I_X = 0, I_C, I_CTX, I_CCTX, I_ADAW, I_ADAB, I_N1G, I_N2G, I_WIN, I_DECF, I_DECB, I_GNG, I_GNB, I_WBRRET,
       I_QAG, I_WUQ, I_KVAG, I_WUKV, I_QNG, I_KNG, I_KRG, I_WBRMLA, I_LNG, I_LNB, I_GWS, I_GBS, I_WBRG, I_WOUT,
       I_ROUTER, I_MBIAS, I_WG, I_WU, I_WD, I_SG, I_SU, I_SD };

struct Frame {
    unsigned char* lds; int tid, lane, wave, G, bid;
    const Args* A;
};
__device__ __forceinline__ const float* fin_(const Args* A, int i) { asm volatile("" : "+v"(i)); i = __builtin_amdgcn_readfirstlane(i); return A->in[i]; }
#define FIN(i) fin_(F.A, (i))
__device__ __forceinline__ unsigned char* ws_(const Args* A) { unsigned char* p = A->ws; asm volatile("" : "+s"(p)); return p; }
#define FWS(T, off) ((T*)(ws_(F.A) + (off)))
#define F_out (F.A->out)
#define F_ctl FWS(unsigned, WS_CTL)
#define F_MOD FWS(float, WS_MOD)
#define F_ROPE FWS(float, WS_ROPE)
#define F_XC FWS(float, WS_XC)
#define F_IDX FWS(int, WS_IDX)
#define F_WTS FWS(float, WS_WTS)
#define F_SLOT FWS(int, WS_SLOT)
#define F_INV FWS(int, WS_INV)
#define F_ROWTOK FWS(int, WS_ROWTOK)
#define F_BLKBASE FWS(int, WS_BLKBASE)
#define F_H FWS(bf16_t, WS_H)
#define F_RET FWS(bf16_t, WS_RET)
#define F_CQ FWS(bf16_t, WS_CQ)
#define F_CKV FWS(bf16_t, WS_CKV)
#define F_KR FWS(bf16_t, WS_KR)
#define F_AO FWS(bf16_t, WS_AO)
#define F_UV FWS(bf16_t, WS_UV)
#define F_Q FWS(bf16_t, WS_Q)
#define F_K FWS(bf16_t, WS_K)
#define F_V FWS(bf16_t, WS_V)
#define F_Y FWS(bf16_t, WS_Y)
#define F_ST FWS(bf16_t, WS_ST)
#define F_KVR FWS(bf16_t, WS_SCR)
#define F_HB FWS(bf16_t, WS_HB)
#define F_HBS FWS(bf16_t, WS_HBS)
#define F_OUT FWS(bf16_t, WS_OUT)
__device__ __forceinline__ int row_batch(int r) { return r < ML ? (r >> 13) : 4; }
__device__ __forceinline__ const float* x_row_src(const Frame& F, int l, int r) { return r < ML ? ((l == 0 ? FIN(I_X) : F_out) + (size_t)r * D) : (F_XC + (size_t)(r - ML) * D); }
__device__ __forceinline__ float* x_row_dst(const Frame& F, int r) { return r < ML ? (F_out + (size_t)r * D) : (F_XC + (size_t)(r - ML) * D); }

__device__ __forceinline__ void ngemm_acc(float (&acc)[4][4], const bf16_t* A, int lda, const int* rowidx, int row0, int nrows,
                                          const float* W, int ldw, int col0, int ncols, int K, float* sA, float* sW, int tid) {
    const int ty = tid >> 4, tx = tid & 15;
    const int lr = tid >> 2, lk = (tid & 3) * 8;
    const int wk = tid >> 4, wc = (tid & 15) * 4;
    const bool rv = (row0 + lr) < nrows;
    const bf16_t* arow = nullptr;
    if (rv) { const int rr = rowidx ? rowidx[row0 + lr] : (row0 + lr); arow = A + (size_t)rr * lda; }
    const bool cv = (col0 + wc) < ncols;
    for (int k0 = 0; k0 < K; k0 += 32) {
        uint4 av = make_uint4(0u, 0u, 0u, 0u);
        if (rv) av = *(const uint4*)(arow + k0 + lk);
        float4 wv = make_float4(0.f, 0.f, 0.f, 0.f);
        if (cv) wv = *(const float4*)(W + (size_t)(k0 + wk) * ldw + col0 + wc);
        __syncthreads();
        float* sa = sA + lr * 33 + lk;
        sa[0] = __builtin_bit_cast(float, av.x << 16); sa[1] = __builtin_bit_cast(float, av.x & 0xffff0000u);
        sa[2] = __builtin_bit_cast(float, av.y << 16); sa[3] = __builtin_bit_cast(float, av.y & 0xffff0000u);
        sa[4] = __builtin_bit_cast(float, av.z << 16); sa[5] = __builtin_bit_cast(float, av.z & 0xffff0000u);
        sa[6] = __builtin_bit_cast(float, av.w << 16); sa[7] = __builtin_bit_cast(float, av.w & 0xffff0000u);
        *(float4*)(sW + wk * 64 + wc) = wv;
        __syncthreads();
#pragma unroll 8
        for (int kk = 0; kk < 32; ++kk) {
            const float4 w = *(const float4*)(sW + kk * 64 + tx * 4);
            float a[4];
#pragma unroll
            for (int i = 0; i < 4; ++i) a[i] = sA[(ty * 4 + i) * 33 + kk];
#pragma unroll
            for (int i = 0; i < 4; ++i) { acc[i][0] += a[i] * w.x; acc[i][1] += a[i] * w.y; acc[i][2] += a[i] * w.z; acc[i][3] += a[i] * w.w; }
        }
    }
}
#define ZERO_ACC(a) do { _Pragma("unroll") for (int _i = 0; _i < 4; ++_i) _Pragma("unroll") for (int _j = 0; _j < 4; ++_j) a[_i][_j] = 0.f; } while (0)

namespace g8 {
typedef short bf16x8 __attribute__((ext_vector_type(8)));
typedef float f32x4 __attribute__((ext_vector_type(4)));
typedef unsigned u32x4 __attribute__((ext_vector_type(4)));
typedef float f32x2 __attribute__((ext_vector_type(2)));
typedef __bf16 bf16x2_t __attribute__((ext_vector_type(2)));
constexpr int HTB = 16384, STAGE_BYTES = 8 * HTB;
__device__ __forceinline__ int lds_byte(int r, int c) { const int st = (r >> 4) * 2 + (c >> 5), rr = r & 15, cc = c & 31, ob = rr * 64 + cc * 2; return st * 1024 + (ob ^ (((ob >> 9) & 1) << 5)); }
__device__ __forceinline__ void stage_rc(int b, int& R, int& C) { const int st = b / 1024, sb = b % 1024, swz = sb ^ (((sb >> 9) & 1) << 5); R = (st >> 1) * 16 + swz / 64; C = (st & 1) * 32 + (swz % 64) / 2; }
__device__ __forceinline__ int perm32(int rho) { const int n = rho >> 4, i = rho & 15; return 8 * (i >> 2) + 4 * n + (i & 3); }
__device__ __forceinline__ unsigned cvtpk(float lo, float hi) { f32x2 v = {lo, hi}; bf16x2_t b = __builtin_convertvector(v, bf16x2_t); return __builtin_bit_cast(unsigned, b); }
__device__ __forceinline__ float fsigmoid(float x) { return __builtin_amdgcn_rcpf(1.0f + __builtin_amdgcn_exp2f(-1.4426950408889634f * x)); }
__device__ __forceinline__ u32x4 pack8(const f32x4& a, const f32x4& b) { u32x4 w; w.x = cvtpk(a[0], a[1]); w.y = cvtpk(a[2], a[3]); w.z = cvtpk(b[0], b[1]); w.w = cvtpk(b[2], b[3]); return w; }
__device__ __forceinline__ void unpack8(const u32x4& w, f32x4& a, f32x4& b) {
    a[0] = __builtin_bit_cast(float, w.x << 16); a[1] = __builtin_bit_cast(float, w.x & 0xffff0000u); a[2] = __builtin_bit_cast(float, w.y << 16); a[3] = __builtin_bit_cast(float, w.y & 0xffff0000u);
    b[0] = __builtin_bit_cast(float, w.z << 16); b[1] = __builtin_bit_cast(float, w.z & 0xffff0000u); b[2] = __builtin_bit_cast(float, w.w << 16); b[3] = __builtin_bit_cast(float, w.w & 0xffff0000u); }

struct GUnit { const char* A; const char* B; const int* rows; int arow0; unsigned lda2, ldb2; int nt; int pm, pn, tag; };

#define G8_ROWS(u, ra) do { _Pragma("unroll") for (int _h = 0; _h < 2; ++_h) { \
        const int _x0 = (u).arow0 + _h * 128 + R0, _x1 = (u).arow0 + _h * 128 + R1; \
        ra[_h][0] = (u).rows ? (u).rows[_x0] : _x0; ra[_h][1] = (u).rows ? (u).rows[_x1] : _x1; } } while (0)

template <bool GATHER, class Sched, class Epi>
__device__ __forceinline__ void gemm_phase(LAS unsigned char* lds, const Sched& S, const Epi& E, int tid_in) {
    int tid = tid_in; asm volatile("" : "+v"(tid));
    const int wid = __builtin_amdgcn_readfirstlane(tid >> 6), lane = tid & 63, wr = wid >> 2, wc = wid & 3, fr = lane & 15, fq = lane >> 4;
    int R0, C0, R1, C1; stage_rc(tid * 16, R0, C0); stage_rc(tid * 16 + 8192, R1, C1);
    const int Rb0 = (R0 & ~31) + perm32(R0 & 31), Rb1 = (R1 & ~31) + perm32(R1 & 31);
    const unsigned ldsw = (unsigned)wid * 1024u, cb0 = (unsigned)C0 * 2u, cb1 = (unsigned)C1 * 2u;
    const int aoff = lds_byte(wr * 64 + fr, fq * 8), boff = lds_byte(wc * 32 + fr, fq * 8);
#define G8_SA(b, h) (((b) * 2 + (h)) * HTB)
#define G8_SB(b, h) ((4 + (b) * 2 + (h)) * HTB)
#define G8_GLDS(gptr, bufoff, i) __builtin_amdgcn_global_load_lds((const unsigned*)(gptr), (LAS unsigned*)(lds + (bufoff) + ldsw + (i) * 8192), 16, 0, 0)
#define G8_STAGE_A(bufoff, gbase, ld2, ra2, arow, h, kb) do { if constexpr (GATHER) { \
        G8_GLDS((gbase) + (size_t)((unsigned)(ra2)[0] * (ld2) + cb0 + (kb)), bufoff, 0); G8_GLDS((gbase) + (size_t)((unsigned)(ra2)[1] * (ld2) + cb1 + (kb)), bufoff, 1); } else { \
        G8_GLDS((gbase) + (size_t)((unsigned)((arow) + (h) * 128 + R0) * (ld2) + cb0 + (kb)), bufoff, 0); G8_GLDS((gbase) + (size_t)((unsigned)((arow) + (h) * 128 + R1) * (ld2) + cb1 + (kb)), bufoff, 1); } } while (0)
#define G8_STAGE_B(bufoff, gbase, ld2, h, kb) do { G8_GLDS((gbase) + (size_t)((unsigned)((h) * 128 + Rb0) * (ld2) + cb0 + (kb)), bufoff, 0); G8_GLDS((gbase) + (size_t)((unsigned)((h) * 128 + Rb1) * (ld2) + cb1 + (kb)), bufoff, 1); } while (0)
#define G8_LDA(dst, b, h) do { _Pragma("unroll") for (int m = 0; m < 4; ++m) _Pragma("unroll") for (int k = 0; k < 2; ++k) dst[m][k] = *(const LAS bf16x8*)(lds + G8_SA(b, h) + aoff + m * 2048 + k * 1024); } while (0)
#define G8_LDB(dst, b, h) do { _Pragma("unroll") for (int n = 0; n < 2; ++n) _Pragma("unroll") for (int k = 0; k < 2; ++k) dst[n][k] = *(const LAS bf16x8*)(lds + G8_SB(b, h) + boff + n * 2048 + k * 1024); } while (0)
#define G8_MMA(ai, bj, At, Bt) do { __builtin_amdgcn_s_setprio(1); _Pragma("unroll") for (int m = 0; m < 4; ++m) _Pragma("unroll") for (int n = 0; n < 2; ++n) _Pragma("unroll") for (int k = 0; k < 2; ++k) \
        acc[ai][bj][m][n] = __builtin_amdgcn_mfma_f32_16x16x32_bf16(Bt[n][k], At[m][k], acc[ai][bj][m][n], 0, 0, 0); __builtin_amdgcn_s_setprio(0); } while (0)
#define G8_WAIT_V(n) asm volatile("s_waitcnt vmcnt(" #n ")" ::: "memory")
#define G8_WAIT_L(n) asm volatile("s_waitcnt lgkmcnt(" #n ")" ::: "memory")
#define G8_BAR __builtin_amdgcn_s_barrier()
#define G8_SCHED __builtin_amdgcn_sched_barrier(0)
    GUnit cur, nxt; int ui = 0;
    if (!S.get(0, cur)) return;
#define G8_OPAQUE(u) do { (u).lda2 = (unsigned)__builtin_amdgcn_readfirstlane((int)(u).lda2); (u).ldb2 = (unsigned)__builtin_amdgcn_readfirstlane((int)(u).ldb2); (u).nt = __builtin_amdgcn_readfirstlane((u).nt); (u).arow0 = __builtin_amdgcn_readfirstlane((u).arow0); \
    asm volatile("" : "+s"((u).lda2), "+s"((u).ldb2), "+s"((u).nt), "+s"((u).arow0)); } while (0)
    G8_OPAQUE(cur);
    int ra_c[2][2], ra_n[2][2];
    if constexpr (GATHER) { G8_ROWS(cur, ra_c); }
    f32x4 acc[2][2][4][2];
#pragma unroll
    for (int a = 0; a < 2; ++a)
#pragma unroll
        for (int b = 0; b < 2; ++b)
#pragma unroll
            for (int m = 0; m < 4; ++m)
#pragma unroll
                for (int n = 0; n < 2; ++n) acc[a][b][m][n] = (f32x4){0.f, 0.f, 0.f, 0.f};
    bf16x8 At[4][2], B0[2][2], B1[2][2];
    G8_STAGE_B(G8_SB(0, 0), cur.B, cur.ldb2, 0, 0u); G8_STAGE_B(G8_SB(0, 1), cur.B, cur.ldb2, 1, 0u); G8_STAGE_A(G8_SA(0, 0), cur.A, cur.lda2, ra_c[0], cur.arow0, 0, 0u); G8_STAGE_A(G8_SA(0, 1), cur.A, cur.lda2, ra_c[1], cur.arow0, 1, 0u);
    if (wr == 1) G8_BAR;
    G8_WAIT_V(2); G8_BAR;
    G8_STAGE_B(G8_SB(1, 0), cur.B, cur.ldb2, 0, 128u); G8_STAGE_A(G8_SA(1, 0), cur.A, cur.lda2, ra_c[0], cur.arow0, 0, 128u); G8_STAGE_B(G8_SB(1, 1), cur.B, cur.ldb2, 1, 128u);
    G8_WAIT_V(6); G8_BAR;
    for (;;) {
        const bool has_next = S.get(ui + 1, nxt);
        if (has_next) G8_OPAQUE(nxt);
        if (has_next) { if constexpr (GATHER) { G8_ROWS(nxt, ra_n); } }
        else { nxt = cur;
            if constexpr (GATHER) {
#pragma unroll
            for (int h = 0; h < 2; ++h)
#pragma unroll
                for (int i = 0; i < 2; ++i) ra_n[h][i] = ra_c[h][i]; } }
        const int nt = cur.nt;
        for (int t = 0; t < nt; t += 2) {
            const bool last = (t == nt - 2);
            const char* a2 = last ? nxt.A : cur.A; const char* b2 = last ? nxt.B : cur.B;
            const unsigned la2 = last ? nxt.lda2 : cur.lda2, lb2 = last ? nxt.ldb2 : cur.ldb2;
            const unsigned k1 = (unsigned)(t + 1) * 128u, k2 = last ? 0u : (unsigned)(t + 2) * 128u, k3 = k2 + 128u;
            const int ar2 = last ? nxt.arow0 : cur.arow0; (void)ar2;
            int ra2[2][2];
            if constexpr (GATHER) {
#pragma unroll
            for (int h = 0; h < 2; ++h)
#pragma unroll
                for (int i = 0; i < 2; ++i) ra2[h][i] = last ? ra_n[h][i] : ra_c[h][i]; }
            G8_LDB(B0, 0, 0); G8_LDB(B1, 0, 1); G8_SCHED; G8_LDA(At, 0, 0); G8_STAGE_A(G8_SA(1, 1), cur.A, cur.lda2, ra_c[1], cur.arow0, 1, k1);
            G8_WAIT_V(8); G8_WAIT_L(0); G8_BAR; G8_MMA(0, 0, At, B0); G8_MMA(0, 1, At, B1); G8_BAR; G8_SCHED;
            G8_LDA(At, 0, 1); G8_STAGE_B(G8_SB(0, 0), b2, lb2, 0, k2); G8_STAGE_B(G8_SB(0, 1), b2, lb2, 1, k2); G8_STAGE_A(G8_SA(0, 0), a2, la2, ra2[0], ar2, 0, k2);
            G8_WAIT_V(8); G8_WAIT_L(0); G8_BAR; G8_MMA(1, 0, At, B0); G8_MMA(1, 1, At, B1); G8_BAR; G8_SCHED;
            G8_LDB(B0, 1, 0); G8_LDB(B1, 1, 1); G8_SCHED; G8_LDA(At, 1, 0); G8_STAGE_A(G8_SA(0, 1), a2, la2, ra2[1], ar2, 1, k2);
            G8_WAIT_V(8); G8_WAIT_L(0); G8_BAR; G8_MMA(0, 0, At, B0); G8_MMA(0, 1, At, B1); G8_BAR; G8_SCHED;
            G8_LDA(At, 1, 1); G8_STAGE_B(G8_SB(1, 0), b2, lb2, 0, k3); G8_STAGE_B(G8_SB(1, 1), b2, lb2, 1, k3); G8_STAGE_A(G8_SA(1, 0), a2, la2, ra2[0], ar2, 0, k3);
            G8_WAIT_V(8); G8_WAIT_L(0); G8_BAR; G8_MMA(1, 0, At, B0); G8_MMA(1, 1, At, B1); G8_BAR; G8_SCHED;
        }
        if (wr == 0) G8_BAR;
        { int efr = fr, efq = fq, etid = tid; asm volatile("" : "+v"(efr), "+v"(efq), "+v"(etid));
          E(acc, cur, wr, wc, efr, efq, etid); }
        if (!has_next) break;
#pragma unroll
        for (int a = 0; a < 2; ++a)
#pragma unroll
            for (int b = 0; b < 2; ++b)
#pragma unroll
                for (int m = 0; m < 4; ++m)
#pragma unroll
                    for (int n = 0; n < 2; ++n) acc[a][b][m][n] = (f32x4){0.f, 0.f, 0.f, 0.f};
        cur = nxt; ++ui;
        if constexpr (GATHER) {
#pragma unroll
        for (int h = 0; h < 2; ++h)
#pragma unroll
            for (int i = 0; i < 2; ++i) ra_c[h][i] = ra_n[h][i]; }
        if (wr == 1) G8_BAR;
    }
    G8_WAIT_V(0);
    G8_BAR;
#undef G8_SA
#undef G8_SB
#undef G8_GLDS
#undef G8_OPAQUE
#undef G8_STAGE_A
#undef G8_STAGE_B
#undef G8_LDA
#undef G8_LDB
#undef G8_MMA
#undef G8_WAIT_V
#undef G8_WAIT_L
#undef G8_BAR
#undef G8_SCHED
}
__device__ __forceinline__ bool tile_order(int i, int G, int c, int nM, int nN, int& pm, int& pn) {
    const int nwg = nM * nN; const long L = (long)i * G + c; if (L >= nwg) return false;
    int wgid = (int)L; { const int q = nwg / 8, r = nwg % 8, xcd = wgid % 8, off = wgid / 8; wgid = (xcd < r ? xcd * (q + 1) : r * (q + 1) + (xcd - r) * q) + off; }
    const int nig = 8 * nN, gid = wgid / nig, fm = gid * 8, gsz = (nM - fm) < 8 ? (nM - fm) : 8;
    pm = fm + ((wgid % nig) % gsz); pn = (wgid % nig) / gsz; return true;
}
}

__device__ __forceinline__ void p_prologue(Frame& F) {
    float* sred = (float*)F.lds;
    const float* cvp = FIN(I_C); const float* ccp = FIN(I_CCTX); const float* adab = FIN(I_ADAB); const float* adaw = FIN(I_ADAW);
    for (int u = F.bid; u < 2 * 96; u += F.G) {
        const int l = u / 96, n0 = (u % 96) * 64, n = n0 + (F.tid & 63), ks = F.tid >> 6;
        float a[5] = {0.f, 0.f, 0.f, 0.f, 0.f};
        const float* W = adaw + (size_t)l * D * 6144;
        for (int k = ks * 128; k < ks * 128 + 128; ++k) {
            const float w = W[(size_t)k * 6144 + n];
#pragma unroll
            for (int b = 0; b < 4; ++b) a[b] += siluf_(cvp[b * D + k]) * w;
            a[4] += siluf_(ccp[k]) * w;
        }
        __syncthreads();
#pragma unroll
        for (int b = 0; b < 5; ++b) sred[(ks * 64 + (F.tid & 63)) * 5 + b] = a[b];
        __syncthreads();
        if (F.tid < 64 * 5) { const int c = F.tid / 5, b = F.tid % 5; float s = 0.f;
            for (int q = 0; q < 8; ++q) s += sred[(q * 64 + c) * 5 + b];
            F_MOD[((size_t)l * 5 + b) * 6144 + n0 + c] = s + adab[l * 6144 + n0 + c]; }
    }
    const int gt = F.bid * NTHR + F.tid, GT = F.G * NTHR;
    for (int i = gt; i < SEQ * 16; i += GT) {
        const int t = i >> 4, a = (i >> 3) & 1, f = i & 7;
        const float inv = powf(10000.0f, -(float)f / 8.0f);
        const float pos = a == 0 ? (float)(t >> 6) : (float)(t & 63);
        const float ang = pos * inv;
        F_ROPE[t * 32 + a * 16 + f] = cosf(ang); F_ROPE[t * 32 + a * 16 + 8 + f] = sinf(ang);
    }
    { const float4* cx = (const float4*)FIN(I_CTX); for (int i = gt; i < MC * D / 4; i += GT) ((float4*)F_XC)[i] = cx[i]; }
}

__device__ __forceinline__ void p_norm(Frame& F, int l, int which, int nrows) {
    const int gw = F.bid * NWAVES + F.wave, NGW = F.G * NWAVES;
    const float* g = FIN(which == 0 ? I_N1G : I_N2G) + l * D;
    const float* xlat = (which == 0 && l == 0) ? FIN(I_X) : F_out;
    for (int r = gw; r < nrows; r += NGW) {
        const float4* xr = (const float4*)(r < ML ? xlat + (size_t)r * D : F_XC + (size_t)(r - ML) * D) + F.lane;
        const float* mod = F_MOD + ((size_t)l * 5 + row_batch(r)) * 6144 + (which == 0 ? 0 : 3 * D);
        float4 v[4]; float s = 0.f;
#pragma unroll
        for (int j = 0; j < 4; ++j) { v[j] = xr[64 * j]; s += (v[j].x * v[j].x + v[j].y * v[j].y) + (v[j].z * v[j].z + v[j].w * v[j].w); }
        const float rstd = 1.0f / sqrtf(wave_sum(s) * (1.0f / D) + EPS);
#pragma unroll
        for (int j = 0; j < 4; ++j) { const int e = j * 256 + F.lane * 4;
            const float4 gg = *(const float4*)(g + e), sh = *(const float4*)(mod + e), sc = *(const float4*)(mod + D + e);
            const float o0 = (v[j].x * rstd * gg.x) * (1.f + sc.x) + sh.x, o1 = (v[j].y * rstd * gg.y) * (1.f + sc.y) + sh.y;
            const float o2 = (v[j].z * rstd * gg.z) * (1.f + sc.z) + sh.z, o3 = (v[j].w * rstd * gg.w) * (1.f + sc.w) + sh.w;
            uint2 w; w.x = f2bf(o0) | (f2bf(o1) << 16); w.y = f2bf(o2) | (f2bf(o3) << 16);
            *(uint2*)(F_H + (size_t)r * D + e) = w; }
    }
}

__device__ __forceinline__ void p_inproj_naive(Frame& F, int l) {
    float* sA = (float*)F.lds; float* sW = sA + 128 * 33;
    const float* W = FIN(I_WIN) + (size_t)l * D * N_IN;
    constexpr int NT_N = (OFF_MERGE + 63) / 64, NT_M = M / 128;
    const int ty = F.tid >> 4, tx = F.tid & 15;
    for (int t = F.bid; t < NT_M * NT_N; t += F.G) {
        const int tm = t / NT_N, tn = t % NT_N; float acc[4][4]; ZERO_ACC(acc);
        ngemm_acc(acc, F_H, D, nullptr, tm * 128, M, W, N_IN, tn * 64, OFF_MERGE, D, sA, sW, F.tid);
#pragma unroll
        for (int i = 0; i < 4; ++i)
#pragma unroll
            for (int j = 0; j < 4; ++j) {
                const int r = tm * 128 + ty * 4 + i, c = tn * 64 + tx * 4 + j; if (c >= OFF_MERGE) continue;
                float v = acc[i][j];
                if (c < OFF_CQ) { if (c >= 512 && c < 1024) v *= 0.08838834764831845f; F_RET[(size_t)r * 2048 + c] = (bf16_t)f2bf(v); }
                else if (c < OFF_CKV) F_CQ[(size_t)r * 384 + (c - OFF_CQ)] = (bf16_t)f2bf(v);
                else if (c < OFF_KR) F_CKV[(size_t)r * 256 + (c - OFF_CKV)] = (bf16_t)f2bf(v);
                else if (c < OFF_UV) F_KR[(size_t)r * 32 + (c - OFF_KR)] = (bf16_t)f2bf(v);
                else F_UV[(size_t)r * 1024 + (c - OFF_UV)] = (bf16_t)f2bf(gelu_tanh(v));
            }
    }
}

__device__ __forceinline__ float rope_elem(const float* tab  , int d, float y, float yp) {
    const int a = d >> 4, j = d & 15, f = j & 7; const float c = tab[a * 16 + f], s = tab[a * 16 + 8 + f];
    return (j < 8) ? (y * c - yp * s) : (yp * s + y * c);
}
__device__ __forceinline__ void p_rowpass_a(Frame& F, int l) {
    const int gw = F.bid * NWAVES + F.wave, NGW = F.G * NWAVES, lane = F.lane;
    const float* qag = FIN(I_QAG) + l * 384; const float* kvag = FIN(I_KVAG) + l * 256; const float* krg = FIN(I_KRG) + l * 32;
    const float* lng = FIN(I_LNG) + l * 512; const float* lnb = FIN(I_LNB) + l * 512;
    for (int r = gw; r < M; r += NGW) {
        { bf16_t* p = F_CQ + (size_t)r * 384; float x[6]; float s = 0.f;
#pragma unroll
          for (int j = 0; j < 6; ++j) { x[j] = bf2f(p[lane + 64 * j]); s += x[j] * x[j]; }
          const float rstd = 1.0f / sqrtf(wave_sum(s) * (1.0f / 384.f) + EPS);
#pragma unroll
          for (int j = 0; j < 6; ++j) p[lane + 64 * j] = (bf16_t)f2bf(x[j] * rstd * qag[lane + 64 * j]); }
        { bf16_t* p = F_CKV + (size_t)r * 256; float x[4]; float s = 0.f;
#pragma unroll
          for (int j = 0; j < 4; ++j) { x[j] = bf2f(p[lane + 64 * j]); s += x[j] * x[j]; }
          const float rstd = 1.0f / sqrtf(wave_sum(s) * (1.0f / 256.f) + EPS);
#pragma unroll
          for (int j = 0; j < 4; ++j) p[lane + 64 * j] = (bf16_t)f2bf(x[j] * rstd * kvag[lane + 64 * j]); }
        { bf16_t* p = F_KR + (size_t)r * 32; const int d = lane & 31; const float x = lane < 32 ? bf2f(p[d]) : 0.f;
          const float rstd = 1.0f / sqrtf(wave_sum(x * x) * (1.0f / 32.f) + EPS);
          float y = x * rstd * krg[d]; const float yp = __shfl_xor(y, 8);
          if (r < ML) y = rope_elem(F_ROPE + (size_t)(r & (SEQ - 1)) * 32, d, y, yp);
          if (lane < 32) p[d] = (bf16_t)f2bf(y); }
        { bf16_t* p = F_UV + (size_t)r * 1024 + 512; float x[8]; float s = 0.f;
#pragma unroll
          for (int j = 0; j < 8; ++j) { x[j] = bf2f(p[lane + 64 * j]); s += x[j]; }
          const float mu = wave_sum(s) * (1.0f / 512.f); float q = 0.f;
#pragma unroll
          for (int j = 0; j < 8; ++j) { x[j] -= mu; q += x[j] * x[j]; }
          const float rstd = 1.0f / sqrtf(wave_sum(q) * (1.0f / 512.f) + EPS);
#pragma unroll
          for (int j = 0; j < 8; ++j) p[lane + 64 * j] = (bf16_t)f2bf(x[j] * rstd * lng[lane + 64 * j] + lnb[lane + 64 * j]); }
    }
}

__device__ __forceinline__ void p_mlaup_naive(Frame& F, int l) {
    float* sA = (float*)F.lds; float* sW = sA + 128 * 33;
    const int ty = F.tid >> 4, tx = F.tid & 15;
    constexpr int NT_M = M / 128, NQ = 768 / 64, NKV = 1024 / 64;
    for (int t = F.bid; t < NT_M * (NQ + NKV); t += F.G) {
        const int tm = t / (NQ + NKV), tn = t % (NQ + NKV); float acc[4][4]; ZERO_ACC(acc);
        if (tn < NQ) {
            ngemm_acc(acc, F_CQ, 384, nullptr, tm * 128, M, FIN(I_WUQ) + (size_t)l * 384 * 768, 768, tn * 64, 768, 384, sA, sW, F.tid);
#pragma unroll
            for (int i = 0; i < 4; ++i)
#pragma unroll
                for (int j = 0; j < 4; ++j) F_Q[(size_t)(tm * 128 + ty * 4 + i) * 768 + tn * 64 + tx * 4 + j] = (bf16_t)f2bf(acc[i][j]);
        } else {
            const int tk = tn - NQ;
            ngemm_acc(acc, F_CKV, 256, nullptr, tm * 128, M, FIN(I_WUKV) + (size_t)l * 256 * 1024, 1024, tk * 64, 1024, 256, sA, sW, F.tid);
#pragma unroll
            for (int i = 0; i < 4; ++i)
#pragma unroll
                for (int j = 0; j < 4; ++j) F_KVR[(size_t)(tm * 128 + ty * 4 + i) * 1024 + tk * 64 + tx * 4 + j] = (bf16_t)f2bf(acc[i][j]);
        }
    }
}
__device__ __forceinline__ void p_rowpass_b(Frame& F, int l) {
    const int gw = F.bid * NWAVES + F.wave, NGW = F.G * NWAVES, lane = F.lane;
    const float* qng = FIN(I_QNG) + l * 96; const float* kng = FIN(I_KNG) + l * 64;
    for (int r = gw; r < M; r += NGW) {
        const float* tab = F_ROPE + (size_t)(r & (SEQ - 1)) * 32;
        const float krv = lane < 32 ? bf2f(F_KR[(size_t)r * 32 + lane]) : 0.f;
        for (int h = 0; h < 8; ++h) {
            bf16_t* q = F_Q + (size_t)r * 768 + h * 96;
            const float x0 = bf2f(q[lane]), x1 = lane < 32 ? bf2f(q[64 + lane]) : 0.f;
            const float rstd = 1.0f / sqrtf(wave_sum(x0 * x0 + x1 * x1) * (1.0f / 96.f) + EPS);
            const float y0 = x0 * rstd * qng[lane]; float y1 = x1 * rstd * qng[64 + (lane & 31)];
            const float yp = __shfl_xor(y1, 8);
            if (r < ML) y1 = rope_elem(tab, lane & 31, y1, yp);
            q[lane] = (bf16_t)f2bf(y0 * QSCALE); if (lane < 32) q[64 + lane] = (bf16_t)f2bf(y1 * QSCALE);
            const bf16_t* kv = F_KVR + (size_t)r * 1024 + h * 128;
            const float k0 = bf2f(kv[lane]);
            const float rk = 1.0f / sqrtf(wave_sum(k0 * k0) * (1.0f / 64.f) + EPS);
            bf16_t* ko = F_K + (size_t)r * 768 + h * 96;
            ko[lane] = (bf16_t)f2bf(k0 * rk * kng[lane]); if (lane < 32) ko[64 + lane] = (bf16_t)f2bf(krv);
            F_V[(size_t)r * 512 + h * 64 + lane] = kv[64 + lane];
        }
    }
}

__device__ __forceinline__ void attn_unit_naive(Frame& F, int h, int qrow0, int kr0, int kn0, int kr1, int kn1) {
    float* sQ = (float*)F.lds;
    float* sK = sQ + 32 * 97;
    float* sV = sK + 64 * 97;
    float* sS = sV + 64 * 64;
    float* sM = sS + 32 * 65;
    const int tid = F.tid;
    __syncthreads();
    for (int i = tid; i < 32 * 96; i += NTHR) { const int rr = i / 96, d = i % 96; sQ[rr * 97 + d] = bf2f(F_Q[(size_t)(qrow0 + rr) * 768 + h * 96 + d]); }
    if (tid < 32) { sM[tid] = -INFINITY; sM[32 + tid] = 0.f; sM[64 + tid] = 0.f; }
    float o[4] = {0.f, 0.f, 0.f, 0.f};
    const int srow = tid >> 4, scol = tid & 15;
    const int orow = (tid >> 6) * 4, ocol = tid & 63;
    const int ntile = (kn0 + kn1) / 64;
    for (int kt = 0; kt < ntile; ++kt) {
        const int j0 = kt * 64; const int krow = j0 < kn0 ? kr0 + j0 : kr1 + (j0 - kn0);
        __syncthreads();
        for (int i = tid; i < 64 * 96; i += NTHR) { const int rr = i / 96, d = i % 96; sK[rr * 97 + d] = bf2f(F_K[(size_t)(krow + rr) * 768 + h * 96 + d]); }
        for (int i = tid; i < 64 * 64; i += NTHR) { const int rr = i >> 6, d = i & 63; sV[rr * 64 + d] = bf2f(F_V[(size_t)(krow + rr) * 512 + h * 64 + d]); }
        __syncthreads();
        float s[4] = {0.f, 0.f, 0.f, 0.f};
        for (int d = 0; d < 96; ++d) { const float qv = sQ[srow * 97 + d];
#pragma unroll
            for (int jj = 0; jj < 4; ++jj) s[jj] += qv * sK[(scol + 16 * jj) * 97 + d]; }
#pragma unroll
        for (int jj = 0; jj < 4; ++jj) sS[srow * 65 + scol + 16 * jj] = s[jj];
        __syncthreads();
        if (tid < 32) { float mx = sM[tid];
            for (int j = 0; j < 64; ++j) mx = fmaxf(mx, sS[tid * 65 + j]);
            const float al = exp2f(sM[tid] - mx); float ls = 0.f;
            for (int j = 0; j < 64; ++j) { const float p = exp2f(sS[tid * 65 + j] - mx); sS[tid * 65 + j] = p; ls += p; }
            sM[tid] = mx; sM[32 + tid] = sM[32 + tid] * al + ls; sM[64 + tid] = al; }
        __syncthreads();
#pragma unroll
        for (int i = 0; i < 4; ++i) { float a = o[i] * sM[64 + orow + i];
            for (int j = 0; j < 64; ++j) a += sS[(orow + i) * 65 + j] * sV[j * 64 + ocol];
            o[i] = a; }
    }
#pragma unroll
    for (int i = 0; i < 4; ++i) F_AO[(size_t)(qrow0 + orow + i) * 512 + h * 64 + ocol] = (bf16_t)f2bf(o[i] / sM[32 + orow + i]);
}

__device__ __forceinline__ void ret_unit_naive(Frame& F, int l, int b, int h, int qpos0, bool isctx) {
    float* sQ = (float*)F.lds;
    float* sK = sQ + 32 * 129;
    float* sV = sK + 64 * 129;
    float* sS = sV + 64 * 128;
    float* sT = sS + 32 * 65;
    const int tid = F.tid;
    const float df = FIN(I_DECF)[l * 4 + h], db = FIN(I_DECB)[l * 4 + h];
    const float lf = -log1pf(expf(-df)) * 1.4426950408889634f, lb = -log1pf(expf(-db)) * 1.4426950408889634f;
    const int qrow0 = isctx ? ML + b * CTX + qpos0 : b * SEQ + qpos0;
    __syncthreads();
    for (int i = tid; i < 32 * 128; i += NTHR) { const int rr = i >> 7, d = i & 127; sQ[rr * 129 + d] = bf2f(F_RET[(size_t)(qrow0 + rr) * 2048 + h * 128 + d]); }
    float o[8];
#pragma unroll
    for (int i = 0; i < 8; ++i) o[i] = 0.f;
    const int srow = tid >> 4, scol = tid & 15;
    const int orow = (tid >> 7) * 8, ocol = tid & 127;
    const int ntile = isctx ? CTX / 64 : (CTX + SEQ) / 64;
    for (int kt = 0; kt < ntile; ++kt) {
        const int j0 = kt * 64; const bool kctx = j0 < CTX;
        const int kpos0 = kctx ? j0 : j0 - CTX; const int krow = kctx ? ML + b * CTX + kpos0 : b * SEQ + kpos0;
        __syncthreads();
        for (int i = tid; i < 64 * 128; i += NTHR) { const int rr = i >> 7, d = i & 127;
            sK[rr * 129 + d] = bf2f(F_RET[(size_t)(krow + rr) * 2048 + 512 + h * 128 + d]);
            sV[rr * 128 + d] = bf2f(F_RET[(size_t)(krow + rr) * 2048 + 1024 + h * 128 + d]); }
        __syncthreads();
        float s[4] = {0.f, 0.f, 0.f, 0.f};
        for (int d = 0; d < 128; ++d) { const float qv = sQ[srow * 129 + d];
#pragma unroll
            for (int jj = 0; jj < 4; ++jj) s[jj] += qv * sK[(scol + 16 * jj) * 129 + d]; }
        const int i_ = qpos0 + srow;
#pragma unroll
        for (int jj = 0; jj < 4; ++jj) { const int j_ = kpos0 + scol + 16 * jj; float w;
            if (isctx == kctx) w = (j_ <= i_) ? exp2f(lf * (float)(i_ - j_)) : exp2f(lb * (float)(j_ - i_));
            else w = exp2f(lf * (float)(i_ + CTX - j_)) + exp2f(lb * (float)(SEQ - i_ + j_));
            sS[srow * 65 + scol + 16 * jj] = s[jj] * w; }
        __syncthreads();
#pragma unroll
        for (int i = 0; i < 8; ++i) { float a = o[i];
            for (int j = 0; j < 64; ++j) a += sS[(orow + i) * 65 + j] * sV[j * 128 + ocol];
            o[i] = a; }
    }
    __syncthreads();
    float* sO = sK;
#pragma unroll
    for (int i = 0; i < 8; ++i) sO[(orow + i) * 129 + ocol] = o[i];
    __syncthreads();
    if (tid < 32) { float mu = 0.f; for (int d = 0; d < 128; ++d) mu += sO[tid * 129 + d]; mu *= (1.0f / 128.f);
        float q = 0.f; for (int d = 0; d < 128; ++d) { const float dd = sO[tid * 129 + d] - mu; q += dd * dd; }
        sT[tid] = mu; sT[32 + tid] = 1.0f / sqrtf(q * (1.0f / 128.f) + EPS); }
    __syncthreads();
    const float gg = FIN(I_GNG)[l * 512 + h * 128 + ocol], gb = FIN(I_GNB)[l * 512 + h * 128 + ocol];
#pragma unroll
    for (int i = 0; i < 8; ++i) { const int rr = orow + i; const size_t base = (size_t)(qrow0 + rr) * 2048 + h * 128 + ocol;
        const float gate = bf2f(F_RET[base + 1536]);
        F_RET[base] = (bf16_t)f2bf(siluf_(gate) * ((o[i] - sT[rr]) * sT[32 + rr] * gg + gb)); }
}

__device__ __forceinline__ void gmlp_unit_naive(Frame& F, int l, int cidx, int g) {
    float* sV = (float*)F.lds;
    float* sW = sV + 128 * 128;
    const int tid = F.tid, r0 = cidx * 128;
    const float* ws = FIN(I_GWS) + ((size_t)l * 4 + g) * 128 * 128; const float* bs = FIN(I_GBS) + (l * 4 + g) * 128;
    __syncthreads();
    for (int i = tid; i < 128 * 128; i += NTHR) { const int rr = i >> 7, c = i & 127;
        sV[rr * 128 + c] = bf2f(F_UV[(size_t)(r0 + rr) * 1024 + 512 + g * 128 + c]); sW[rr * 129 + c] = ws[i]; }
    __syncthreads();
    const int ig = (tid >> 7) * 32, c = tid & 127;
    for (int i = ig; i < ig + 32; ++i) { float a = bs[i];
        for (int j = 0; j < 128; ++j) a += sW[i * 129 + j] * sV[j * 128 + c];
        bf16_t* up = F_UV + (size_t)(r0 + i) * 1024 + g * 128 + c; *up = (bf16_t)f2bf(bf2f(*up) * a); }
}

__device__ __forceinline__ void p_merge_naive(Frame& F, int l, int nrows) {
    float* sA = (float*)F.lds; float* sW = sA + 128 * 33;
    const int ty = F.tid >> 4, tx = F.tid & 15;
    const float* Win = FIN(I_WIN) + (size_t)l * D * N_IN;
    const int ntm = nrows / 128;
    for (int t = F.bid; t < ntm * 16; t += F.G) {
        const int tm = t >> 4, tn = t & 15; float y[4][4]; ZERO_ACC(y);
#pragma unroll 1
        for (int br = 0; br < 3; ++br) {
            float g[4][4]; ZERO_ACC(g); float a[4][4]; ZERO_ACC(a);
            ngemm_acc(g, F_H, D, nullptr, tm * 128, nrows, Win + OFF_MERGE + br * 1024, N_IN, tn * 64, 1024, D, sA, sW, F.tid);
            const bf16_t* A = br == 0 ? F_RET : (br == 1 ? F_AO : F_UV); const int lda = br == 0 ? 2048 : (br == 1 ? 512 : 1024);
            const float* Wb = FIN(br == 0 ? I_WBRRET : (br == 1 ? I_WBRMLA : I_WBRG)) + (size_t)l * 512 * D;
            ngemm_acc(a, A, lda, nullptr, tm * 128, nrows, Wb, D, tn * 64, 1024, 512, sA, sW, F.tid);
#pragma unroll
            for (int i = 0; i < 4; ++i)
#pragma unroll
                for (int j = 0; j < 4; ++j) y[i][j] += sigmoidf_(g[i][j]) * a[i][j];
        }
#pragma unroll
        for (int i = 0; i < 4; ++i)
#pragma unroll
            for (int j = 0; j < 4; ++j) F_Y[(size_t)(tm * 128 + ty * 4 + i) * D + tn * 64 + tx * 4 + j] = (bf16_t)f2bf(y[i][j]);
    }
}
__device__ __forceinline__ void p_out_naive(Frame& F, int l, int nrows) {
    float* sA = (float*)F.lds; float* sW = sA + 128 * 33;
    const int ty = F.tid >> 4, tx = F.tid & 15;
    const int ntm = nrows / 128;
    for (int t = F.bid; t < ntm * 16; t += F.G) {
        const int tm = t >> 4, tn = t & 15; float acc[4][4]; ZERO_ACC(acc);
        ngemm_acc(acc, F_Y, D, nullptr, tm * 128, nrows, FIN(I_WOUT) + (size_t)l * D * D, D, tn * 64, D, D, sA, sW, F.tid);
#pragma unroll
        for (int i = 0; i < 4; ++i) { const int r = tm * 128 + ty * 4 + i; const float* xs = x_row_src(F, l, r); float* xd = x_row_dst(F, r);
            const float* ga = F_MOD + ((size_t)l * 5 + row_batch(r)) * 6144 + 2 * D;
#pragma unroll
            for (int j = 0; j < 4; ++j) { const int c = tn * 64 + tx * 4 + j; xd[c] = xs[c] + ga[c] * acc[i][j]; } }
    }
}

__device__ __forceinline__ void p_router(Frame& F, int l, int ntok) {
    int* hist = (int*)F.lds;
    const int gw = F.bid * NWAVES + F.wave, NGW = F.G * NWAVES, lane = F.lane;
    __syncthreads();
    if (F.tid < 64) hist[F.tid] = 0;
    __syncthreads();
    const float* R = FIN(I_ROUTER) + (size_t)l * D * NEXP; const float bias = FIN(I_MBIAS)[l * NEXP + lane];
    for (int r = gw; r < ntok; r += NGW) {
        const bf16_t* hrow = F_H + (size_t)r * D; float a = 0.f;
        for (int k = 0; k < D; k += 8) { const uint4 hv = *(const uint4*)(hrow + k);
            a += __builtin_bit_cast(float, hv.x << 16) * R[(k + 0) * NEXP + lane]; a += __builtin_bit_cast(float, hv.x & 0xffff0000u) * R[(k + 1) * NEXP + lane];
            a += __builtin_bit_cast(float, hv.y << 16) * R[(k + 2) * NEXP + lane]; a += __builtin_bit_cast(float, hv.y & 0xffff0000u) * R[(k + 3) * NEXP + lane];
            a += __builtin_bit_cast(float, hv.z << 16) * R[(k + 4) * NEXP + lane]; a += __builtin_bit_cast(float, hv.z & 0xffff0000u) * R[(k + 5) * NEXP + lane];
            a += __builtin_bit_cast(float, hv.w << 16) * R[(k + 6) * NEXP + lane]; a += __builtin_bit_cast(float, hv.w & 0xffff0000u) * R[(k + 7) * NEXP + lane]; }
        const float score = sigmoidf_(a); float sel = score + bias;
        float wk[TOPK]; int ek[TOPK]; float wsum = 0.f;
#pragma unroll
        for (int k = 0; k < TOPK; ++k) {
            float bv = sel; int bi = lane;
#pragma unroll
            for (int o = 1; o < 64; o <<= 1) { const float ov = __shfl_xor(bv, o); const int oi = __shfl_xor(bi, o); if (ov > bv || (ov == bv && oi < bi)) { bv = ov; bi = oi; } }
            ek[k] = bi; wk[k] = __shfl(score, bi); wsum += wk[k]; if (lane == bi) sel = -INFINITY;
        }
        if (lane == 0) {
#pragma unroll
            for (int k = 0; k < TOPK; ++k) { F_IDX[r * TOPK + k] = ek[k]; F_WTS[r * TOPK + k] = wk[k] / wsum * 2.5f; F_SLOT[r * TOPK + k] = atomicAdd(&hist[ek[k]], 1); }
        }
    }
    __syncthreads();
    if (F.tid < 64) F_BLKBASE[(l * 256 + F.bid) * 64 + F.tid] = (int)atomicAdd(F_ctl + CW_CNT + l * 64 + F.tid, (unsigned)hist[F.tid]);
    for (int i = F.bid * NTHR + F.tid; i < APAD; i += F.G * NTHR) F_ROWTOK[i] = 0;
}
__device__ __forceinline__ void moe_offsets(Frame& F, int l, int* ps) {
    __syncthreads();
    if (F.tid == 0) { int acc = 0; for (int e = 0; e < NEXP; ++e) { ps[e] = acc; const int c = (int)F_ctl[CW_CNT + l * 64 + e]; ps[65 + e] = c; acc += ((c + 255) >> 8) << 8; } ps[64] = acc; }
    __syncthreads();
}
__device__ __forceinline__ void p_scatter(Frame& F, int l, int ntok) {
    int* ps = (int*)F.lds; moe_offsets(F, l, ps);
    const int NGW = F.G * NWAVES;
    for (int i = F.bid * NTHR + F.tid; i < ntok * TOPK; i += F.G * NTHR) {
        const int r = i / TOPK; const int e = F_IDX[i]; const int blk = (r % NGW) / NWAVES;
        const int row = ps[e] + F_BLKBASE[(l * 256 + blk) * 64 + e] + F_SLOT[i];
        F_ROWTOK[row] = r; F_INV[i] = row;
    }
}
__device__ __forceinline__ void p_moe_gateup_naive(Frame& F, int l, int ntok) {
    int* ps = (int*)F.lds; moe_offsets(F, l, ps);
    float* sA = (float*)(F.lds + 1024); float* sW = sA + 128 * 33;
    const int ty = F.tid >> 4, tx = F.tid & 15;
    int tbase = 0, t = F.bid;
    for (int e = 0; e < NEXP; ++e) {
        const int cnt = ps[65 + e], nt = ((cnt + 127) >> 7) * 4;
        for (; t < tbase + nt; t += F.G) {
            const int tt = t - tbase, tm = tt >> 2, tn = tt & 3; float g[4][4], u[4][4]; ZERO_ACC(g); ZERO_ACC(u);
            const float* Wg = FIN(I_WG) + ((size_t)l * NEXP + e) * D * DEXP; const float* Wu = FIN(I_WU) + ((size_t)l * NEXP + e) * D * DEXP;
            ngemm_acc(g, F_H, D, F_ROWTOK + ps[e], tm * 128, cnt, Wg, DEXP, tn * 64, DEXP, D, sA, sW, F.tid);
            ngemm_acc(u, F_H, D, F_ROWTOK + ps[e], tm * 128, cnt, Wu, DEXP, tn * 64, DEXP, D, sA, sW, F.tid);
#pragma unroll
            for (int i = 0; i < 4; ++i) { const int rr = tm * 128 + ty * 4 + i; if (rr >= cnt) continue;
#pragma unroll
                for (int j = 0; j < 4; ++j) F_HB[(size_t)(ps[e] + rr) * DEXP + tn * 64 + tx * 4 + j] = (bf16_t)f2bf(siluf_(g[i][j]) * u[i][j]); }
        }
        tbase += nt;
    }
    const int ntm = ntok / 128;
    for (int t = F.bid; t < ntm * 4; t += F.G) {
        const int tm = t >> 2, tn = t & 3; float g[4][4], u[4][4]; ZERO_ACC(g); ZERO_ACC(u);
        ngemm_acc(g, F_H, D, nullptr, tm * 128, ntok, FIN(I_SG) + (size_t)l * D * DEXP, DEXP, tn * 64, DEXP, D, sA, sW, F.tid);
        ngemm_acc(u, F_H, D, nullptr, tm * 128, ntok, FIN(I_SU) + (size_t)l * D * DEXP, DEXP, tn * 64, DEXP, D, sA, sW, F.tid);
#pragma unroll
        for (int i = 0; i < 4; ++i)
#pragma unroll
            for (int j = 0; j < 4; ++j) F_HBS[(size_t)(tm * 128 + ty * 4 + i) * DEXP + tn * 64 + tx * 4 + j] = (bf16_t)f2bf(siluf_(g[i][j]) * u[i][j]);
    }
}
__device__ __forceinline__ void p_moe_down_naive(Frame& F, int l, int ntok, int c0) {
    int* ps = (int*)F.lds; moe_offsets(F, l, ps);
    float* sA = (float*)(F.lds + 1024); float* sW = sA + 128 * 33;
    const int ty = F.tid >> 4, tx = F.tid & 15;
    int tbase = 0, t = F.bid;
    for (int e = 0; e < NEXP; ++e) {
        const int cnt = ps[65 + e], nt = ((cnt + 127) >> 7) * 8;
        for (; t < tbase + nt; t += F.G) {
            const int tt = t - tbase, tm = tt >> 3, tn = tt & 7; float acc[4][4]; ZERO_ACC(acc);
            const float* Wd = FIN(I_WD) + ((size_t)l * NEXP + e) * DEXP * D;
            ngemm_acc(acc, F_HB + (size_t)ps[e] * DEXP, DEXP, nullptr, tm * 128, cnt, Wd, D, c0 + tn * 64, D, DEXP, sA, sW, F.tid);
#pragma unroll
            for (int i = 0; i < 4; ++i) { const int rr = tm * 128 + ty * 4 + i; if (rr >= cnt) continue;
#pragma unroll
                for (int j = 0; j < 4; ++j) F_OUT[(size_t)(ps[e] + rr) * 512 + tn * 64 + tx * 4 + j] = (bf16_t)f2bf(acc[i][j]); }
        }
        tbase += nt;
    }
    if (c0 == 0) {
        const int ntm = ntok / 128;
        for (int t = F.bid; t < ntm * 16; t += F.G) {
            const int tm = t >> 4, tn = t & 15; float acc[4][4]; ZERO_ACC(acc);
            ngemm_acc(acc, F_HBS, DEXP, nullptr, tm * 128, ntok, FIN(I_SD) + (size_t)l * DEXP * D, D, tn * 64, D, DEXP, sA, sW, F.tid);
#pragma unroll
            for (int i = 0; i < 4; ++i) { const int r = tm * 128 + ty * 4 + i; float* xd = x_row_dst(F, r);
                const float* gf = F_MOD + ((size_t)l * 5 + row_batch(r)) * 6144 + 5 * D;
#pragma unroll
                for (int j = 0; j < 4; ++j) { const int c = tn * 64 + tx * 4 + j; xd[c] += gf[c] * acc[i][j]; } }
        }
    }
}
__device__ __forceinline__ void p_combine(Frame& F, int l, int ntok, int c0) {
    const int gw = F.bid * NWAVES + F.wave, NGW = F.G * NWAVES, lane = F.lane;
    for (int r = gw; r < ntok; r += NGW) {
        float* xd = x_row_dst(F, r) + c0; const float* gf = F_MOD + ((size_t)l * 5 + row_batch(r)) * 6144 + 5 * D + c0;
        float s[8];
#pragma unroll
        for (int j = 0; j < 8; ++j) s[j] = 0.f;
#pragma unroll
        for (int k = 0; k < TOPK; ++k) { const float w = F_WTS[r * TOPK + k]; const uint4 v = *(const uint4*)(F_OUT + (size_t)F_INV[r * TOPK + k] * 512 + lane * 8);
            s[0] += w * __builtin_bit_cast(float, v.x << 16); s[1] += w * __builtin_bit_cast(float, v.x & 0xffff0000u);
            s[2] += w * __builtin_bit_cast(float, v.y << 16); s[3] += w * __builtin_bit_cast(float, v.y & 0xffff0000u);
            s[4] += w * __builtin_bit_cast(float, v.z << 16); s[5] += w * __builtin_bit_cast(float, v.z & 0xffff0000u);
            s[6] += w * __builtin_bit_cast(float, v.w << 16); s[7] += w * __builtin_bit_cast(float, v.w & 0xffff0000u); }
#pragma unroll
        for (int j = 0; j < 8; ++j) xd[lane * 8 + j] += gf[lane * 8 + j] * s[j];
    }
}

__device__ __forceinline__ void cvt_item(const float* W, int ldw, int k0, int n0, bf16_t* dst  , int ldt, LAS float* scr, int lane) {
#pragma unroll 8
    for (int i = 0; i < 32; ++i) { const int kk = 2 * i + (lane >> 5); scr[kk * 33 + (lane & 31)] = W[(size_t)(k0 + kk) * ldw + n0 + (lane & 31)]; }
    asm volatile("s_waitcnt lgkmcnt(0)" ::: "memory");
    const int c = lane & 7;
#pragma unroll
    for (int j = 0; j < 4; ++j) { const int n = (lane >> 3) + 8 * j; const LAS float* s = scr + (8 * c) * 33 + n;
        uint4 o; o.x = g8::cvtpk(s[0 * 33], s[1 * 33]); o.y = g8::cvtpk(s[2 * 33], s[3 * 33]); o.z = g8::cvtpk(s[4 * 33], s[5 * 33]); o.w = g8::cvtpk(s[6 * 33], s[7 * 33]);
        *(uint4*)(dst + (size_t)n * ldt + k0 + 8 * c) = o; }
    asm volatile("s_waitcnt lgkmcnt(0)" ::: "memory");
}
#define CVT_JOB(Wp, Kk, ldw_, c0_, ncols_, dstp) do { const int _nb = (ncols_) / 32, _ni = ((Kk) / 64) * _nb; \
    if (it < _ni) { const int _kb = it / _nb, _nbi = it % _nb; cvt_item((Wp), (ldw_), 64 * _kb, (c0_) + 32 * _nbi, (dstp) + (size_t)(32 * _nbi) * (Kk), (Kk), scr, lane); return; } it -= _ni; } while (0)
constexpr int CVT_SMALL_ITEMS = 16 * 85 + 16 * 32 + 16 * 96 + 6 * 24 + 4 * 32 + 3 * 8 * 32 + 16 * 32 + 2 * 16 * 8 + 4 * 32;
__device__ __forceinline__ void cvt_small_item(Frame& F, int l, int it, LAS float* scr, int lane) {
    unsigned char* base = ws_(F.A) + WS_WSM + (size_t)l * SMW_L;
    const float* win = FIN(I_WIN) + (size_t)l * D * N_IN;
    CVT_JOB(win, 1024, N_IN, 0, 2720, (bf16_t*)(base + SMW_WIN));
    CVT_JOB(win, 1024, N_IN, 2720, 1024, (bf16_t*)(base + SMW_WIN) + (size_t)2816 * 1024);
    CVT_JOB(win, 1024, N_IN, 3744, 3072, (bf16_t*)(base + SMW_WG));
    CVT_JOB(FIN(I_WUQ) + (size_t)l * 384 * 768, 384, 768, 0, 768, (bf16_t*)(base + SMW_WUQ));
    CVT_JOB(FIN(I_WUKV) + (size_t)l * 256 * 1024, 256, 1024, 0, 1024, (bf16_t*)(base + SMW_WUKV));
    CVT_JOB(FIN(I_WBRRET) + (size_t)l * 512 * D, 512, D, 0, D, (bf16_t*)(base + SMW_WBR));
    CVT_JOB(FIN(I_WBRMLA) + (size_t)l * 512 * D, 512, D, 0, D, (bf16_t*)(base + SMW_WBR) + (size_t)1024 * 512);
    CVT_JOB(FIN(I_WBRG) + (size_t)l * 512 * D, 512, D, 0, D, (bf16_t*)(base + SMW_WBR) + (size_t)2 * 1024 * 512);
    CVT_JOB(FIN(I_WOUT) + (size_t)l * D * D, 1024, D, 0, D, (bf16_t*)(base + SMW_WOUT));
    CVT_JOB(FIN(I_SG) + (size_t)l * D * DEXP, 1024, DEXP, 0, 128, (bf16_t*)(base + SMW_SHGU));
    CVT_JOB(FIN(I_SG) + (size_t)l * D * DEXP, 1024, DEXP, 128, 128, (bf16_t*)(base + SMW_SHGU) + (size_t)256 * 1024);
    CVT_JOB(FIN(I_SU) + (size_t)l * D * DEXP, 1024, DEXP, 0, 128, (bf16_t*)(base + SMW_SHGU) + (size_t)128 * 1024);
    CVT_JOB(FIN(I_SU) + (size_t)l * D * DEXP, 1024, DEXP, 128, 128, (bf16_t*)(base + SMW_SHGU) + (size_t)384 * 1024);
    CVT_JOB(FIN(I_SD) + (size_t)l * DEXP * D, 256, D, 0, D, (bf16_t*)(base + SMW_SHD));
}
constexpr int CVT_MOE_ITEMS_PER_E = 4 * 16 * 4 + 4 * 32;
__device__ __forceinline__ void cvt_moe_item(Frame& F, int l, int itg, LAS float* scr, int lane) {
    const int e = itg / CVT_MOE_ITEMS_PER_E; int it = itg % CVT_MOE_ITEMS_PER_E;
    unsigned char* base = ws_(F.A) + WS_MOEW + (size_t)e * (1536 * 1024);
    const float* wg = FIN(I_WG) + ((size_t)l * NEXP + e) * D * DEXP; const float* wu = FIN(I_WU) + ((size_t)l * NEXP + e) * D * DEXP;
    CVT_JOB(wg, 1024, DEXP, 0, 128, (bf16_t*)base);
    CVT_JOB(wg, 1024, DEXP, 128, 128, (bf16_t*)base + (size_t)256 * 1024);
    CVT_JOB(wu, 1024, DEXP, 0, 128, (bf16_t*)base + (size_t)128 * 1024);
    CVT_JOB(wu, 1024, DEXP, 128, 128, (bf16_t*)base + (size_t)384 * 1024);
    CVT_JOB(FIN(I_WD) + ((size_t)l * NEXP + e) * DEXP * D, 256, D, 0, D, (bf16_t*)(base + 1024 * 1024));
}
__device__ __forceinline__ void p_cvt_small(Frame& F) {
    LAS float* scr = (LAS float*)((LAS unsigned char*)F.lds + F.wave * 16384);
    const int gw = F.bid * NWAVES + F.wave, NGW = F.G * NWAVES;
    for (int it = gw; it < 2 * CVT_SMALL_ITEMS; it += NGW) cvt_small_item(F, it / CVT_SMALL_ITEMS, it % CVT_SMALL_ITEMS, scr, F.lane);
    for (int l = 0; l < 2; ++l) { uint4* z = (uint4*)(ws_(F.A) + WS_WSM + (size_t)l * SMW_L + SMW_WIN + (size_t)2720 * 2048);
        for (int i = F.bid * NTHR + F.tid; i < 96 * 2048 / 16; i += F.G * NTHR) z[i] = make_uint4(0u, 0u, 0u, 0u); }
}
__device__ __forceinline__ void p_cvt_moe(Frame& F, int l) {
    LAS float* scr = (LAS float*)((LAS unsigned char*)F.lds + F.wave * 16384);
    const int gw = F.bid * NWAVES + F.wave, NGW = F.G * NWAVES;
    for (int it = gw; it < NEXP * CVT_MOE_ITEMS_PER_E; it += NGW) cvt_moe_item(F, l, it, scr, F.lane);
}

using g8::f32x4; using g8::u32x4; using g8::GUnit;
#define EPI_ARGS const f32x4 (&acc)[2][2][4][2], const GUnit& u, int wr, int wc, int fr, int fq, int tid
#define EPI_FOR(...) do { _Pragma("unroll") for (int ai = 0; ai < 2; ++ai) _Pragma("unroll") for (int m = 0; m < 4; ++m) { const int lr = ai * 128 + wr * 64 + m * 16 + fr; \
    _Pragma("unroll") for (int bj = 0; bj < 2; ++bj) { const int lc = bj * 128 + wc * 32 + 8 * fq; f32x4 v0 = acc[ai][bj][m][0], v1 = acc[ai][bj][m][1]; const int gi = (ai * 4 + m) * 2 + bj; (void)gi; __VA_ARGS__ } asm volatile("" ::: "memory"); } } while (0)
__device__ __forceinline__ f32x4 gelu4(f32x4 x) { f32x4 o;
#pragma unroll
    for (int i = 0; i < 4; ++i) { const float t = x[i]; o[i] = t * g8::fsigmoid(1.5957691216057308f * (t + 0.044715f * t * t * t)); } return o; }

struct SchedInproj { const char* A; const char* B; int G, c;
    __device__ __forceinline__ bool get(int i, GUnit& u) const { int pm, pn; if (!g8::tile_order(i, G, c, M / 256, 15, pm, pn)) return false;
        u.A = A; u.B = B + (size_t)pn * 256 * 2048; u.rows = nullptr; u.arow0 = pm * 256; u.lda2 = 2048u; u.ldb2 = 2048u; u.nt = 16; u.pm = pm; u.pn = pn; u.tag = 0; return true; } };
struct EpiInproj { bf16_t *RET, *CQ, *CKV, *KR, *UV;
    __device__ __forceinline__ void operator()(EPI_ARGS) const {
        const int r0 = u.pm * 256;
        if (u.pn < 8) { const float sc = (u.pn == 2 || u.pn == 3) ? 0.08838834764831845f : 1.0f;
            EPI_FOR({ *(u32x4*)(RET + (size_t)(r0 + lr) * 2048 + u.pn * 256 + lc) = g8::pack8(v0 * sc, v1 * sc); });
        } else if (u.pn < 11) {
            EPI_FOR({ const int c = (u.pn - 8) * 256 + lc; const u32x4 w = g8::pack8(v0, v1);
                if (c < 384) *(u32x4*)(CQ + (size_t)(r0 + lr) * 384 + c) = w;
                else if (c < 640) *(u32x4*)(CKV + (size_t)(r0 + lr) * 256 + (c - 384)) = w;
                else if (c < 672) *(u32x4*)(KR + (size_t)(r0 + lr) * 32 + (c - 640)) = w; });
        } else {
            EPI_FOR({ *(u32x4*)(UV + (size_t)(r0 + lr) * 1024 + (u.pn - 11) * 256 + lc) = g8::pack8(gelu4(v0), gelu4(v1)); });
        }
    } };
struct SchedMlaUp { const char *CQ, *CKV, *WQ, *WKV; int G, c;
    __device__ __forceinline__ bool get(int i, GUnit& u) const { int pm, pn; if (!g8::tile_order(i, G, c, M / 256, 7, pm, pn)) return false;
        u.rows = nullptr; u.arow0 = pm * 256; u.pm = pm;
        if (pn < 3) { u.A = CQ; u.lda2 = 768u; u.B = WQ + (size_t)pn * 256 * 768; u.ldb2 = 768u; u.nt = 6; u.pn = pn; u.tag = 0; }
        else { u.A = CKV; u.lda2 = 512u; u.B = WKV + (size_t)(pn - 3) * 256 * 512; u.ldb2 = 512u; u.nt = 4; u.pn = pn - 3; u.tag = 1; }
        return true; } };
struct EpiMlaUp { bf16_t *Q, *ST;
    __device__ __forceinline__ void operator()(EPI_ARGS) const {
        const int r0 = u.pm * 256;
        if (u.tag == 0) { EPI_FOR({ *(u32x4*)(Q + (size_t)(r0 + lr) * 768 + u.pn * 256 + lc) = g8::pack8(v0, v1); }); }
        else { EPI_FOR({ *(u32x4*)(ST + (size_t)(r0 + lr) * 1024 + u.pn * 256 + lc) = g8::pack8(v0, v1); }); }
    } };
struct SchedMerge { const char *H, *WG, *ABR, *WBR; unsigned lda2; int G, c, nM;
    __device__ __forceinline__ bool get(int i, GUnit& u) const { int pm, pn; if (!g8::tile_order(i >> 1, G, c, nM, 4, pm, pn)) return false;
        u.rows = nullptr; u.arow0 = pm * 256; u.pm = pm; u.pn = pn; u.tag = i & 1;
        if ((i & 1) == 0) { u.A = H; u.lda2 = 2048u; u.B = WG + (size_t)(pn * 256) * 2048; u.ldb2 = 2048u; u.nt = 16; }
        else { u.A = ABR; u.lda2 = lda2; u.B = WBR + (size_t)pn * 256 * 1024; u.ldb2 = 1024u; u.nt = 8; }
        return true; } };
template <int BR> struct EpiMerge { bf16_t* Y; u32x4* scrT;
    __device__ __forceinline__ void operator()(EPI_ARGS) const {
        const int r0 = u.pm * 256;
        if (u.tag == 0) { EPI_FOR({ f32x4 s0, s1;
                _Pragma("unroll") for (int i = 0; i < 4; ++i) { s0[i] = g8::fsigmoid(v0[i]); s1[i] = g8::fsigmoid(v1[i]); }
                scrT[gi * 512 + tid] = g8::pack8(s0, s1); });
        } else {
            EPI_FOR({ f32x4 t0, t1; g8::unpack8(scrT[gi * 512 + tid], t0, t1); f32x4 y0 = t0 * v0, y1 = t1 * v1;
                u32x4* yp = (u32x4*)(Y + (size_t)(r0 + lr) * 1024 + u.pn * 256 + lc);
                if (BR > 0) { f32x4 p0, p1; g8::unpack8(*yp, p0, p1); y0 += p0; y1 += p1; }
                *yp = g8::pack8(y0, y1); });
        }
    } };
struct SchedOut { const char *Y, *W; int G, c, nM;
    __device__ __forceinline__ bool get(int i, GUnit& u) const { int pm, pn; if (!g8::tile_order(i, G, c, nM, 4, pm, pn)) return false;
        u.A = Y; u.B = W + (size_t)pn * 256 * 2048; u.rows = nullptr; u.arow0 = pm * 256; u.lda2 = 2048u; u.ldb2 = 2048u; u.nt = 16; u.pm = pm; u.pn = pn; u.tag = 0; return true; } };
struct EpiResid { const float* xlat_src; float* xlat_dst; float* XC; const float* modg;
    __device__ __forceinline__ void operator()(EPI_ARGS) const {
        const int r0 = u.pm * 256;
        EPI_FOR({ const int r = r0 + lr, c = u.pn * 256 + lc; const float* xs = r < ML ? xlat_src + (size_t)r * D : XC + (size_t)(r - ML) * D; float* xd = r < ML ? xlat_dst + (size_t)r * D : XC + (size_t)(r - ML) * D;
            const float* g = modg + (size_t)row_batch(r) * 6144 + c;
            const f32x4 g0 = *(const f32x4*)g, g1 = *(const f32x4*)(g + 4), x0 = *(const f32x4*)(xs + c), x1 = *(const f32x4*)(xs + c + 4);
            *(f32x4*)(xd + c) = x0 + g0 * v0; *(f32x4*)(xd + c + 4) = x1 + g1 * v1; });
    } };
__device__ __forceinline__ void moe_tiles(Frame& F, int l, LAS int* tt) {
    __syncthreads();
    if (F.tid == 0) { int nt = 0; for (int e = 0; e < NEXP; ++e) { const int c = (int)F_ctl[CW_CNT + l * 64 + e]; const int n = (c + 255) >> 8; for (int j = 0; j < n; ++j) tt[1 + nt + j] = e; nt += n; } tt[0] = nt; }
    __syncthreads();
}
struct SchedGateUp { const char *H, *MOEW, *SHGU; const int* rowtok; const LAS int* tt; int G, c, nsh  ;
    __device__ __forceinline__ bool get(int i, GUnit& u) const { const int L = i * G + c; const int nr = __builtin_amdgcn_readfirstlane(tt[0]) * 2;
        u.A = H; u.lda2 = 2048u; u.ldb2 = 2048u; u.nt = 16;
        if (L < nr) { const int rt = L >> 1, pn = L & 1, e = __builtin_amdgcn_readfirstlane(tt[1 + rt]); u.rows = rowtok; u.arow0 = rt * 256; u.B = MOEW + (size_t)e * (1536 * 1024) + (size_t)pn * 256 * 2048; u.pm = rt; u.pn = pn; u.tag = 0; return true; }
        const int L2 = L - nr; if (L2 >= nsh * 2) return false;
        u.rows = nullptr; u.arow0 = (L2 >> 1) * 256; u.B = SHGU + (size_t)(L2 & 1) * 256 * 2048; u.pm = L2 >> 1; u.pn = L2 & 1; u.tag = 1; return true; } };
struct EpiGateUp { bf16_t *HB, *HBS;
    __device__ __forceinline__ void operator()(EPI_ARGS) const {
        bf16_t* dst = (u.tag == 0 ? HB : HBS) + (size_t)(u.pm * 256) * DEXP + u.pn * 128;
#pragma unroll
        for (int ai = 0; ai < 2; ++ai)
#pragma unroll
            for (int m = 0; m < 4; ++m) { const int lr = ai * 128 + wr * 64 + m * 16 + fr; f32x4 h0, h1;
#pragma unroll
                for (int i = 0; i < 4; ++i) { const float g0 = acc[ai][0][m][0][i], g1 = acc[ai][0][m][1][i];
                    h0[i] = g0 * g8::fsigmoid(g0) * acc[ai][1][m][0][i]; h1[i] = g1 * g8::fsigmoid(g1) * acc[ai][1][m][1][i]; }
                *(u32x4*)(dst + (size_t)lr * DEXP + wc * 32 + 8 * fq) = g8::pack8(h0, h1); }
    } };
struct SchedDown { const char *HB, *HBS, *MOEW, *SHD; const LAS int* tt; int G, c, nsh, c0;
    __device__ __forceinline__ bool get(int i, GUnit& u) const { const int L = i * G + c; const int nr = __builtin_amdgcn_readfirstlane(tt[0]) * 2;
        u.rows = nullptr; u.lda2 = 512u; u.ldb2 = 512u; u.nt = 4;
        if (L < nr) { const int rt = L >> 1, pn = L & 1, e = __builtin_amdgcn_readfirstlane(tt[1 + rt]); u.A = HB; u.arow0 = rt * 256; u.B = MOEW + (size_t)e * (1536 * 1024) + 1024 * 1024 + (size_t)(c0 + pn * 256) * 512; u.pm = rt; u.pn = pn; u.tag = 0; return true; }
        const int L2 = L - nr; if (c0 != 0 || L2 >= nsh * 4) return false;
        u.A = HBS; u.arow0 = (L2 >> 2) * 256; u.B = SHD + (size_t)(L2 & 3) * 256 * 512; u.pm = L2 >> 2; u.pn = L2 & 3; u.tag = 1; return true; } };
struct EpiDown { bf16_t* OUT; EpiResid res;
    __device__ __forceinline__ void operator()(EPI_ARGS) const {
        if (u.tag == 0) { EPI_FOR({ *(u32x4*)(OUT + (size_t)(u.pm * 256 + lr) * 512 + u.pn * 256 + lc) = g8::pack8(v0, v1); }); }
        else res(acc, u, wr, wc, fr, fq, tid);
    } };

namespace at {
typedef short bf16x8 __attribute__((ext_vector_type(8)));
typedef short s16x4 __attribute__((ext_vector_type(4)));
typedef float f32x16 __attribute__((ext_vector_type(16)));
constexpr int KSTR = 208, VSTR = 192, KBUF = 64 * KSTR, VBUF = 64 * VSTR, STAGE = KBUF + VBUF, LDS_WSF = 2 * STAGE;
__device__ __forceinline__ int crow(int r, int hi) { return (r & 3) + 8 * (r >> 2) + 4 * hi; }
__device__ __forceinline__ s16x4 vtr(const LAS unsigned char* p) { return __builtin_bit_cast(s16x4, __builtin_amdgcn_ds_read_tr16_b64_v4i16((LAS s16x4*)p)); }
#define AT_BAR() do { asm volatile("s_waitcnt lgkmcnt(0)" ::: "memory"); __builtin_amdgcn_s_barrier(); asm volatile("" ::: "memory"); } while (0)
__device__ __forceinline__ void attn_unit(LAS unsigned char* lds, const bf16_t* __restrict__ Q, const bf16_t* __restrict__ K, const bf16_t* __restrict__ V, bf16_t* __restrict__ O,
                                          int h, int qrow0, int kr0, int kn0, int kr1, int kn1, int tid) {
    const int lane = tid & 63, wave = __builtin_amdgcn_readfirstlane(tid >> 6), r32 = lane & 31, hi = lane >> 5;
    const int kc0r = tid / 12, kc0c = tid % 12, kc1r = (512 + tid) / 12, kc1c = (512 + tid) % 12, vr = tid >> 3, vc = tid & 7;
    const bool k2 = tid < 256;
    const unsigned kw0 = kc0r * KSTR + kc0c * 16, kw1 = kc1r * KSTR + kc1c * 16, vw = KBUF + vr * VSTR + vc * 16;
    const int nt = kn0 + kn1;
    g8::u32x4 rk0, rk1 = {0u, 0u, 0u, 0u}, rv;
#define AT_LOAD(t) do { const int _t = (t); const int _row = _t < kn0 ? kr0 + 64 * _t : kr1 + 64 * (_t - kn0); \
        rk0 = *(const g8::u32x4*)(K + (size_t)(_row + kc0r) * 768 + h * 96 + kc0c * 8); if (k2) rk1 = *(const g8::u32x4*)(K + (size_t)(_row + kc1r) * 768 + h * 96 + kc1c * 8); \
        rv = *(const g8::u32x4*)(V + (size_t)(_row + vr) * 512 + h * 64 + vc * 8); } while (0)
#define AT_WRITE(buf) do { LAS unsigned char* _b = lds + (buf) * STAGE; *(LAS g8::u32x4*)(_b + kw0) = rk0; if (k2) *(LAS g8::u32x4*)(_b + kw1) = rk1; *(LAS g8::u32x4*)(_b + vw) = rv; } while (0)
    AT_LOAD(0);
    bf16x8 qf[6];
    { const bf16_t* qp = Q + (size_t)(qrow0 + wave * 32 + r32) * 768 + h * 96 + hi * 8;
#pragma unroll
      for (int d0 = 0; d0 < 6; ++d0) qf[d0] = *(const bf16x8*)(qp + d0 * 16); }
    AT_WRITE(0);
    if (nt > 1) AT_LOAD(1);
    AT_BAR();
    f32x16 o0 = {}, o1 = {}; float lsum = 0.f;
    const unsigned kroff = r32 * KSTR + hi * 16;
    const unsigned vroff = KBUF + (4 * hi + ((lane & 15) >> 2)) * VSTR + ((lane >> 4) & 1) * 32 + (lane & 3) * 8;
    for (int t = 0; t < nt; ++t) {
        const LAS unsigned char* sb = lds + (t & 1) * STAGE;
        f32x16 p0 = {}, p1 = {};
#pragma unroll
        for (int d0 = 0; d0 < 6; ++d0) {
            const bf16x8 a0 = *(const LAS bf16x8*)(sb + kroff + d0 * 32), a1 = *(const LAS bf16x8*)(sb + kroff + 32 * KSTR + d0 * 32);
            p0 = __builtin_amdgcn_mfma_f32_32x32x16_bf16(a0, qf[d0], p0, 0, 0, 0);
            p1 = __builtin_amdgcn_mfma_f32_32x32x16_bf16(a1, qf[d0], p1, 0, 0, 0);
        }
        float s = 0.f;
#pragma unroll
        for (int r = 0; r < 16; ++r) { p0[r] = __builtin_amdgcn_exp2f(p0[r]); p1[r] = __builtin_amdgcn_exp2f(p1[r]); s += p0[r] + p1[r]; }
        lsum += s;
        bf16x8 pa[4];
#pragma unroll
        for (int ks = 0; ks < 4; ++ks) { unsigned w[4];
#pragma unroll
            for (int j = 0; j < 4; ++j) { const int r = 8 * (ks & 1) + 2 * j; w[j] = (ks < 2) ? g8::cvtpk(p0[r], p0[r + 1]) : g8::cvtpk(p1[r], p1[r + 1]); }
            pa[ks] = __builtin_bit_cast(bf16x8, (g8::u32x4){w[0], w[1], w[2], w[3]}); }
#pragma unroll
        for (int ks = 0; ks < 4; ++ks) {
#pragma unroll
            for (int d0 = 0; d0 < 2; ++d0) {
                const s16x4 lo = vtr(sb + vroff + (16 * ks) * VSTR + d0 * 64), hh = vtr(sb + vroff + (16 * ks + 8) * VSTR + d0 * 64);
                const bf16x8 vf = (bf16x8){lo[0], lo[1], lo[2], lo[3], hh[0], hh[1], hh[2], hh[3]};
                if (d0 == 0) o0 = __builtin_amdgcn_mfma_f32_32x32x16_bf16(pa[ks], vf, o0, 0, 0, 0); else o1 = __builtin_amdgcn_mfma_f32_32x32x16_bf16(pa[ks], vf, o1, 0, 0, 0);
            }
        }
        if (t + 1 < nt) { AT_WRITE((t + 1) & 1); if (t + 2 < nt) AT_LOAD(t + 2); }
        AT_BAR();
    }
    lsum += __shfl_xor(lsum, 32);
    LAS float* wsf = (LAS float*)(lds + LDS_WSF) + wave * 32;
    if (hi == 0) wsf[r32] = lsum;
    asm volatile("s_waitcnt lgkmcnt(0)" ::: "memory");
    bf16_t* op = O + (size_t)(qrow0 + wave * 32) * 512 + h * 64 + r32;
#pragma unroll
    for (int r = 0; r < 16; ++r) { const int q = crow(r, hi); const float rl = 1.0f / wsf[q];
        op[(size_t)q * 512] = (bf16_t)f2bf(o0[r] * rl); op[(size_t)q * 512 + 32] = (bf16_t)f2bf(o1[r] * rl); }
    AT_BAR();
#undef AT_LOAD
#undef AT_WRITE
}
#undef AT_BAR
}

namespace rt {
using at::bf16x8; using at::s16x4; using at::f32x16; using at::crow; using at::vtr;
constexpr int TSTR = 320;
constexpr int KSTR2 = 272;
constexpr size_t SLOT = 32768;
__device__ __forceinline__ bf16_t* slot_ptr(bf16_t* ST, int dir, int bh, int c) { return ST + ((size_t)((dir * 16 + bh) * 66 + c)) * 16384; }
__device__ __forceinline__ float log2_decay(const float* dec, int l, int h) { const float x = dec[l * 4 + h]; return -log1pf(expf(-x)) * 1.4426950408889634f; }
#define RT_BAR() do { asm volatile("s_waitcnt vmcnt(0) lgkmcnt(0)" ::: "memory"); __builtin_amdgcn_s_barrier(); asm volatile("" ::: "memory"); } while (0)
__device__ __forceinline__ g8::u32x4 scale8(const g8::u32x4& w, float s) { g8::f32x4 a, b; g8::unpack8(w, a, b); return g8::pack8(a * s, b * s); }
__device__ __forceinline__ bf16x8 tr_frag(const LAS unsigned char* tile, int k0, int cb, int lane) {
    const int hi = lane >> 5, q = (lane & 15) >> 2, p = lane & 3, g1 = (lane >> 4) & 1;
    const LAS unsigned char* a = tile + (k0 + 8 * hi + q) * TSTR + (cb * 32 + 16 * g1 + 4 * p) * 2;
    const s16x4 lo = vtr(a), hh = vtr(a + 4 * TSTR);
    return (bf16x8){lo[0], lo[1], lo[2], lo[3], hh[0], hh[1], hh[2], hh[3]};
}
__device__ __forceinline__ bf16x8 tr_frag_perm(const LAS unsigned char* tile, int k0, int cb, int lane) {
    const int hi = lane >> 5, q = (lane & 15) >> 2, p = lane & 3, g1 = (lane >> 4) & 1;
    const LAS unsigned char* a = tile + (k0 + 4 * hi + q) * TSTR + (cb * 32 + 16 * g1 + 4 * p) * 2;
    const s16x4 lo = vtr(a), hh = vtr(a + 8 * TSTR);
    return (bf16x8){lo[0], lo[1], lo[2], lo[3], hh[0], hh[1], hh[2], hh[3]};
}
__device__ __forceinline__ void chunk_kv_unit(LAS unsigned char* lds, const bf16_t* RET, bf16_t* ST, float lf, float lb, int bh, int c, int tid) {
    const int lane = tid & 63, wave = __builtin_amdgcn_readfirstlane(tid >> 6), b = bh >> 2, h = bh & 3;
    const int r0 = c < 2 ? ML + b * CTX + c * 128 : b * SEQ + (c - 2) * 128;
    LAS unsigned char* Kf = lds; LAS unsigned char* Kb = lds + 128 * TSTR; LAS unsigned char* Vt = lds + 2 * 128 * TSTR;
#pragma unroll
    for (int i = 0; i < 4; ++i) { const int ch = tid + i * 512, row = ch >> 4, cc = ch & 15;
        const g8::u32x4 kv = *(const g8::u32x4*)(RET + (size_t)(r0 + row) * 2048 + 512 + h * 128 + cc * 8), vv = *(const g8::u32x4*)(RET + (size_t)(r0 + row) * 2048 + 1024 + h * 128 + cc * 8);
        *(LAS g8::u32x4*)(Kf + row * TSTR + cc * 16) = scale8(kv, __builtin_amdgcn_exp2f(lf * (float)(127 - row)));
        *(LAS g8::u32x4*)(Kb + row * TSTR + cc * 16) = scale8(kv, __builtin_amdgcn_exp2f(lb * (float)row));
        *(LAS g8::u32x4*)(Vt + row * TSTR + cc * 16) = vv; }
    RT_BAR();
    const int dir = wave >> 2, db = wave & 3; const LAS unsigned char* Kt = dir ? Kb : Kf;
    f32x16 acc[4] = {};
#pragma unroll
    for (int s = 0; s < 8; ++s) { const bf16x8 a = tr_frag(Kt, 16 * s, db, lane);
#pragma unroll
        for (int vb = 0; vb < 4; ++vb) acc[vb] = __builtin_amdgcn_mfma_f32_32x32x16_bf16(a, tr_frag(Vt, 16 * s, vb, lane), acc[vb], 0, 0, 0); }
    bf16_t* dst = slot_ptr(ST, dir, bh, c) + (lane & 31);
#pragma unroll
    for (int vb = 0; vb < 4; ++vb)
#pragma unroll
        for (int r = 0; r < 16; ++r) dst[(size_t)(32 * db + crow(r, lane >> 5)) * 128 + vb * 32] = (bf16_t)f2bf(acc[vb][r]);
    RT_BAR();
}
__device__ __forceinline__ void scan_states(bf16_t* ST, const float* decf, const float* decb, int l, int gtid, int gsize) {
    for (int v = gtid; v < 2 * 16 * 2048; v += gsize) {
        const int dir = v >> 15, bh = (v >> 11) & 15, e = v & 2047, h = bh & 3;
        const float cdec = __builtin_amdgcn_exp2f(128.0f * log2_decay(dir ? decb : decf, l, h));
        g8::u32x4* base = (g8::u32x4*)slot_ptr(ST, dir, bh, 0) + e;
        g8::f32x4 s0, s1, a0, a1, b0, b1;
        g8::unpack8(base[0], a0, a1); g8::unpack8(base[2048], b0, b1);
        if (dir == 0) { s0 = a0 * cdec + b0; s1 = a1 * cdec + b1; } else { s0 = a0 + b0 * cdec; s1 = a1 + b1 * cdec; }
#pragma unroll 4
        for (int n = 0; n < 64; ++n) { g8::u32x4* p = base + (size_t)(2 + (dir ? 63 - n : n)) * 2048; g8::f32x4 k0, k1; g8::unpack8(*p, k0, k1);
            *p = g8::pack8(s0, s1); s0 = s0 * cdec + k0; s1 = s1 * cdec + k1; }
    }
}
__device__ __forceinline__ void chunk_out_unit(LAS unsigned char* lds, bf16_t* RET, const bf16_t* ST, const float* gng, const float* gnb, float lf, float lb, int bh, int c, int tid) {
    const int lane = tid & 63, wave = __builtin_amdgcn_readfirstlane(tid >> 6), r32 = lane & 31, hi = lane >> 5, b = bh >> 2, h = bh & 3;
    const int r0 = c < 2 ? ML + b * CTX + c * 128 : b * SEQ + (c - 2) * 128;
    const int qb = wave & 3, dvh = wave >> 2;
    LAS unsigned char* Kt = lds; LAS unsigned char* Vt = lds + 128 * KSTR2; LAS unsigned char* St = Vt + 128 * TSTR;
    const bool has_f = (c != 0), has_b = (c != 1);
    const bf16_t* sf = slot_ptr((bf16_t*)ST, 0, bh, c == 1 ? 0 : c); const bf16_t* sb = slot_ptr((bf16_t*)ST, 1, bh, c == 0 ? 1 : c);
#pragma unroll
    for (int i = 0; i < 4; ++i) { const int ch = tid + i * 512, row = ch >> 4, cc = ch & 15;
        *(LAS g8::u32x4*)(Kt + row * KSTR2 + cc * 16) = *(const g8::u32x4*)(RET + (size_t)(r0 + row) * 2048 + 512 + h * 128 + cc * 8);
        *(LAS g8::u32x4*)(Vt + row * TSTR + cc * 16) = *(const g8::u32x4*)(RET + (size_t)(r0 + row) * 2048 + 1024 + h * 128 + cc * 8);
        if (has_f) *(LAS g8::u32x4*)(St + row * TSTR + cc * 16) = *(const g8::u32x4*)(sf + (size_t)row * 128 + cc * 8); }
    bf16x8 qf[8];
    { const bf16_t* qp = RET + (size_t)(r0 + qb * 32 + r32) * 2048 + h * 128 + hi * 8;
#pragma unroll
      for (int d0 = 0; d0 < 8; ++d0) qf[d0] = *(const bf16x8*)(qp + d0 * 16); }
    RT_BAR();
    f32x16 o[2] = {}, af[2] = {}, ab[2] = {};
    const int iq = qb * 32 + r32;
#pragma unroll
    for (int kt = 0; kt < 2; ++kt) {
        f32x16 p0 = {}, p1 = {};
#pragma unroll
        for (int d0 = 0; d0 < 8; ++d0) {
            const bf16x8 a0 = *(const LAS bf16x8*)(Kt + (64 * kt + r32) * KSTR2 + d0 * 32 + hi * 16), a1 = *(const LAS bf16x8*)(Kt + (64 * kt + 32 + r32) * KSTR2 + d0 * 32 + hi * 16);
            p0 = __builtin_amdgcn_mfma_f32_32x32x16_bf16(a0, qf[d0], p0, 0, 0, 0);
            p1 = __builtin_amdgcn_mfma_f32_32x32x16_bf16(a1, qf[d0], p1, 0, 0, 0);
        }
#pragma unroll
        for (int r = 0; r < 16; ++r) { const int j0 = 64 * kt + crow(r, hi), d0_ = iq - j0, d1_ = d0_ - 32;
            p0[r] *= __builtin_amdgcn_exp2f(d0_ >= 0 ? lf * (float)d0_ : lb * (float)(-d0_));
            p1[r] *= __builtin_amdgcn_exp2f(d1_ >= 0 ? lf * (float)d1_ : lb * (float)(-d1_)); }
        bf16x8 pa[4];
#pragma unroll
        for (int ks = 0; ks < 4; ++ks) { unsigned w[4];
#pragma unroll
            for (int j = 0; j < 4; ++j) { const int r = 8 * (ks & 1) + 2 * j; w[j] = (ks < 2) ? g8::cvtpk(p0[r], p0[r + 1]) : g8::cvtpk(p1[r], p1[r + 1]); }
            pa[ks] = __builtin_bit_cast(bf16x8, (g8::u32x4){w[0], w[1], w[2], w[3]}); }
#pragma unroll
        for (int ks = 0; ks < 4; ++ks)
#pragma unroll
            for (int d0 = 0; d0 < 2; ++d0) o[d0] = __builtin_amdgcn_mfma_f32_32x32x16_bf16(pa[ks], tr_frag_perm(Vt, 64 * kt + 16 * ks, dvh * 2 + d0, lane), o[d0], 0, 0, 0);
    }
    if (has_f) {
#pragma unroll
        for (int s = 0; s < 8; ++s)
#pragma unroll
            for (int d0 = 0; d0 < 2; ++d0) af[d0] = __builtin_amdgcn_mfma_f32_32x32x16_bf16(qf[s], tr_frag(St, 16 * s, dvh * 2 + d0, lane), af[d0], 0, 0, 0);
    }
    RT_BAR();
    if (has_b) {
#pragma unroll
        for (int i = 0; i < 4; ++i) { const int ch = tid + i * 512, row = ch >> 4, cc = ch & 15;
            *(LAS g8::u32x4*)(St + row * TSTR + cc * 16) = *(const g8::u32x4*)(sb + (size_t)row * 128 + cc * 8); }
    }
    RT_BAR();
    if (has_b) {
#pragma unroll
        for (int s = 0; s < 8; ++s)
#pragma unroll
            for (int d0 = 0; d0 < 2; ++d0) ab[d0] = __builtin_amdgcn_mfma_f32_32x32x16_bf16(qf[s], tr_frag(St, 16 * s, dvh * 2 + d0, lane), ab[d0], 0, 0, 0);
    }
    LAS float* Ot = (LAS float*)lds;
#pragma unroll
    for (int r = 0; r < 16; ++r) { const int i = qb * 32 + crow(r, hi); const float qdf = __builtin_amdgcn_exp2f(lf * (float)(i + 1)), qdb = __builtin_amdgcn_exp2f(lb * (float)(128 - i));
#pragma unroll
        for (int d0 = 0; d0 < 2; ++d0) Ot[i * 132 + dvh * 64 + d0 * 32 + r32] = o[d0][r] + qdf * af[d0][r] + qdb * ab[d0][r]; }
    RT_BAR();
    { const int row = tid >> 2, qt = tid & 3; const LAS float* op = Ot + row * 132 + qt * 32; float v[32]; float s = 0.f;
#pragma unroll
      for (int j = 0; j < 32; ++j) { v[j] = op[j]; s += v[j]; }
      s += __shfl_xor(s, 1); s += __shfl_xor(s, 2); const float mu = s * (1.0f / 128.f); float q = 0.f;
#pragma unroll
      for (int j = 0; j < 32; ++j) { v[j] -= mu; q += v[j] * v[j]; }
      q += __shfl_xor(q, 1); q += __shfl_xor(q, 2); const float rstd = 1.0f / sqrtf(q * (1.0f / 128.f) + EPS);
      bf16_t* rowp = RET + (size_t)(r0 + row) * 2048 + h * 128 + qt * 32; const float* gg = gng + h * 128 + qt * 32; const float* gb = gnb + h * 128 + qt * 32;
#pragma unroll
      for (int j8 = 0; j8 < 4; ++j8) { g8::f32x4 g0, g1; g8::unpack8(*(const g8::u32x4*)(rowp + 1536 + j8 * 8), g0, g1); g8::f32x4 y0, y1;
#pragma unroll
          for (int j = 0; j < 4; ++j) { const float ga = g0[j], gb_ = g1[j];
              y0[j] = ga * g8::fsigmoid(ga) * (v[j8 * 8 + j] * rstd * gg[j8 * 8 + j] + gb[j8 * 8 + j]);
              y1[j] = gb_ * g8::fsigmoid(gb_) * (v[j8 * 8 + 4 + j] * rstd * gg[j8 * 8 + 4 + j] + gb[j8 * 8 + 4 + j]); }
          *(g8::u32x4*)(rowp + j8 * 8) = g8::pack8(y0, y1); } }
    RT_BAR();
}
__device__ __forceinline__ void gmlp_unit(LAS unsigned char* lds, bf16_t* UV, const float* ws, const float* bs, int cidx, int g, int tid) {
    const int lane = tid & 63, wave = __builtin_amdgcn_readfirstlane(tid >> 6), r32 = lane & 31, hi = lane >> 5, r0 = cidx * 128;
    LAS unsigned char* Wt = lds; LAS unsigned char* Vt = lds + 128 * KSTR2;
#pragma unroll
    for (int i = 0; i < 4; ++i) { const int ch = tid + i * 512, row = ch >> 4, cc = ch & 15;
        const g8::f32x4 w0 = *(const g8::f32x4*)(ws + row * 128 + cc * 8), w1 = *(const g8::f32x4*)(ws + row * 128 + cc * 8 + 4);
        *(LAS g8::u32x4*)(Wt + row * KSTR2 + cc * 16) = g8::pack8(w0, w1);
        *(LAS g8::u32x4*)(Vt + row * TSTR + cc * 16) = *(const g8::u32x4*)(UV + (size_t)(r0 + row) * 1024 + 512 + g * 128 + cc * 8); }
    RT_BAR();
    const int ib = wave & 3, cb0 = (wave >> 2) * 2;
    f32x16 acc[2] = {};
#pragma unroll
    for (int s = 0; s < 8; ++s) { const bf16x8 a = *(const LAS bf16x8*)(Wt + (32 * ib + r32) * KSTR2 + s * 32 + hi * 16);
#pragma unroll
        for (int d0 = 0; d0 < 2; ++d0) acc[d0] = __builtin_amdgcn_mfma_f32_32x32x16_bf16(a, tr_frag(Vt, 16 * s, cb0 + d0, lane), acc[d0], 0, 0, 0); }
#pragma unroll
    for (int r = 0; r < 16; ++r) { const int i = 32 * ib + crow(r, hi); const float bi = bs[i];
#pragma unroll
        for (int d0 = 0; d0 < 2; ++d0) { bf16_t* up = UV + (size_t)(r0 + i) * 1024 + g * 128 + (cb0 + d0) * 32 + r32; *up = (bf16_t)f2bf(bf2f(*up) * (acc[d0][r] + bi)); } }
    RT_BAR();
}
#undef RT_BAR
}

constexpr int LDS_TT = 131072;
__device__ __forceinline__ const char* smw(const Frame& F, int l, size_t off) { return (const char*)(ws_(F.A) + WS_WSM + (size_t)l * SMW_L + off); }
__device__ __forceinline__ void p_inproj_fast(Frame& F, int l) {
    SchedInproj S{(const char*)F_H, smw(F, l, SMW_WIN), F.G, F.bid}; EpiInproj E{F_RET, F_CQ, F_CKV, F_KR, F_UV};
    g8::gemm_phase<false>((LAS unsigned char*)F.lds, S, E, F.tid);
}
__device__ __forceinline__ void p_mlaup_fast(Frame& F, int l) {
    SchedMlaUp S{(const char*)F_CQ, (const char*)F_CKV, smw(F, l, SMW_WUQ), smw(F, l, SMW_WUKV), F.G, F.bid}; EpiMlaUp E{F_Q, F_KVR};
    g8::gemm_phase<false>((LAS unsigned char*)F.lds, S, E, F.tid);
}
template <int BR> __device__ __forceinline__ void p_merge_br(Frame& F, int l, int nrows) {
    const char* abr = BR == 0 ? (const char*)F_RET : (BR == 1 ? (const char*)F_AO : (const char*)F_UV);
    SchedMerge S{(const char*)F_H, smw(F, l, SMW_WG) + (size_t)BR * 1024 * 2048, abr, smw(F, l, SMW_WBR) + (size_t)BR * 1024 * 1024, BR == 0 ? 4096u : (BR == 1 ? 1024u : 2048u), F.G, F.bid, nrows / 256};
    EpiMerge<BR> E{F_Y, (u32x4*)(ws_(F.A) + WS_SCR + (size_t)F.bid * 131072)};
    g8::gemm_phase<false>((LAS unsigned char*)F.lds, S, E, F.tid);
}
__device__ __forceinline__ void p_merge_fast(Frame& F, int l, int nrows) {
    p_merge_br<0>(F, l, nrows); asm volatile("" : "+v"(F.tid));
    p_merge_br<1>(F, l, nrows); asm volatile("" : "+v"(F.tid));
    p_merge_br<2>(F, l, nrows);
}
__device__ __forceinline__ void p_out_fast(Frame& F, int l, int nrows) {
    SchedOut S{(const char*)F_Y, smw(F, l, SMW_WOUT), F.G, F.bid, nrows / 256};
    EpiResid E{l == 0 ? FIN(I_X) : F_out, F_out, F_XC, F_MOD + (size_t)l * 5 * 6144 + 2 * D};
    g8::gemm_phase<false>((LAS unsigned char*)F.lds, S, E, F.tid);
}
__device__ __forceinline__ void p_gateup_fast(Frame& F, int l, int ntok) {
    LAS int* tt = (LAS int*)((LAS unsigned char*)F.lds + LDS_TT); moe_tiles(F, l, tt);
    SchedGateUp S{(const char*)F_H, (const char*)(ws_(F.A) + WS_MOEW), smw(F, l, SMW_SHGU), F_ROWTOK, tt, F.G, F.bid, ntok / 256}; EpiGateUp E{F_HB, F_HBS};
    g8::gemm_phase<true>((LAS unsigned char*)F.lds, S, E, F.tid);
}
__device__ __forceinline__ void p_down_fast(Frame& F, int l, int ntok, int c0) {
    LAS int* tt = (LAS int*)((LAS unsigned char*)F.lds + LDS_TT); moe_tiles(F, l, tt);
    SchedDown S{(const char*)F_HB, (const char*)F_HBS, (const char*)(ws_(F.A) + WS_MOEW), smw(F, l, SMW_SHD), tt, F.G, F.bid, ntok / 256, c0};
    EpiDown E{F_OUT, EpiResid{F_out, F_out, F_XC, F_MOD + (size_t)l * 5 * 6144 + 5 * D}};
    g8::gemm_phase<false>((LAS unsigned char*)F.lds, S, E, F.tid);
}
#ifndef FAST_INPROJ
#define FAST_INPROJ 1
#endif
#ifndef FAST_MLAUP
#define FAST_MLAUP 1
#endif
#ifndef FAST_MERGE
#define FAST_MERGE 1
#endif
#ifndef FAST_OUT
#define FAST_OUT 1
#endif
#ifndef FAST_MOE
#define FAST_MOE 1
#endif
#ifndef FAST_ATTN
#define FAST_ATTN 1
#endif
#ifndef FAST_RET
#define FAST_RET 1
#endif

constexpr int NPL = 16;
constexpr int NPH = 1 + DEPTH * NPL;
__global__ void __launch_bounds__(NTHR, 2) fwd_kernel(Args args) {
    extern __shared__ __attribute__((aligned(16))) unsigned char lds[];
    Frame F;
    F.lds = lds; F.tid = threadIdx.x; F.lane = F.tid & 63; F.wave = __builtin_amdgcn_readfirstlane(F.tid >> 6); F.G = gridDim.x; F.bid = blockIdx.x;
    F.A = &args;
    volatile LAS unsigned* MISC = (volatile LAS unsigned*)((LAS unsigned char*)lds + MISC_OFF);
    if (F.tid < 32) MISC[F.tid] = 0u;
    __syncthreads();
    const int lo = args.ph_lo, hi = args.ph_hi;
    XcdBarrier bar; bar.bar = F_ctl + CW_BAR; bar.x = 0; bar.st = nullptr;
    if (hi - lo > 1) bar = xcd_barrier_post(F_ctl + CW_BAR, MISC + 8);
#define REFRESH() do { asm volatile("" : "+v"(F.tid)); F.lane = F.tid & 63; F.wave = __builtin_amdgcn_readfirstlane(F.tid >> 6); } while (0)
#define IN(k) (lo <= (k) && (k) < hi)
#define SEAM(k) do { if (lo <= (k) && (k) + 1 < hi) xcd_barrier(bar); REFRESH(); } while (0)

    if (IN(0)) { p_prologue(F); p_cvt_small(F); } SEAM(0);
    for (int l = 0; l < DEPTH; ++l) {
        const int pb = 1 + l * NPL;
        const int nrows_mix = (l == 0) ? M : ML;
        if (IN(pb + 0)) { p_norm(F, l, 0, M); } SEAM(pb + 0);
        if (IN(pb + 1)) { if (FAST_INPROJ) p_inproj_fast(F, l); else p_inproj_naive(F, l); } SEAM(pb + 1);
        if (IN(pb + 2)) { p_rowpass_a(F, l);
#if FAST_RET
            { const float* decf = FIN(I_DECF); const float* decb = FIN(I_DECB);
              for (int u = F.bid; u < 16 * 66; u += F.G) { const int bh = u / 66, c = u % 66;
                  rt::chunk_kv_unit((LAS unsigned char*)F.lds, F_RET, F_ST, rt::log2_decay(decf, l, bh & 3), rt::log2_decay(decb, l, bh & 3), bh, c, F.tid); } }
#endif
        } SEAM(pb + 2);
        if (IN(pb + 3)) {
#if FAST_RET
            if (F.tid < 256) rt::scan_states(F_ST, FIN(I_DECF), FIN(I_DECB), l, F.bid * 256 + F.tid, F.G * 256);
            __syncthreads();
#endif
            if (FAST_MLAUP) p_mlaup_fast(F, l); else p_mlaup_naive(F, l); } SEAM(pb + 3);
        if (IN(pb + 4)) { p_rowpass_b(F, l); } SEAM(pb + 4);
        if (IN(pb + 5)) {
#if FAST_ATTN
            {
                const int vcu = (F.G % 8 == 0) ? (F.bid % 8) * (F.G / 8) + F.bid / 8 : F.bid;
                for (int u = vcu; u < NB * 8 * 32; u += F.G) {
                    const int bh = (u & 255) >> 3, qb = (u & 7) + 8 * (u >> 8), b = bh >> 3, h = bh & 7;
                    at::attn_unit((LAS unsigned char*)F.lds, F_Q, F_K, F_V, F_AO, h, b * SEQ + qb * 256, ML + b * CTX, CTX / 64, b * SEQ, SEQ / 64, F.tid); }
                if (l == 0 && F.bid < NB * 8) { const int b = F.bid >> 3, h = F.bid & 7;
                    at::attn_unit((LAS unsigned char*)F.lds, F_Q, F_K, F_V, F_AO, h, ML + b * CTX, ML + b * CTX, CTX / 64, 0, 0, F.tid); }
            }
#else
            const int nu_att = NB * 8 * 256 + (l == 0 ? NB * 8 * 8 : 0);
            for (int u = F.bid; u < nu_att; u += F.G) {
                if (u < NB * 8 * 256) { const int qt = u & 255, h = (u >> 8) & 7, b = u >> 11; attn_unit_naive(F, h, b * SEQ + qt * 32, ML + b * CTX, CTX, b * SEQ, SEQ); }
                else { const int v = u - NB * 8 * 256; const int qt = v & 7, h = (v >> 3) & 7, b = v >> 6; attn_unit_naive(F, h, ML + b * CTX + qt * 32, ML + b * CTX, CTX, 0, 0); }
            }
#endif
#if FAST_RET
            { const float* decf = FIN(I_DECF); const float* decb = FIN(I_DECB); const float* gng = FIN(I_GNG) + l * 512; const float* gnb = FIN(I_GNB) + l * 512;
              for (int u = F.bid; u < 16 * 66; u += F.G) { const int bh = u / 66, c = u % 66; if (c < 2 && l != 0) continue;
                  rt::chunk_out_unit((LAS unsigned char*)F.lds, F_RET, F_ST, gng, gnb, rt::log2_decay(decf, l, bh & 3), rt::log2_decay(decb, l, bh & 3), bh, c, F.tid); }
              const int nch = nrows_mix / 128;
              for (int u = F.bid; u < nch * 4; u += F.G) { const int g = u & 3; rt::gmlp_unit((LAS unsigned char*)F.lds, F_UV, FIN(I_GWS) + ((size_t)l * 4 + g) * 128 * 128, FIN(I_GBS) + (l * 4 + g) * 128, u >> 2, g, F.tid); } }
#else
            const int nu_ret = NB * 4 * 256 + (l == 0 ? NB * 4 * 8 : 0);
            for (int u = F.bid; u < nu_ret; u += F.G) {
                if (u < NB * 4 * 256) { const int qt = u & 255, h = (u >> 8) & 3, b = u >> 10; ret_unit_naive(F, l, b, h, qt * 32, false); }
                else { const int v = u - NB * 4 * 256; const int qt = v & 7, h = (v >> 3) & 3, b = v >> 5; ret_unit_naive(F, l, b, h, qt * 32, true); }
            }
            const int nch = nrows_mix / 128;
            for (int u = F.bid; u < nch * 4; u += F.G) gmlp_unit_naive(F, l, u >> 2, u & 3);
#endif
        } SEAM(pb + 5);
        if (IN(pb + 6)) { if (FAST_MERGE) p_merge_fast(F, l, nrows_mix); else p_merge_naive(F, l, nrows_mix); } SEAM(pb + 6);
        if (IN(pb + 7)) { if (FAST_OUT) p_out_fast(F, l, nrows_mix); else p_out_naive(F, l, nrows_mix); if (FAST_MOE) p_cvt_moe(F, l); } SEAM(pb + 7);
        if (IN(pb + 8)) { p_norm(F, l, 1, nrows_mix); } SEAM(pb + 8);
        if (IN(pb + 9)) { p_router(F, l, nrows_mix); } SEAM(pb + 9);
        if (IN(pb + 10)) { p_scatter(F, l, nrows_mix); } SEAM(pb + 10);
        if (IN(pb + 11)) { if (FAST_MOE) p_gateup_fast(F, l, nrows_mix); else p_moe_gateup_naive(F, l, nrows_mix); } SEAM(pb + 11);
        if (IN(pb + 12)) { if (FAST_MOE) p_down_fast(F, l, nrows_mix, 0); else p_moe_down_naive(F, l, nrows_mix, 0); } SEAM(pb + 12);
        if (IN(pb + 13)) { p_combine(F, l, nrows_mix, 0); } SEAM(pb + 13);
        if (IN(pb + 14)) { if (FAST_MOE) p_down_fast(F, l, nrows_mix, 512); else p_moe_down_naive(F, l, nrows_mix, 512); } SEAM(pb + 14);
        if (IN(pb + 15)) { p_combine(F, l, nrows_mix, 512); } SEAM(pb + 15);
    }
#undef IN
#undef SEAM
}

#ifndef MK_PER_PHASE
#define MK_PER_PHASE 0
#endif
extern "C" void kernel_launch(void* const* d_in, const int* in_sizes, int n_in, void* d_out, int out_size, void* d_ws, size_t ws_size, hipStream_t stream) {
    static int grid = 0;
    if (grid == 0) {
        if (n_in != 36 || out_size != ML * D || ws_size < WS_END) { fprintf(stderr, "kernel_launch: unexpected problem (n_in %d out %d ws %zu)\n", n_in, out_size, ws_size); grid = -1; return; }
        int dev = 0, cus = 0;
        if (hipGetDevice(&dev) != hipSuccess || hipDeviceGetAttribute(&cus, hipDeviceAttributeMultiprocessorCount, dev) != hipSuccess) { grid = -1; return; }
        if (hipFuncSetAttribute((const void*)fwd_kernel, hipFuncAttributeMaxDynamicSharedMemorySize, LDS_BYTES) != hipSuccess) { fprintf(stderr, "kernel_launch: hipFuncSetAttribute failed\n"); grid = -1; return; }
        int per_cu = 0;
        if (hipOccupancyMaxActiveBlocksPerMultiprocessor(&per_cu, (const void*)fwd_kernel, NTHR, LDS_BYTES) != hipSuccess || per_cu < 1) fprintf(stderr, "kernel_launch: occupancy query says %d\n", per_cu);
        (void)hipGetLastError();
        grid = cus > 256 ? 256 : cus;
    }
    if (grid < 0) return;
    (void)hipMemsetAsync((char*)d_ws + WS_CTL, 0, CTL_ZERO_BYTES, stream);
    Args a{};
    for (int i = 0; i < 36; ++i) a.in[i] = (const float*)d_in[i];
    a.out = (float*)d_out; a.ws = (unsigned char*)d_ws;
#if MK_PER_PHASE
    for (int p = 0; p < NPH; ++p) { a.ph_lo = p; a.ph_hi = p + 1; hipLaunchKernelGGL(fwd_kernel, dim3(grid), dim3(NTHR), LDS_BYTES, stream, a); }
#else
    a.ph_lo = 0; a.ph_hi = NPH; hipLaunchKernelGGL(fwd_kernel, dim3(grid), dim3(NTHR), LDS_BYTES, stream, a);
#endif
}
```

```cpp
#include <hip/hip_runtime.h>
#include <cstdio>
#include <cstdint>

constexpr int D = 1024, NB = 4, SEQ = 8192, CTX = 256, DEPTH = 2;
constexpr int ML = NB * SEQ;
constexpr int MC = NB * CTX;
constexpr int M = ML + MC;
constexpr int N_IN = 6816, OFF_CQ = 2048, OFF_CKV = 2432, OFF_KR = 2688, OFF_UV = 2720, OFF_MERGE = 3744;
constexpr int NEXP = 64, TOPK = 6, DEXP = 256;
constexpr int APAD = 219136;
constexpr float EPS = 1e-6f;
#ifndef FAST_ROUTER
#define FAST_ROUTER 1
#endif
#ifndef ATTN_NS
#define ATTN_NS at16
#endif
#ifndef REP_ATTN
#define REP_ATTN 1
#endif
#ifndef REP_R3
#define REP_R3 1
#endif
#ifndef REP_GMLP
#define REP_GMLP 1
#endif
#ifndef REP_NORM1
#define REP_NORM1 1
#endif
#ifndef REP_CVTMOE
#define REP_CVTMOE 1
#endif
#ifndef REP_R1
#define REP_R1 1
#endif
#ifndef REP_PRO
#define REP_PRO 1
#endif
#ifndef REP_MERGE
#define REP_MERGE 1
#endif
#ifndef REP_GATEUP
#define REP_GATEUP 1
#endif
#ifndef REP_MLAUP
#define REP_MLAUP 1
#endif
#ifndef REP_DOWN1
#define REP_DOWN1 1
#endif
#ifndef REP_INPROJ
#define REP_INPROJ 1
#endif
#ifndef REP_NORM2
#define REP_NORM2 1
#endif
#ifndef REP_ROUTER
#define REP_ROUTER 1
#endif
constexpr float QSCALE = 0.14724649622f;

constexpr size_t MiB = 1u << 20;
constexpr size_t WS_CTL = 0, CTL_ZERO_BYTES = 1 * MiB;
constexpr size_t WS_MOD = 1 * MiB;
constexpr size_t WS_ROPE = 2 * MiB;
constexpr size_t WS_XC = 4 * MiB;
constexpr size_t WS_IDX = 8 * MiB;
constexpr size_t WS_WTS = 9 * MiB;
constexpr size_t WS_SLOT = 10 * MiB;
constexpr size_t WS_INV = 11 * MiB;
constexpr size_t WS_ROWTOK = 12 * MiB;
constexpr size_t WS_BLKBASE = 13 * MiB;
constexpr size_t WS_WSM = 14 * MiB;
constexpr size_t SMW_WIN = 0, SMW_WG = SMW_WIN + (size_t)3840 * 2048, SMW_WUQ = SMW_WG + (size_t)3072 * 2048, SMW_WUKV = SMW_WUQ + (size_t)1024 * 768,
                 SMW_WBR = SMW_WUKV + (size_t)1024 * 512, SMW_WOUT = SMW_WBR + (size_t)3 * 1024 * 1024, SMW_SHGU = SMW_WOUT + (size_t)1024 * 2048,
                 SMW_SHD = SMW_SHGU + (size_t)512 * 2048, SMW_RT = SMW_SHD + (size_t)1024 * 512, SMW_L = SMW_RT + (size_t)2 * 64 * 1024 * 2;
static_assert(WS_WSM + 2 * SMW_L <= 60 * MiB, "small weights");
constexpr size_t WS_MOEW = 126 * MiB;
constexpr size_t WS_SCR = 566 * MiB;
constexpr size_t WS_H = 60 * MiB;
constexpr size_t WS_RET = 126 * MiB;
constexpr size_t WS_CQ = 258 * MiB;
constexpr size_t WS_CKV = WS_CQ + (size_t)M * 384 * 2;
constexpr size_t WS_KR = WS_CKV + (size_t)M * 256 * 2;
constexpr size_t WS_AO = 258 * MiB;
constexpr size_t WS_UV = 302 * MiB;
constexpr size_t WS_Q = 368 * MiB;
constexpr size_t WS_K = WS_Q + (size_t)M * 768 * 2;
constexpr size_t WS_Y = 368 * MiB;
constexpr size_t WS_V = 467 * MiB;
constexpr size_t WS_ST = 500 * MiB;
constexpr size_t WS_HB = 222 * MiB;
constexpr size_t WS_HBS = 329 * MiB;
constexpr size_t WS_OUT = 346 * MiB;
constexpr size_t WS_PART = 632 * MiB;
constexpr size_t WS_PARTV = 636 * MiB;
constexpr size_t WS_END = 642 * MiB;
static_assert(WS_KR + (size_t)M * 32 * 2 <= WS_UV && WS_K + (size_t)M * 768 * 2 <= WS_V && WS_V + (size_t)M * 512 * 2 <= WS_ST, "ws map");
static_assert(WS_HB + (size_t)APAD * 256 * 2 <= WS_HBS && WS_HBS + (size_t)M * 256 * 2 <= WS_OUT && WS_OUT + (size_t)APAD * 512 * 2 <= WS_END, "ws map moe");
constexpr int CW_BAR = 4096;
constexpr int CW_CNT = 16384;

constexpr int NWAVES = 8, NTHR = 512;
constexpr int LDS_BYTES = 147456;
constexpr int MISC_OFF = 139264;

#define LAS __attribute__((address_space(3)))
#define GAS __attribute__((address_space(1)))
typedef unsigned short bf16_t;
__device__ __forceinline__ unsigned f2bf(float f) { unsigned u = __builtin_bit_cast(unsigned, f); return (u + 0x7fffu + ((u >> 16) & 1u)) >> 16; }
__device__ __forceinline__ float bf2f(bf16_t h) { return __builtin_bit_cast(float, (unsigned)h << 16); }
__device__ __forceinline__ float sigmoidf_(float x) { return 1.0f / (1.0f + expf(-x)); }
__device__ __forceinline__ float siluf_(float x) { return x / (1.0f + expf(-x)); }
__device__ __forceinline__ float gelu_tanh(float x) { const float u = 0.7978845608028654f * (x + 0.044715f * x * x * x); return 0.5f * x * (1.0f + tanhf(u)); }
__device__ __forceinline__ float xlane32(float v, int lane) { return __builtin_bit_cast(float, __builtin_amdgcn_ds_bpermute((lane ^ 32) << 2, __builtin_bit_cast(int, v))); }
__device__ __forceinline__ int xlane32i(int v, int lane) { return __builtin_amdgcn_ds_bpermute((lane ^ 32) << 2, v); }
template <int CTRL> __device__ __forceinline__ float dppx(float v) { return __builtin_bit_cast(float, __builtin_amdgcn_update_dpp(0, __builtin_bit_cast(int, v), CTRL, 0xf, 0xf, true)); }
__device__ __forceinline__ float row16_sum(float v) { v += dppx<0xB1>(v); v += dppx<0x4E>(v); v += dppx<0x141>(v); v += dppx<0x140>(v); return v; }
__device__ __forceinline__ float wave_sum(float v) {
    v = row16_sum(v);
    const float a = __builtin_bit_cast(float, __builtin_amdgcn_readlane(__builtin_bit_cast(int, v), 0)), b = __builtin_bit_cast(float, __builtin_amdgcn_readlane(__builtin_bit_cast(int, v), 16));
    const float c = __builtin_bit_cast(float, __builtin_amdgcn_readlane(__builtin_bit_cast(int, v), 32)), d = __builtin_bit_cast(float, __builtin_amdgcn_readlane(__builtin_bit_cast(int, v), 48));
    return (a + b) + (c + d);
}

#define XB_TMO      128
#define XB_XCNT(j)  (256  + 64 * (j))
#define XB_XSUB(j)  (1280 + 64 * (j))
#define XB_XGEN(j)  (2304 + 64 * (j))
#define XB_TOP      3328
#define XB_TOPGEN   3392
#define XCD_BAR_WORDS 3456
#define XB_SPIN_CAP (1u << 22)
__device__ __forceinline__ unsigned xb_ld(unsigned* p)              { return __hip_atomic_load(p, __ATOMIC_RELAXED, __HIP_MEMORY_SCOPE_AGENT); }
__device__ __forceinline__ unsigned xb_add(unsigned* p, unsigned v) { return __hip_atomic_fetch_add(p, v, __ATOMIC_RELAXED, __HIP_MEMORY_SCOPE_AGENT); }
__device__ __forceinline__ unsigned xb_xcc_id() { return (unsigned)__builtin_amdgcn_s_getreg((3 << 11) | 20) & 0xFu; }
#define XB_SPIN(cond, bar) do { unsigned _sp = 0; while (cond) { __builtin_amdgcn_s_sleep(1); \
    if ((++_sp & 255u) == 0u) { if (xb_ld(&(bar)[XB_TMO])) break; if (_sp > XB_SPIN_CAP) { atomicAdd(&(bar)[XB_TMO], 1u); break; } } } } while (0)
struct XcdBarrier { unsigned* bar; unsigned x; volatile LAS unsigned* st; };
__device__ __forceinline__ XcdBarrier xcd_barrier_post(unsigned* bar, volatile LAS unsigned* st) {
    XcdBarrier b; b.bar = bar; b.x = xb_xcc_id(); b.st = st;
    if (threadIdx.x == 0) (void)xb_add(&bar[XB_XCNT(b.x)], 1u);
    return b;
}
__device__ __forceinline__ void xcd_barrier_complete(unsigned* bar, unsigned x, unsigned& nloc, unsigned& nx) {
    const unsigned G = gridDim.x * gridDim.y * gridDim.z;
    unsigned sum, cnt, mine, sp = 0u;
    for (;;) {
        sum = 0u; cnt = 0u; mine = 0u;
#pragma unroll
        for (unsigned j = 0; j < 16; ++j) { const unsigned c = xb_ld(&bar[XB_XCNT(j)]); sum += c; cnt += (c > 0u) ? 1u : 0u; mine = (j == x) ? c : mine; }
        if (sum == G) break;
        __builtin_amdgcn_s_sleep(1);
        if ((++sp & 255u) == 0u) { if (xb_ld(&bar[XB_TMO])) break; if (sp > XB_SPIN_CAP) { atomicAdd(&bar[XB_TMO], 1u); break; } }
    }
    nloc = mine > 0u ? mine : 1u; nx = cnt > 0u ? cnt : 1u;
}
__device__ __forceinline__ void xcd_barrier(const XcdBarrier& b, int tid) {
    asm volatile("s_waitcnt vmcnt(0)" ::: "memory");
    __syncthreads();
    if (tid == 0) {
        GAS unsigned* barg = (GAS unsigned*)b.bar; unsigned bx = b.x;
        asm volatile("" : "+s"(barg), "+s"(bx));
        unsigned* bar = (unsigned*)barg;
        __builtin_amdgcn_s_waitcnt(0);
        unsigned nloc = b.st[0], nx = b.st[1];
        if (nloc == 0u) { xcd_barrier_complete(bar, bx, nloc, nx); b.st[0] = nloc; b.st[1] = nx; }
        const unsigned old = xb_add(&bar[XB_XSUB(bx)], 1u);
        const unsigned gen = old / nloc;
        if (old + 1u == (gen + 1u) * nloc) {
            __builtin_amdgcn_fence(__ATOMIC_RELEASE, "agent");
            asm volatile("s_waitcnt vmcnt(0)" ::: "memory");
            const unsigned og = xb_add(&bar[XB_TOP], 1u);
            const unsigned tg = og / nx;
            if (og + 1u == (tg + 1u) * nx) xb_add(&bar[XB_TOPGEN], 1u);
            else XB_SPIN(xb_ld(&bar[XB_TOPGEN]) == tg, bar);
            __builtin_amdgcn_fence(__ATOMIC_ACQUIRE, "agent");
            xb_add(&bar[XB_XGEN(bx)], 1u);
            asm volatile("s_waitcnt vmcnt(0)" ::: "memory");
        } else {
            XB_SPIN(xb_ld(&bar[XB_XGEN(bx)]) == gen, bar);
            __builtin_amdgcn_fence(__ATOMIC_ACQUIRE, "agent");
            asm volatile("s_waitcnt vmcnt(0)" ::: "memory");
        }
    }
    __syncthreads();
}

struct Args {
    const float* in[36]; float* out; unsigned char* ws; int ph_lo, ph_hi;
};
enum { I_X = 0, I_C, I_CTX, I_CCTX, I_ADAW, I_ADAB, I_N1G, I_N2G, I_WIN, I_DECF, I_DECB, I_GNG, I_GNB, I_WBRRET,
       I_QAG, I_WUQ, I_KVAG, I_WUKV, I_QNG, I_KNG, I_KRG, I_WBRMLA, I_LNG, I_LNB, I_GWS, I_GBS, I_WBRG, I_WOUT,
       I_ROUTER, I_MBIAS, I_WG, I_WU, I_WD, I_SG, I_SU, I_SD };

struct Frame {
    unsigned char* lds; int tid, lane, wave, G, bid;
    const Args* A;
};
__device__ __forceinline__ unsigned long long uni64_(unsigned long long v) { const unsigned a = __builtin_amdgcn_readfirstlane((unsigned)v), b = __builtin_amdgcn_readfirstlane((unsigned)(v >> 32)); return ((unsigned long long)b << 32) | a; }
__device__ __forceinline__ const float* fin_(const Args* A, int i) { asm volatile("" : "+v"(i)); i = __builtin_amdgcn_readfirstlane(i); const GAS float* g = (const GAS float*)uni64_((unsigned long long)A->in[i]); asm volatile("" : "+s"(g)); return (const float*)g; }
#define FIN(i) fin_(F.A, (i))
__device__ __forceinline__ unsigned char* ws_(const Args* A) { GAS unsigned char* g = (GAS unsigned char*)uni64_((unsigned long long)A->ws); asm volatile("" : "+s"(g)); return (unsigned char*)g; }
#define FWS(T, off) ((T*)(ws_(F.A) + (off)))
__device__ __forceinline__ float* out_(const Args* A) { GAS float* g = (GAS float*)uni64_((unsigned long long)A->out); asm volatile("" : "+s"(g)); return (float*)g; }
#define F_out out_(F.A)
#define F_ctl FWS(unsigned, WS_CTL)
#define F_MOD FWS(float, WS_MOD)
#define F_ROPE FWS(float, WS_ROPE)
#define F_XC FWS(float, WS_XC)
#define F_IDX FWS(int, WS_IDX)
#define F_WTS FWS(float, WS_WTS)
#define F_SLOT FWS(int, WS_SLOT)
#define F_INV FWS(int, WS_INV)
#define F_ROWTOK FWS(int, WS_ROWTOK)
#define F_BLKBASE FWS(int, WS_BLKBASE)
#define F_H ((bf16_t*)out_(F.A))
#define F_X16 FWS(bf16_t, WS_H)
#define F_RET FWS(bf16_t, WS_RET)
#define F_CQ FWS(bf16_t, WS_CQ)
#define F_CKV FWS(bf16_t, WS_CKV)
#define F_KR FWS(bf16_t, WS_KR)
#define F_AO FWS(bf16_t, WS_AO)
#define F_UV FWS(bf16_t, WS_UV)
#define F_Q FWS(bf16_t, WS_Q)
#define F_K FWS(bf16_t, WS_K)
#define F_V FWS(bf16_t, WS_V)
#define F_Y FWS(bf16_t, WS_Y)
#define F_ST FWS(bf16_t, WS_ST)
#define F_KVR FWS(bf16_t, WS_SCR)
#define F_HB FWS(bf16_t, WS_HB)
#define F_HBS FWS(bf16_t, WS_HBS)
#define F_OUT FWS(bf16_t, WS_OUT)
__device__ __forceinline__ int row_batch(int r) { return r < ML ? (r >> 13) : 4; }
__device__ __forceinline__ const float* x_row_src(const Frame& F, int l, int r) { return r < ML ? ((l == 0 ? FIN(I_X) : F_out) + (size_t)r * D) : (F_XC + (size_t)(r - ML) * D); }
__device__ __forceinline__ float* x_row_dst(const Frame& F, int r) { return r < ML ? (F_out + (size_t)r * D) : (F_XC + (size_t)(r - ML) * D); }

__device__ __forceinline__ void ngemm_acc(float (&acc)[4][4], const bf16_t* A, int lda, const int* rowidx, int row0, int nrows,
                                          const float* W, int ldw, int col0, int ncols, int K, float* sA, float* sW, int tid) {
    const int ty = tid >> 4, tx = tid & 15;
    const int lr = tid >> 2, lk = (tid & 3) * 8;
    const int wk = tid >> 4, wc = (tid & 15) * 4;
    const bool rv = (row0 + lr) < nrows;
    const bf16_t* arow = nullptr;
    if (rv) { const int rr = rowidx ? rowidx[row0 + lr] : (row0 + lr); arow = A + (size_t)rr * lda; }
    const bool cv = (col0 + wc) < ncols;
    for (int k0 = 0; k0 < K; k0 += 32) {
        uint4 av = make_uint4(0u, 0u, 0u, 0u);
        if (rv) av = *(const uint4*)(arow + k0 + lk);
        float4 wv = make_float4(0.f, 0.f, 0.f, 0.f);
        if (cv) wv = *(const float4*)(W + (size_t)(k0 + wk) * ldw + col0 + wc);
        __syncthreads();
        float* sa = sA + lr * 33 + lk;
        sa[0] = __builtin_bit_cast(float, av.x << 16); sa[1] = __builtin_bit_cast(float, av.x & 0xffff0000u);
        sa[2] = __builtin_bit_cast(float, av.y << 16); sa[3] = __builtin_bit_cast(float, av.y & 0xffff0000u);
        sa[4] = __builtin_bit_cast(float, av.z << 16); sa[5] = __builtin_bit_cast(float, av.z & 0xffff0000u);
        sa[6] = __builtin_bit_cast(float, av.w << 16); sa[7] = __builtin_bit_cast(float, av.w & 0xffff0000u);
        *(float4*)(sW + wk * 64 + wc) = wv;
        __syncthreads();
#pragma unroll 8
        for (int kk = 0; kk < 32; ++kk) {
            const float4 w = *(const float4*)(sW + kk * 64 + tx * 4);
            float a[4];
#pragma unroll
            for (int i = 0; i < 4; ++i) a[i] = sA[(ty * 4 + i) * 33 + kk];
#pragma unroll
            for (int i = 0; i < 4; ++i) { acc[i][0] += a[i] * w.x; acc[i][1] += a[i] * w.y; acc[i][2] += a[i] * w.z; acc[i][3] += a[i] * w.w; }
        }
    }
}
#define ZERO_ACC(a) do { _Pragma("unroll") for (int _i = 0; _i < 4; ++_i) _Pragma("unroll") for (int _j = 0; _j < 4; ++_j) a[_i][_j] = 0.f; } while (0)

namespace g8 {
typedef short bf16x8 __attribute__((ext_vector_type(8)));
typedef float f32x4 __attribute__((ext_vector_type(4)));
typedef unsigned u32x4 __attribute__((ext_vector_type(4)));
typedef float f32x2 __attribute__((ext_vector_type(2)));
typedef __bf16 bf16x2_t __attribute__((ext_vector_type(2)));
constexpr int HTB = 16384, STAGE_BYTES = 8 * HTB;
__device__ __forceinline__ int lds_byte(int r, int c) { const int st = (r >> 4) * 2 + (c >> 5), rr = r & 15, cc = c & 31, ob = rr * 64 + cc * 2; return st * 1024 + (ob ^ (((ob >> 9) & 1) << 5)); }
__device__ __forceinline__ void stage_rc(int b, int& R, int& C) { const int st = b / 1024, sb = b % 1024, swz = sb ^ (((sb >> 9) & 1) << 5); R = (st >> 1) * 16 + swz / 64; C = (st & 1) * 32 + (swz % 64) / 2; }
__device__ __forceinline__ int perm32(int rho) { const int n = rho >> 4, i = rho & 15; return 8 * (i >> 2) + 4 * n + (i & 3); }
__device__ __forceinline__ unsigned cvtpk(float lo, float hi) { f32x2 v = {lo, hi}; bf16x2_t b = __builtin_convertvector(v, bf16x2_t); return __builtin_bit_cast(unsigned, b); }
__device__ __forceinline__ float fsigmoid(float x) { return __builtin_amdgcn_rcpf(1.0f + __builtin_amdgcn_exp2f(-1.4426950408889634f * x)); }
__device__ __forceinline__ u32x4 pack8(const f32x4& a, const f32x4& b) { u32x4 w; w.x = cvtpk(a[0], a[1]); w.y = cvtpk(a[2], a[3]); w.z = cvtpk(b[0], b[1]); w.w = cvtpk(b[2], b[3]); return w; }
__device__ __forceinline__ void unpack8(const u32x4& w, f32x4& a, f32x4& b) {
    a[0] = __builtin_bit_cast(float, w.x << 16); a[1] = __builtin_bit_cast(float, w.x & 0xffff0000u); a[2] = __builtin_bit_cast(float, w.y << 16); a[3] = __builtin_bit_cast(float, w.y & 0xffff0000u);
    b[0] = __builtin_bit_cast(float, w.z << 16); b[1] = __builtin_bit_cast(float, w.z & 0xffff0000u); b[2] = __builtin_bit_cast(float, w.w << 16); b[3] = __builtin_bit_cast(float, w.w & 0xffff0000u); }

struct GUnit { const char* A; const char* B; const int* rows; int arow0; unsigned lda2, ldb2; int nt; int pm, pn, tag; };

#define G8_ROWS(u, ra) do { _Pragma("unroll") for (int _h = 0; _h < 2; ++_h) { \
        const int _x0 = (u).arow0 + _h * 128 + R0, _x1 = (u).arow0 + _h * 128 + R1; \
        ra[_h][0] = (u).rows ? (u).rows[_x0] : _x0; ra[_h][1] = (u).rows ? (u).rows[_x1] : _x1; } } while (0)

template <bool GATHER, class Sched, class Epi>
__device__ __forceinline__ void gemm_phase(LAS unsigned char* lds, const Sched& S, const Epi& E, int tid_in) {
    int tid = tid_in; asm volatile("" : "+v"(tid));
    const int wid = __builtin_amdgcn_readfirstlane(tid >> 6), lane = tid & 63, wr = wid >> 2, wc = wid & 3, fr = lane & 15, fq = lane >> 4;
    int R0, C0, R1, C1; stage_rc(tid * 16, R0, C0); stage_rc(tid * 16 + 8192, R1, C1);
    const int Rb0 = (R0 & ~31) + perm32(R0 & 31), Rb1 = (R1 & ~31) + perm32(R1 & 31);
    const unsigned ldsw = (unsigned)wid * 1024u, cb0 = (unsigned)C0 * 2u, cb1 = (unsigned)C1 * 2u;
    const int aoff = lds_byte(wr * 64 + fr, fq * 8), boff = lds_byte(wc * 32 + fr, fq * 8);
#define G8_SA(b, h) (((b) * 2 + (h)) * HTB)
#define G8_SB(b, h) ((4 + (b) * 2 + (h)) * HTB)
#define G8_GLDS(gptr, bufoff, i) __builtin_amdgcn_global_load_lds((const unsigned*)(gptr), (LAS unsigned*)(lds + (bufoff) + ldsw + (i) * 8192), 16, 0, 0)
#define G8_STAGE_A(bufoff, gbase, ld2, ra2, arow, h, kb) do { if constexpr (GATHER) { \
        G8_GLDS((gbase) + (size_t)((unsigned)(ra2)[0] * (ld2) + cb0 + (kb)), bufoff, 0); G8_GLDS((gbase) + (size_t)((unsigned)(ra2)[1] * (ld2) + cb1 + (kb)), bufoff, 1); } else { \
        G8_GLDS((gbase) + (size_t)((unsigned)((arow) + (h) * 128 + R0) * (ld2) + cb0 + (kb)), bufoff, 0); G8_GLDS((gbase) + (size_t)((unsigned)((arow) + (h) * 128 + R1) * (ld2) + cb1 + (kb)), bufoff, 1); } } while (0)
#define G8_STAGE_B(bufoff, gbase, ld2, h, kb) do { G8_GLDS((gbase) + (size_t)((unsigned)((h) * 128 + Rb0) * (ld2) + cb0 + (kb)), bufoff, 0); G8_GLDS((gbase) + (size_t)((unsigned)((h) * 128 + Rb1) * (ld2) + cb1 + (kb)), bufoff, 1); } while (0)
#define G8_LDA(dst, b, h) do { _Pragma("unroll") for (int m = 0; m < 4; ++m) _Pragma("unroll") for (int k = 0; k < 2; ++k) dst[m][k] = *(const LAS bf16x8*)(lds + G8_SA(b, h) + aoff + m * 2048 + k * 1024); } while (0)
#define G8_LDB(dst, b, h) do { _Pragma("unroll") for (int n = 0; n < 2; ++n) _Pragma("unroll") for (int k = 0; k < 2; ++k) dst[n][k] = *(const LAS bf16x8*)(lds + G8_SB(b, h) + boff + n * 2048 + k * 1024); } while (0)
#define G8_MMA(ai, bj, At, Bt) do { __builtin_amdgcn_s_setprio(1); _Pragma("unroll") for (int m = 0; m < 4; ++m) _Pragma("unroll") for (int n = 0; n < 2; ++n) _Pragma("unroll") for (int k = 0; k < 2; ++k) \
        acc[ai][bj][m][n] = __builtin_amdgcn_mfma_f32_16x16x32_bf16(Bt[n][k], At[m][k], acc[ai][bj][m][n], 0, 0, 0); __builtin_amdgcn_s_setprio(0); } while (0)
#define G8_WAIT_V(n) asm volatile("s_waitcnt vmcnt(" #n ")" ::: "memory")
#define G8_WAIT_L(n) asm volatile("s_waitcnt lgkmcnt(" #n ")" ::: "memory")
#define G8_BAR __builtin_amdgcn_s_barrier()
#define G8_SCHED __builtin_amdgcn_sched_barrier(0)
    GUnit cur, nxt; int ui = 0;
    if (!S.get(0, cur)) return;
#define G8_OPAQUE(u) do { (u).lda2 = (unsigned)__builtin_amdgcn_readfirstlane((int)(u).lda2); (u).ldb2 = (unsigned)__builtin_amdgcn_readfirstlane((int)(u).ldb2); (u).nt = __builtin_amdgcn_readfirstlane((u).nt); (u).arow0 = __builtin_amdgcn_readfirstlane((u).arow0); \
    asm volatile("" : "+s"((u).lda2), "+s"((u).ldb2), "+s"((u).nt), "+s"((u).arow0)); } while (0)
    G8_OPAQUE(cur);
    int ra_c[2][2], ra_n[2][2];
    if constexpr (GATHER) { G8_ROWS(cur, ra_c); }
    f32x4 acc[2][2][4][2];
#pragma unroll
    for (int a = 0; a < 2; ++a)
#pragma unroll
        for (int b = 0; b < 2; ++b)
#pragma unroll
            for (int m = 0; m < 4; ++m)
#pragma unroll
                for (int n = 0; n < 2; ++n) acc[a][b][m][n] = (f32x4){0.f, 0.f, 0.f, 0.f};
    bf16x8 At[4][2], B0[2][2], B1[2][2];
    G8_STAGE_B(G8_SB(0, 0), cur.B, cur.ldb2, 0, 0u); G8_STAGE_B(G8_SB(0, 1), cur.B, cur.ldb2, 1, 0u); G8_STAGE_A(G8_SA(0, 0), cur.A, cur.lda2, ra_c[0], cur.arow0, 0, 0u); G8_STAGE_A(G8_SA(0, 1), cur.A, cur.lda2, ra_c[1], cur.arow0, 1, 0u);
    if (wr == 1) G8_BAR;
    G8_WAIT_V(2); G8_BAR;
    G8_STAGE_B(G8_SB(1, 0), cur.B, cur.ldb2, 0, 128u); G8_STAGE_A(G8_SA(1, 0), cur.A, cur.lda2, ra_c[0], cur.arow0, 0, 128u); G8_STAGE_B(G8_SB(1, 1), cur.B, cur.ldb2, 1, 128u);
    G8_WAIT_V(6); G8_BAR;
    for (;;) {
        const bool has_next = S.get(ui + 1, nxt);
        if (has_next) G8_OPAQUE(nxt);
        if (has_next) { if constexpr (GATHER) { G8_ROWS(nxt, ra_n); } }
        else { nxt = cur;
            if constexpr (GATHER) {
#pragma unroll
            for (int h = 0; h < 2; ++h)
#pragma unroll
                for (int i = 0; i < 2; ++i) ra_n[h][i] = ra_c[h][i]; } }
        const int nt = cur.nt;
        for (int t = 0; t < nt; t += 2) {
            const bool last = (t == nt - 2);
            const char* a2 = last ? nxt.A : cur.A; const char* b2 = last ? nxt.B : cur.B;
            const unsigned la2 = last ? nxt.lda2 : cur.lda2, lb2 = last ? nxt.ldb2 : cur.ldb2;
            const unsigned k1 = (unsigned)(t + 1) * 128u, k2 = last ? 0u : (unsigned)(t + 2) * 128u, k3 = k2 + 128u;
            const int ar2 = last ? nxt.arow0 : cur.arow0; (void)ar2;
            int ra2[2][2];
            if constexpr (GATHER) {
#pragma unroll
            for (int h = 0; h < 2; ++h)
#pragma unroll
                for (int i = 0; i < 2; ++i) ra2[h][i] = last ? ra_n[h][i] : ra_c[h][i]; }
            G8_LDB(B0, 0, 0); G8_LDB(B1, 0, 1); G8_SCHED; G8_LDA(At, 0, 0); G8_STAGE_A(G8_SA(1, 1), cur.A, cur.lda2, ra_c[1], cur.arow0, 1, k1);
            G8_WAIT_V(8); G8_WAIT_L(0); G8_BAR; G8_MMA(0, 0, At, B0); G8_MMA(0, 1, At, B1); G8_BAR; G8_SCHED;
            G8_LDA(At, 0, 1); G8_STAGE_B(G8_SB(0, 0), b2, lb2, 0, k2); G8_STAGE_B(G8_SB(0, 1), b2, lb2, 1, k2); G8_STAGE_A(G8_SA(0, 0), a2, la2, ra2[0], ar2, 0, k2);
            G8_WAIT_V(8); G8_WAIT_L(0); G8_BAR; G8_MMA(1, 0, At, B0); G8_MMA(1, 1, At, B1); G8_BAR; G8_SCHED;
            G8_LDB(B0, 1, 0); G8_LDB(B1, 1, 1); G8_SCHED; G8_LDA(At, 1, 0); G8_STAGE_A(G8_SA(0, 1), a2, la2, ra2[1], ar2, 1, k2);
            G8_WAIT_V(8); G8_WAIT_L(0); G8_BAR; G8_MMA(0, 0, At, B0); G8_MMA(0, 1, At, B1); G8_BAR; G8_SCHED;
            G8_LDA(At, 1, 1); G8_STAGE_B(G8_SB(1, 0), b2, lb2, 0, k3); G8_STAGE_B(G8_SB(1, 1), b2, lb2, 1, k3); G8_STAGE_A(G8_SA(1, 0), a2, la2, ra2[0], ar2, 0, k3);
            G8_WAIT_V(8); G8_WAIT_L(0); G8_BAR; G8_MMA(1, 0, At, B0); G8_MMA(1, 1, At, B1); G8_BAR; G8_SCHED;
        }
        if (wr == 0) G8_BAR;
        { int efr = fr, efq = fq, etid = tid; asm volatile("" : "+v"(efr), "+v"(efq), "+v"(etid));
          E(acc, cur, wr, wc, efr, efq, etid); }
        if (!has_next) break;
#pragma unroll
        for (int a = 0; a < 2; ++a)
#pragma unroll
            for (int b = 0; b < 2; ++b)
#pragma unroll
                for (int m = 0; m < 4; ++m)
#pragma unroll
                    for (int n = 0; n < 2; ++n) acc[a][b][m][n] = (f32x4){0.f, 0.f, 0.f, 0.f};
        cur = nxt; ++ui;
        if constexpr (GATHER) {
#pragma unroll
        for (int h = 0; h < 2; ++h)
#pragma unroll
            for (int i = 0; i < 2; ++i) ra_c[h][i] = ra_n[h][i]; }
        if (wr == 1) G8_BAR;
    }
    G8_WAIT_V(0);
    G8_BAR;
#undef G8_SA
#undef G8_SB
#undef G8_GLDS
#undef G8_OPAQUE
#undef G8_STAGE_A
#undef G8_STAGE_B
#undef G8_LDA
#undef G8_LDB
#undef G8_MMA
#undef G8_WAIT_V
#undef G8_WAIT_L
#undef G8_BAR
#undef G8_SCHED
}
__device__ __forceinline__ bool tile_order(int i, int G, int c, int nM, int nN, int& pm, int& pn) {
    const int nwg = nM * nN; const long L = (long)i * G + c; if (L >= nwg) return false;
    int wgid = (int)L; { const int q = nwg / 8, r = nwg % 8, xcd = wgid % 8, off = wgid / 8; wgid = (xcd < r ? xcd * (q + 1) : r * (q + 1) + (xcd - r) * q) + off; }
    const int nig = 8 * nN, gid = wgid / nig, fm = gid * 8, gsz = (nM - fm) < 8 ? (nM - fm) : 8;
    pm = fm + ((wgid % nig) % gsz); pn = (wgid % nig) / gsz; return true;
}
}

__device__ __forceinline__ float sumsq8(const g8::f32x4& a, const g8::f32x4& b) { return (a[0] * a[0] + a[1] * a[1]) + (a[2] * a[2] + a[3] * a[3]) + (b[0] * b[0] + b[1] * b[1]) + (b[2] * b[2] + b[3] * b[3]); }
__device__ __forceinline__ void p_prologue(Frame& F) {
    float* sred = (float*)F.lds;
    const float* cvp = FIN(I_C); const float* ccp = FIN(I_CCTX); const float* adab = FIN(I_ADAB); const float* adaw = FIN(I_ADAW);
    float* ssil = sred + 8 * 64 * 5;
    if (F.bid < 2 * 96) { for (int i = F.tid; i < 5 * D; i += NTHR) { const float v = i < 4 * D ? cvp[i] : ccp[i - 4 * D]; ssil[i] = siluf_(v); } }
    __syncthreads();
    for (int u = F.bid; u < 2 * 96; u += F.G) {
        const int l = u / 96, n0 = (u % 96) * 64, n = n0 + (F.tid & 63), ks = F.tid >> 6;
        float a[5] = {0.f, 0.f, 0.f, 0.f, 0.f};
        const float* W = adaw + (size_t)l * D * 6144;
#pragma unroll 8
        for (int k = ks * 128; k < ks * 128 + 128; ++k) {
            const float w = W[(size_t)k * 6144 + n];
#pragma unroll
            for (int b = 0; b < 5; ++b) a[b] += ssil[b * D + k] * w;
        }
        __syncthreads();
#pragma unroll
        for (int b = 0; b < 5; ++b) sred[(ks * 64 + (F.tid & 63)) * 5 + b] = a[b];
        __syncthreads();
        if (F.tid < 64 * 5) { const int c = F.tid / 5, b = F.tid % 5; float s = 0.f;
            for (int q = 0; q < 8; ++q) s += sred[(q * 64 + c) * 5 + b];
            F_MOD[((size_t)l * 5 + b) * 6144 + n0 + c] = s + adab[l * 6144 + n0 + c]; }
    }
    const int gt = F.bid * NTHR + F.tid, GT = F.G * NTHR;
    for (int i = gt; i < SEQ * 16; i += GT) {
        const int t = i >> 4, a = (i >> 3) & 1, f = i & 7;
        const float inv = powf(10000.0f, -(float)f / 8.0f);
        const float pos = a == 0 ? (float)(t >> 6) : (float)(t & 63);
        const float ang = pos * inv;
        F_ROPE[t * 32 + a * 16 + f] = cosf(ang); F_ROPE[t * 32 + a * 16 + 8 + f] = sinf(ang);
    }
}

__device__ __forceinline__ void p_norm(Frame& F, int l, int which, int nrows) {
    const int gw = F.bid * NWAVES + F.wave, NGW = F.G * NWAVES;
    const float* g = FIN(which == 0 ? I_N1G : I_N2G) + l * D;
    const float* xlat = FIN(I_X); const float* xctx = FIN(I_CTX);
    g8::f32x4 gg[4];
#pragma unroll
    for (int j = 0; j < 4; ++j) gg[j] = *(const g8::f32x4*)(g + j * 256 + F.lane * 4);
    for (int rb = gw; rb < nrows; rb += 4 * NGW) {
        g8::f32x4 v[4][4]; int rr[4];
#pragma unroll
        for (int q = 0; q < 4; ++q) { const int r = rb + q * NGW; rr[q] = r < nrows ? r : rb;
            const g8::f32x4* xr = (const g8::f32x4*)(rr[q] < ML ? xlat + (size_t)rr[q] * D : xctx + (size_t)(rr[q] - ML) * D) + F.lane;
#pragma unroll
            for (int j = 0; j < 4; ++j) v[q][j] = xr[64 * j]; }
#pragma unroll
        for (int q = 0; q < 4; ++q) { if (rb + q * NGW >= nrows) break; const int r = rr[q];
            float s = 0.f;
#pragma unroll
            for (int j = 0; j < 4; ++j) s += (v[q][j][0] * v[q][j][0] + v[q][j][1] * v[q][j][1]) + (v[q][j][2] * v[q][j][2] + v[q][j][3] * v[q][j][3]);
            const float rstd = 1.0f / sqrtf(wave_sum(s) * (1.0f / D) + EPS);
            const float* mod = F_MOD + ((size_t)l * 5 + row_batch(r)) * 6144 + (which == 0 ? 0 : 3 * D);
#pragma unroll
            for (int j = 0; j < 4; ++j) { const int e = j * 256 + F.lane * 4;
                const g8::f32x4 sh = *(const g8::f32x4*)(mod + e), sc = *(const g8::f32x4*)(mod + D + e);
                const g8::f32x4 o = (v[q][j] * rstd * gg[j]) * (sc + 1.0f) + sh;
                uint2 w; w.x = g8::cvtpk(o[0], o[1]); w.y = g8::cvtpk(o[2], o[3]);
                *(uint2*)(F_H + (size_t)r * D + e) = w; } }
    }
}

__device__ __forceinline__ void p_norm2(Frame& F, int l, int nrows) {
    const int gw = F.bid * NWAVES + F.wave, NGW = F.G * NWAVES, e = F.lane * 16;
    const float* g = FIN(I_N2G) + l * D + e;
    constexpr int NLB = ML / 16;
    const int nseg = NLB + (nrows > ML ? nrows - ML : 0);
    for (int seg = gw; seg < nseg; seg += NGW) {
        const int r0 = seg < NLB ? seg * 16 : ML + (seg - NLB), n = seg < NLB ? 16 : 1;
        const float* mod = F_MOD + ((size_t)l * 5 + row_batch(r0)) * 6144 + 3 * D + e;
        g8::f32x4 gs[4], sh[4];
#pragma unroll
        for (int q = 0; q < 4; ++q) { sh[q] = *(const g8::f32x4*)(mod + 4 * q); gs[q] = *(const g8::f32x4*)(g + 4 * q) * (*(const g8::f32x4*)(mod + D + 4 * q) + 1.0f); }
        for (int j0 = 0; j0 < n; j0 += 8) {
            g8::u32x4 v[8][2];
#pragma unroll
            for (int q = 0; q < 8; ++q) { const int r = r0 + (j0 + q < n ? j0 + q : j0); const bf16_t* xr = F_X16 + (size_t)r * D + e; v[q][0] = *(const g8::u32x4*)xr; v[q][1] = *(const g8::u32x4*)(xr + 8); }
#pragma unroll
            for (int q = 0; q < 8; ++q) { if (j0 + q >= n) break; const int r = r0 + j0 + q;
                g8::f32x4 a0, a1, a2, a3; g8::unpack8(v[q][0], a0, a1); g8::unpack8(v[q][1], a2, a3);
                const float rstd = 1.0f / sqrtf(wave_sum(sumsq8(a0, a1) + sumsq8(a2, a3)) * (1.0f / D) + EPS);
                *(g8::u32x4*)(F_H + (size_t)r * D + e) = g8::pack8(a0 * rstd * gs[0] + sh[0], a1 * rstd * gs[1] + sh[1]);
                *(g8::u32x4*)(F_H + (size_t)r * D + e + 8) = g8::pack8(a2 * rstd * gs[2] + sh[2], a3 * rstd * gs[3] + sh[3]); }
        }
    }
}

__device__ __forceinline__ void p_inproj_naive(Frame& F, int l) {
    float* sA = (float*)F.lds; float* sW = sA + 128 * 33;
    const float* W = FIN(I_WIN) + (size_t)l * D * N_IN;
    constexpr int NT_N = (OFF_MERGE + 63) / 64, NT_M = M / 128;
    const int ty = F.tid >> 4, tx = F.tid & 15;
    for (int t = F.bid; t < NT_M * NT_N; t += F.G) {
        const int tm = t / NT_N, tn = t % NT_N; float acc[4][4]; ZERO_ACC(acc);
        ngemm_acc(acc, F_H, D, nullptr, tm * 128, M, W, N_IN, tn * 64, OFF_MERGE, D, sA, sW, F.tid);
#pragma unroll
        for (int i = 0; i < 4; ++i)
#pragma unroll
            for (int j = 0; j < 4; ++j) {
                const int r = tm * 128 + ty * 4 + i, c = tn * 64 + tx * 4 + j; if (c >= OFF_MERGE) continue;
                float v = acc[i][j];
                if (c < OFF_CQ) { if (c >= 512 && c < 1024) v *= 0.08838834764831845f; F_RET[(size_t)r * 2048 + c] = (bf16_t)f2bf(v); }
                else if (c < OFF_CKV) F_CQ[(size_t)r * 384 + (c - OFF_CQ)] = (bf16_t)f2bf(v);
                else if (c < OFF_KR) F_CKV[(size_t)r * 256 + (c - OFF_CKV)] = (bf16_t)f2bf(v);
                else if (c < OFF_UV) F_KR[(size_t)r * 32 + (c - OFF_KR)] = (bf16_t)f2bf(v);
                else F_UV[(size_t)r * 1024 + (c - OFF_UV)] = (bf16_t)f2bf(gelu_tanh(v));
            }
    }
}

__device__ __forceinline__ float rope_elem(const float* tab  , int d, float y, float yp) {
    const int a = d >> 4, j = d & 15, f = j & 7; const float c = tab[a * 16 + f], s = tab[a * 16 + 8 + f];
    return (j < 8) ? (y * c - yp * s) : (yp * s + y * c);
}
__device__ __forceinline__ void p_rowpass_a(Frame& F, int l) {
    const int gw = F.bid * NWAVES + F.wave, NGW = F.G * NWAVES, lane = F.lane;
    const float* qag = FIN(I_QAG) + l * 384; const float* kvag = FIN(I_KVAG) + l * 256; const float* krg = FIN(I_KRG) + l * 32;
    const float* lng = FIN(I_LNG) + l * 512; const float* lnb = FIN(I_LNB) + l * 512;
    for (int r = gw; r < M; r += NGW) {
        { bf16_t* p = F_CQ + (size_t)r * 384; float x[6]; float s = 0.f;
#pragma unroll
          for (int j = 0; j < 6; ++j) { x[j] = bf2f(p[lane + 64 * j]); s += x[j] * x[j]; }
          const float rstd = 1.0f / sqrtf(wave_sum(s) * (1.0f / 384.f) + EPS);
#pragma unroll
          for (int j = 0; j < 6; ++j) p[lane + 64 * j] = (bf16_t)f2bf(x[j] * rstd * qag[lane + 64 * j]); }
        { bf16_t* p = F_CKV + (size_t)r * 256; float x[4]; float s = 0.f;
#pragma unroll
          for (int j = 0; j < 4; ++j) { x[j] = bf2f(p[lane + 64 * j]); s += x[j] * x[j]; }
          const float rstd = 1.0f / sqrtf(wave_sum(s) * (1.0f / 256.f) + EPS);
#pragma unroll
          for (int j = 0; j < 4; ++j) p[lane + 64 * j] = (bf16_t)f2bf(x[j] * rstd * kvag[lane + 64 * j]); }
        { bf16_t* p = F_KR + (size_t)r * 32; const int d = lane & 31; const float x = lane < 32 ? bf2f(p[d]) : 0.f;
          const float rstd = 1.0f / sqrtf(wave_sum(x * x) * (1.0f / 32.f) + EPS);
          float y = x * rstd * krg[d]; const float yp = __shfl_xor(y, 8);
          if (r < ML) y = rope_elem(F_ROPE + (size_t)(r & (SEQ - 1)) * 32, d, y, yp);
          if (lane < 32) p[d] = (bf16_t)f2bf(y); }
        { bf16_t* p = F_UV + (size_t)r * 1024 + 512; float x[8]; float s = 0.f;
#pragma unroll
          for (int j = 0; j < 8; ++j) { x[j] = bf2f(p[lane + 64 * j]); s += x[j]; }
          const float mu = wave_sum(s) * (1.0f / 512.f); float q = 0.f;
#pragma unroll
          for (int j = 0; j < 8; ++j) { x[j] -= mu; q += x[j] * x[j]; }
          const float rstd = 1.0f / sqrtf(wave_sum(q) * (1.0f / 512.f) + EPS);
#pragma unroll
          for (int j = 0; j < 8; ++j) p[lane + 64 * j] = (bf16_t)f2bf(x[j] * rstd * lng[lane + 64 * j] + lnb[lane + 64 * j]); }
    }
}

__device__ __forceinline__ void p_mlaup_naive(Frame& F, int l) {
    float* sA = (float*)F.lds; float* sW = sA + 128 * 33;
    const int ty = F.tid >> 4, tx = F.tid & 15;
    constexpr int NT_M = M / 128, NQ = 768 / 64, NKV = 1024 / 64;
    for (int t = F.bid; t < NT_M * (NQ + NKV); t += F.G) {
        const int tm = t / (NQ + NKV), tn = t % (NQ + NKV); float acc[4][4]; ZERO_ACC(acc);
        if (tn < NQ) {
            ngemm_acc(acc, F_CQ, 384, nullptr, tm * 128, M, FIN(I_WUQ) + (size_t)l * 384 * 768, 768, tn * 64, 768, 384, sA, sW, F.tid);
#pragma unroll
            for (int i = 0; i < 4; ++i)
#pragma unroll
                for (int j = 0; j < 4; ++j) F_Q[(size_t)(tm * 128 + ty * 4 + i) * 768 + tn * 64 + tx * 4 + j] = (bf16_t)f2bf(acc[i][j]);
        } else {
            const int tk = tn - NQ;
            ngemm_acc(acc, F_CKV, 256, nullptr, tm * 128, M, FIN(I_WUKV) + (size_t)l * 256 * 1024, 1024, tk * 64, 1024, 256, sA, sW, F.tid);
#pragma unroll
            for (int i = 0; i < 4; ++i)
#pragma unroll
                for (int j = 0; j < 4; ++j) F_KVR[(size_t)(tm * 128 + ty * 4 + i) * 1024 + tk * 64 + tx * 4 + j] = (bf16_t)f2bf(acc[i][j]);
        }
    }
}
__device__ __forceinline__ void p_rowpass_b(Frame& F, int l) {
    const int gw = F.bid * NWAVES + F.wave, NGW = F.G * NWAVES, lane = F.lane;
    const float* qng = FIN(I_QNG) + l * 96; const float* kng = FIN(I_KNG) + l * 64;
    for (int r = gw; r < M; r += NGW) {
        const float* tab = F_ROPE + (size_t)(r & (SEQ - 1)) * 32;
        const float krv = lane < 32 ? bf2f(F_KR[(size_t)r * 32 + lane]) : 0.f;
        for (int h = 0; h < 8; ++h) {
            bf16_t* q = F_Q + (size_t)r * 768 + h * 96;
            const float x0 = bf2f(q[lane]), x1 = lane < 32 ? bf2f(q[64 + lane]) : 0.f;
            const float rstd = 1.0f / sqrtf(wave_sum(x0 * x0 + x1 * x1) * (1.0f / 96.f) + EPS);
            const float y0 = x0 * rstd * qng[lane]; float y1 = x1 * rstd * qng[64 + (lane & 31)];
            const float yp = __shfl_xor(y1, 8);
            if (r < ML) y1 = rope_elem(tab, lane & 31, y1, yp);
            q[lane] = (bf16_t)f2bf(y0 * QSCALE); if (lane < 32) q[64 + lane] = (bf16_t)f2bf(y1 * QSCALE);
            const bf16_t* kv = F_KVR + (size_t)r * 1024 + h * 128;
            const float k0 = bf2f(kv[lane]);
            const float rk = 1.0f / sqrtf(wave_sum(k0 * k0) * (1.0f / 64.f) + EPS);
            bf16_t* ko = F_K + (size_t)r * 768 + h * 96;
            ko[lane] = (bf16_t)f2bf(k0 * rk * kng[lane]); if (lane < 32) ko[64 + lane] = (bf16_t)f2bf(krv);
            F_V[(size_t)r * 512 + h * 64 + lane] = kv[64 + lane];
        }
    }
}

__device__ __forceinline__ void attn_unit_naive(Frame& F, int h, int qrow0, int kr0, int kn0, int kr1, int kn1) {
    float* sQ = (float*)F.lds;
    float* sK = sQ + 32 * 97;
    float* sV = sK + 64 * 97;
    float* sS = sV + 64 * 64;
    float* sM = sS + 32 * 65;
    const int tid = F.tid;
    __syncthreads();
    for (int i = tid; i < 32 * 96; i += NTHR) { const int rr = i / 96, d = i % 96; sQ[rr * 97 + d] = bf2f(F_Q[(size_t)(qrow0 + rr) * 768 + h * 96 + d]); }
    if (tid < 32) { sM[tid] = -INFINITY; sM[32 + tid] = 0.f; sM[64 + tid] = 0.f; }
    float o[4] = {0.f, 0.f, 0.f, 0.f};
    const int srow = tid >> 4, scol = tid & 15;
    const int orow = (tid >> 6) * 4, ocol = tid & 63;
    const int ntile = (kn0 + kn1) / 64;
    for (int kt = 0; kt < ntile; ++kt) {
        const int j0 = kt * 64; const int krow = j0 < kn0 ? kr0 + j0 : kr1 + (j0 - kn0);
        __syncthreads();
        for (int i = tid; i < 64 * 96; i += NTHR) { const int rr = i / 96, d = i % 96; sK[rr * 97 + d] = bf2f(F_K[(size_t)(krow + rr) * 768 + h * 96 + d]); }
        for (int i = tid; i < 64 * 64; i += NTHR) { const int rr = i >> 6, d = i & 63; sV[rr * 64 + d] = bf2f(F_V[(size_t)(krow + rr) * 512 + h * 64 + d]); }
        __syncthreads();
        float s[4] = {0.f, 0.f, 0.f, 0.f};
        for (int d = 0; d < 96; ++d) { const float qv = sQ[srow * 97 + d];
#pragma unroll
            for (int jj = 0; jj < 4; ++jj) s[jj] += qv * sK[(scol + 16 * jj) * 97 + d]; }
#pragma unroll
        for (int jj = 0; jj < 4; ++jj) sS[srow * 65 + scol + 16 * jj] = s[jj];
        __syncthreads();
        if (tid < 32) { float mx = sM[tid];
            for (int j = 0; j < 64; ++j) mx = fmaxf(mx, sS[tid * 65 + j]);
            const float al = exp2f(sM[tid] - mx); float ls = 0.f;
            for (int j = 0; j < 64; ++j) { const float p = exp2f(sS[tid * 65 + j] - mx); sS[tid * 65 + j] = p; ls += p; }
            sM[tid] = mx; sM[32 + tid] = sM[32 + tid] * al + ls; sM[64 + tid] = al; }
        __syncthreads();
#pragma unroll
        for (int i = 0; i < 4; ++i) { float a = o[i] * sM[64 + orow + i];
            for (int j = 0; j < 64; ++j) a += sS[(orow + i) * 65 + j] * sV[j * 64 + ocol];
            o[i] = a; }
    }
#pragma unroll
    for (int i = 0; i < 4; ++i) F_AO[(size_t)(qrow0 + orow + i) * 512 + h * 64 + ocol] = (bf16_t)f2bf(o[i] / sM[32 + orow + i]);
}

__device__ __forceinline__ void ret_unit_naive(Frame& F, int l, int b, int h, int qpos0, bool isctx) {
    float* sQ = (float*)F.lds;
    float* sK = sQ + 32 * 129;
    float* sV = sK + 64 * 129;
    float* sS = sV + 64 * 128;
    float* sT = sS + 32 * 65;
    const int tid = F.tid;
    const float df = FIN(I_DECF)[l * 4 + h], db = FIN(I_DECB)[l * 4 + h];
    const float lf = -log1pf(expf(-df)) * 1.4426950408889634f, lb = -log1pf(expf(-db)) * 1.4426950408889634f;
    const int qrow0 = isctx ? ML + b * CTX + qpos0 : b * SEQ + qpos0;
    __syncthreads();
    for (int i = tid; i < 32 * 128; i += NTHR) { const int rr = i >> 7, d = i & 127; sQ[rr * 129 + d] = bf2f(F_RET[(size_t)(qrow0 + rr) * 2048 + h * 128 + d]); }
    float o[8];
#pragma unroll
    for (int i = 0; i < 8; ++i) o[i] = 0.f;
    const int srow = tid >> 4, scol = tid & 15;
    const int orow = (tid >> 7) * 8, ocol = tid & 127;
    const int ntile = isctx ? CTX / 64 : (CTX + SEQ) / 64;
    for (int kt = 0; kt < ntile; ++kt) {
        const int j0 = kt * 64; const bool kctx = j0 < CTX;
        const int kpos0 = kctx ? j0 : j0 - CTX; const int krow = kctx ? ML + b * CTX + kpos0 : b * SEQ + kpos0;
        __syncthreads();
        for (int i = tid; i < 64 * 128; i += NTHR) { const int rr = i >> 7, d = i & 127;
            sK[rr * 129 + d] = bf2f(F_RET[(size_t)(krow + rr) * 2048 + 512 + h * 128 + d]);
            sV[rr * 128 + d] = bf2f(F_RET[(size_t)(krow + rr) * 2048 + 1024 + h * 128 + d]); }
        __syncthreads();
        float s[4] = {0.f, 0.f, 0.f, 0.f};
        for (int d = 0; d < 128; ++d) { const float qv = sQ[srow * 129 + d];
#pragma unroll
            for (int jj = 0; jj < 4; ++jj) s[jj] += qv * sK[(scol + 16 * jj) * 129 + d]; }
        const int i_ = qpos0 + srow;
#pragma unroll
        for (int jj = 0; jj < 4; ++jj) { const int j_ = kpos0 + scol + 16 * jj; float w;
            if (isctx == kctx) w = (j_ <= i_) ? exp2f(lf * (float)(i_ - j_)) : exp2f(lb * (float)(j_ - i_));
            else w = exp2f(lf * (float)(i_ + CTX - j_)) + exp2f(lb * (float)(SEQ - i_ + j_));
            sS[srow * 65 + scol + 16 * jj] = s[jj] * w; }
        __syncthreads();
#pragma unroll
        for (int i = 0; i < 8; ++i) { float a = o[i];
            for (int j = 0; j < 64; ++j) a += sS[(orow + i) * 65 + j] * sV[j * 128 + ocol];
            o[i] = a; }
    }
    __syncthreads();
    float* sO = sK;
#pragma unroll
    for (int i = 0; i < 8; ++i) sO[(orow + i) * 129 + ocol] = o[i];
    __syncthreads();
    if (tid < 32) { float mu = 0.f; for (int d = 0; d < 128; ++d) mu += sO[tid * 129 + d]; mu *= (1.0f / 128.f);
        float q = 0.f; for (int d = 0; d < 128; ++d) { const float dd = sO[tid * 129 + d] - mu; q += dd * dd; }
        sT[tid] = mu; sT[32 + tid] = 1.0f / sqrtf(q * (1.0f / 128.f) + EPS); }
    __syncthreads();
    const float gg = FIN(I_GNG)[l * 512 + h * 128 + ocol], gb = FIN(I_GNB)[l * 512 + h * 128 + ocol];
#pragma unroll
    for (int i = 0; i < 8; ++i) { const int rr = orow + i; const size_t base = (size_t)(qrow0 + rr) * 2048 + h * 128 + ocol;
        const float gate = bf2f(F_RET[base + 1536]);
        F_RET[base] = (bf16_t)f2bf(siluf_(gate) * ((o[i] - sT[rr]) * sT[32 + rr] * gg + gb)); }
}

__device__ __forceinline__ void gmlp_unit_naive(Frame& F, int l, int cidx, int g) {
    float* sV = (float*)F.lds;
    float* sW = sV + 128 * 128;
    const int tid = F.tid, r0 = cidx * 128;
    const float* ws = FIN(I_GWS) + ((size_t)l * 4 + g) * 128 * 128; const float* bs = FIN(I_GBS) + (l * 4 + g) * 128;
    __syncthreads();
    for (int i = tid; i < 128 * 128; i += NTHR) { const int rr = i >> 7, c = i & 127;
        sV[rr * 128 + c] = bf2f(F_UV[(size_t)(r0 + rr) * 1024 + 512 + g * 128 + c]); sW[rr * 129 + c] = ws[i]; }
    __syncthreads();
    const int ig = (tid >> 7) * 32, c = tid & 127;
    for (int i = ig; i < ig + 32; ++i) { float a = bs[i];
        for (int j = 0; j < 128; ++j) a += sW[i * 129 + j] * sV[j * 128 + c];
        bf16_t* up = F_UV + (size_t)(r0 + i) * 1024 + g * 128 + c; *up = (bf16_t)f2bf(bf2f(*up) * a); }
}

__device__ __forceinline__ void p_merge_naive(Frame& F, int l, int nrows) {
    float* sA = (float*)F.lds; float* sW = sA + 128 * 33;
    const int ty = F.tid >> 4, tx = F.tid & 15;
    const float* Win = FIN(I_WIN) + (size_t)l * D * N_IN;
    const int ntm = nrows / 128;
    for (int t = F.bid; t < ntm * 16; t += F.G) {
        const int tm = t >> 4, tn = t & 15; float y[4][4]; ZERO_ACC(y);
#pragma unroll 1
        for (int br = 0; br < 3; ++br) {
            float g[4][4]; ZERO_ACC(g); float a[4][4]; ZERO_ACC(a);
            ngemm_acc(g, F_H, D, nullptr, tm * 128, nrows, Win + OFF_MERGE + br * 1024, N_IN, tn * 64, 1024, D, sA, sW, F.tid);
            const bf16_t* A = br == 0 ? F_RET : (br == 1 ? F_AO : F_UV); const int lda = br == 0 ? 2048 : (br == 1 ? 512 : 1024);
            const float* Wb = FIN(br == 0 ? I_WBRRET : (br == 1 ? I_WBRMLA : I_WBRG)) + (size_t)l * 512 * D;
            ngemm_acc(a, A, lda, nullptr, tm * 128, nrows, Wb, D, tn * 64, 1024, 512, sA, sW, F.tid);
#pragma unroll
            for (int i = 0; i < 4; ++i)
#pragma unroll
                for (int j = 0; j < 4; ++j) y[i][j] += sigmoidf_(g[i][j]) * a[i][j];
        }
#pragma unroll
        for (int i = 0; i < 4; ++i)
#pragma unroll
            for (int j = 0; j < 4; ++j) F_Y[(size_t)(tm * 128 + ty * 4 + i) * D + tn * 64 + tx * 4 + j] = (bf16_t)f2bf(y[i][j]);
    }
}
__device__ __forceinline__ void p_out_naive(Frame& F, int l, int nrows) {
    float* sA = (float*)F.lds; float* sW = sA + 128 * 33;
    const int ty = F.tid >> 4, tx = F.tid & 15;
    const int ntm = nrows / 128;
    for (int t = F.bid; t < ntm * 16; t += F.G) {
        const int tm = t >> 4, tn = t & 15; float acc[4][4]; ZERO_ACC(acc);
        ngemm_acc(acc, F_Y, D, nullptr, tm * 128, nrows, FIN(I_WOUT) + (size_t)l * D * D, D, tn * 64, D, D, sA, sW, F.tid);
#pragma unroll
        for (int i = 0; i < 4; ++i) { const int r = tm * 128 + ty * 4 + i; const float* xs = x_row_src(F, l, r); float* xd = x_row_dst(F, r);
            const float* ga = F_MOD + ((size_t)l * 5 + row_batch(r)) * 6144 + 2 * D;
#pragma unroll
            for (int j = 0; j < 4; ++j) { const int c = tn * 64 + tx * 4 + j; xd[c] = xs[c] + ga[c] * acc[i][j]; } }
    }
}

__device__ __forceinline__ void p_router(Frame& F, int l, int ntok) {
    int* hist = (int*)F.lds;
    const int gw = F.bid * NWAVES + F.wave, NGW = F.G * NWAVES, lane = F.lane;
    __syncthreads();
    if (F.tid < 64) hist[F.tid] = 0;
    __syncthreads();
    const float* R = FIN(I_ROUTER) + (size_t)l * D * NEXP; const float bias = FIN(I_MBIAS)[l * NEXP + lane];
    for (int r = gw; r < ntok; r += NGW) {
        const bf16_t* hrow = F_H + (size_t)r * D; float a = 0.f;
        for (int k = 0; k < D; k += 8) { const uint4 hv = *(const uint4*)(hrow + k);
            a += __builtin_bit_cast(float, hv.x << 16) * R[(k + 0) * NEXP + lane]; a += __builtin_bit_cast(float, hv.x & 0xffff0000u) * R[(k + 1) * NEXP + lane];
            a += __builtin_bit_cast(float, hv.y << 16) * R[(k + 2) * NEXP + lane]; a += __builtin_bit_cast(float, hv.y & 0xffff0000u) * R[(k + 3) * NEXP + lane];
            a += __builtin_bit_cast(float, hv.z << 16) * R[(k + 4) * NEXP + lane]; a += __builtin_bit_cast(float, hv.z & 0xffff0000u) * R[(k + 5) * NEXP + lane];
            a += __builtin_bit_cast(float, hv.w << 16) * R[(k + 6) * NEXP + lane]; a += __builtin_bit_cast(float, hv.w & 0xffff0000u) * R[(k + 7) * NEXP + lane]; }
        const float score = sigmoidf_(a); float sel = score + bias;
        float wk[TOPK]; int ek[TOPK]; float wsum = 0.f;
#pragma unroll
        for (int k = 0; k < TOPK; ++k) {
            float bv = sel; int bi = lane;
#pragma unroll
            for (int o = 1; o < 64; o <<= 1) { const float ov = __shfl_xor(bv, o); const int oi = __shfl_xor(bi, o); if (ov > bv || (ov == bv && oi < bi)) { bv = ov; bi = oi; } }
            ek[k] = bi; wk[k] = __shfl(score, bi); wsum += wk[k]; if (lane == bi) sel = -INFINITY;
        }
        if (lane == 0) {
#pragma unroll
            for (int k = 0; k < TOPK; ++k) { F_IDX[r * TOPK + k] = ek[k]; F_WTS[r * TOPK + k] = wk[k] / wsum * 2.5f; F_SLOT[r * TOPK + k] = atomicAdd(&hist[ek[k]], 1) | (F.bid << 20); }
        }
    }
    __syncthreads();
    if (F.tid < 64) F_BLKBASE[(l * 256 + F.bid) * 64 + F.tid] = (int)atomicAdd(F_ctl + CW_CNT + l * 64 + F.tid, (unsigned)hist[F.tid]);
    for (int i = F.bid * NTHR + F.tid; i < APAD; i += F.G * NTHR) F_ROWTOK[i] = 0;
}
__device__ __forceinline__ void moe_offsets(Frame& F, int l, int* ps) {
    __syncthreads();
    if (F.tid < 64) { const int e = F.tid; const int c = (int)F_ctl[CW_CNT + l * 64 + e]; const int n = ((c + 255) >> 8) << 8; int incl = n;
#pragma unroll
        for (int o = 1; o < 64; o <<= 1) { const int v = __builtin_amdgcn_ds_bpermute(((e - o) & 63) << 2, incl); if (e >= o) incl += v; }
        ps[e] = incl - n; ps[65 + e] = c; if (e == 63) ps[64] = incl; }
    __syncthreads();
}
__device__ __forceinline__ void p_scatter(Frame& F, int l, int ntok) {
    int* ps = (int*)F.lds; moe_offsets(F, l, ps);
    for (int i = F.bid * NTHR + F.tid; i < ntok * TOPK; i += F.G * NTHR) {
        const int r = i / TOPK; const int e = F_IDX[i]; const int sl = F_SLOT[i]; const int blk = sl >> 20;
        const int row = ps[e] + F_BLKBASE[(l * 256 + blk) * 64 + e] + (sl & 0xFFFFF);
        F_ROWTOK[row] = r; F_INV[i] = row;
    }
}
__device__ __forceinline__ void p_moe_gateup_naive(Frame& F, int l, int ntok) {
    int* ps = (int*)F.lds; moe_offsets(F, l, ps);
    float* sA = (float*)(F.lds + 1024); float* sW = sA + 128 * 33;
    const int ty = F.tid >> 4, tx = F.tid & 15;
    int tbase = 0, t = F.bid;
    for (int e = 0; e < NEXP; ++e) {
        const int cnt = ps[65 + e], nt = ((cnt + 127) >> 7) * 4;
        for (; t < tbase + nt; t += F.G) {
            const int tt = t - tbase, tm = tt >> 2, tn = tt & 3; float g[4][4], u[4][4]; ZERO_ACC(g); ZERO_ACC(u);
            const float* Wg = FIN(I_WG) + ((size_t)l * NEXP + e) * D * DEXP; const float* Wu = FIN(I_WU) + ((size_t)l * NEXP + e) * D * DEXP;
            ngemm_acc(g, F_H, D, F_ROWTOK + ps[e], tm * 128, cnt, Wg, DEXP, tn * 64, DEXP, D, sA, sW, F.tid);
            ngemm_acc(u, F_H, D, F_ROWTOK + ps[e], tm * 128, cnt, Wu, DEXP, tn * 64, DEXP, D, sA, sW, F.tid);
#pragma unroll
            for (int i = 0; i < 4; ++i) { const int rr = tm * 128 + ty * 4 + i; if (rr >= cnt) continue;
#pragma unroll
                for (int j = 0; j < 4; ++j) F_HB[(size_t)(ps[e] + rr) * DEXP + tn * 64 + tx * 4 + j] = (bf16_t)f2bf(siluf_(g[i][j]) * u[i][j]); }
        }
        tbase += nt;
    }
    const int ntm = ntok / 128;
    for (int t = F.bid; t < ntm * 4; t += F.G) {
        const int tm = t >> 2, tn = t & 3; float g[4][4], u[4][4]; ZERO_ACC(g); ZERO_ACC(u);
        ngemm_acc(g, F_H, D, nullptr, tm * 128, ntok, FIN(I_SG) + (size_t)l * D * DEXP, DEXP, tn * 64, DEXP, D, sA, sW, F.tid);
        ngemm_acc(u, F_H, D, nullptr, tm * 128, ntok, FIN(I_SU) + (size_t)l * D * DEXP, DEXP, tn * 64, DEXP, D, sA, sW, F.tid);
#pragma unroll
        for (int i = 0; i < 4; ++i)
#pragma unroll
            for (int j = 0; j < 4; ++j) F_HBS[(size_t)(tm * 128 + ty * 4 + i) * DEXP + tn * 64 + tx * 4 + j] = (bf16_t)f2bf(siluf_(g[i][j]) * u[i][j]);
    }
}
__device__ __forceinline__ void p_moe_down_naive(Frame& F, int l, int ntok, int c0) {
    int* ps = (int*)F.lds; moe_offsets(F, l, ps);
    float* sA = (float*)(F.lds + 1024); float* sW = sA + 128 * 33;
    const int ty = F.tid >> 4, tx = F.tid & 15;
    int tbase = 0, t = F.bid;
    for (int e = 0; e < NEXP; ++e) {
        const int cnt = ps[65 + e], nt = ((cnt + 127) >> 7) * 8;
        for (; t < tbase + nt; t += F.G) {
            const int tt = t - tbase, tm = tt >> 3, tn = tt & 7; float acc[4][4]; ZERO_ACC(acc);
            const float* Wd = FIN(I_WD) + ((size_t)l * NEXP + e) * DEXP * D;
            ngemm_acc(acc, F_HB + (size_t)ps[e] * DEXP, DEXP, nullptr, tm * 128, cnt, Wd, D, c0 + tn * 64, D, DEXP, sA, sW, F.tid);
#pragma unroll
            for (int i = 0; i < 4; ++i) { const int rr = tm * 128 + ty * 4 + i; if (rr >= cnt) continue;
#pragma unroll
                for (int j = 0; j < 4; ++j) F_OUT[(size_t)(ps[e] + rr) * 512 + tn * 64 + tx * 4 + j] = (bf16_t)f2bf(acc[i][j]); }
        }
        tbase += nt;
    }
    if (c0 == 0) {
        const int ntm = ntok / 128;
        for (int t = F.bid; t < ntm * 16; t += F.G) {
            const int tm = t >> 4, tn = t & 15; float acc[4][4]; ZERO_ACC(acc);
            ngemm_acc(acc, F_HBS, DEXP, nullptr, tm * 128, ntok, FIN(I_SD) + (size_t)l * DEXP * D, D, tn * 64, D, DEXP, sA, sW, F.tid);
#pragma unroll
            for (int i = 0; i < 4; ++i) { const int r = tm * 128 + ty * 4 + i; float* xd = x_row_dst(F, r);
                const float* gf = F_MOD + ((size_t)l * 5 + row_batch(r)) * 6144 + 5 * D;
#pragma unroll
                for (int j = 0; j < 4; ++j) { const int c = tn * 64 + tx * 4 + j; xd[c] += gf[c] * acc[i][j]; } }
        }
    }
}
typedef float f32x2_t __attribute__((ext_vector_type(2)));
__device__ __forceinline__ void acc16(f32x2_t (&s)[8], float w, const g8::u32x4& v) {
    const f32x2_t w2 = {w, w};
#pragma unroll
    for (int q = 0; q < 4; ++q) { const f32x2_t lo = __builtin_amdgcn_cvt_pk_f32_fp8(v[q], false), hi = __builtin_amdgcn_cvt_pk_f32_fp8(v[q], true);
        s[2 * q] = __builtin_elementwise_fma(w2, lo, s[2 * q]); s[2 * q + 1] = __builtin_elementwise_fma(w2, hi, s[2 * q + 1]); } }
template <bool NORM_NEXT> __device__ __forceinline__ void p_combine(Frame& F, int l, int ntok) {
    const int gw = F.bid * NWAVES + F.wave, NGW = F.G * NWAVES, lane = F.lane;
    const float* g1 = NORM_NEXT ? FIN(I_N1G) + (l + 1) * D : nullptr;
    const unsigned char* OUT8 = (const unsigned char*)F_OUT;
    LAS int* tabI = (LAS int*)((LAS unsigned char*)F.lds) + F.wave * 512; LAS float* tabW = (LAS float*)(tabI + 256);
    constexpr int NLB = ML / 16;
    const int nseg = NLB + (ntok > ML ? ntok - ML : 0);
    for (int seg = gw; seg < nseg; seg += NGW) {
        const int r0 = seg < NLB ? seg * 16 : ML + (seg - NLB), n = seg < NLB ? 16 : 1;
        int l16 = lane * 16; asm volatile("" : "+v"(l16));
        for (int e = lane; e < n * TOPK; e += 64) { tabI[e] = F_INV[r0 * TOPK + e]; tabW[e] = F_WTS[r0 * TOPK + e]; }
        const int bt = row_batch(r0);
        g8::f32x4 gt[4], gs[4], sh[4];
        { const float* gf = F_MOD + ((size_t)l * 5 + bt) * 6144 + 5 * D + l16;
#pragma unroll
          for (int q = 0; q < 4; ++q) gt[q] = *(const g8::f32x4*)(gf + 4 * q);
          if constexpr (NORM_NEXT) { const float* mod = F_MOD + ((size_t)(l + 1) * 5 + bt) * 6144 + l16;
#pragma unroll
              for (int q = 0; q < 4; ++q) { sh[q] = *(const g8::f32x4*)(mod + 4 * q); gs[q] = *(const g8::f32x4*)(g1 + l16 + 4 * q) * (*(const g8::f32x4*)(mod + D + 4 * q) + 1.0f); } } }
        asm volatile("s_waitcnt vmcnt(0) lgkmcnt(0)" ::: "memory");
        for (int j = 0; j < n; j += 2) {
            const bool hb = j + 1 < n; const int ra = r0 + j, jb = hb ? j + 1 : j, rb_ = r0 + jb;
            bf16_t* xa = F_X16 + (size_t)ra * D + l16; bf16_t* xb = F_X16 + (size_t)rb_ * D + l16;
            int ia[TOPK], ib[TOPK]; float wa[TOPK], wb[TOPK];
#pragma unroll
            for (int k = 0; k < TOPK; ++k) { ia[k] = tabI[j * TOPK + k]; ib[k] = tabI[jb * TOPK + k]; wa[k] = tabW[j * TOPK + k]; wb[k] = tabW[jb * TOPK + k]; }
            g8::u32x4 va[TOPK], vb[TOPK];
#pragma unroll
            for (int k = 0; k < TOPK; ++k) { va[k] = *(const g8::u32x4*)(OUT8 + (size_t)ia[k] * 1024 + l16); vb[k] = *(const g8::u32x4*)(OUT8 + (size_t)ib[k] * 1024 + l16); }
            const bf16_t* shp = FWS(bf16_t, WS_SCR) + l16; const g8::u32x4 sha0 = *(const g8::u32x4*)(shp + (size_t)ra * 1024), sha1 = *(const g8::u32x4*)(shp + (size_t)ra * 1024 + 8), shb0 = *(const g8::u32x4*)(shp + (size_t)rb_ * 1024), shb1 = *(const g8::u32x4*)(shp + (size_t)rb_ * 1024 + 8);
            const g8::u32x4 xa0 = *(const g8::u32x4*)xa, xa1 = *(const g8::u32x4*)(xa + 8), xb0 = *(const g8::u32x4*)xb, xb1 = *(const g8::u32x4*)(xb + 8);
            f32x2_t sa2[8], sb2[8];
#pragma unroll
            for (int i = 0; i < 8; ++i) { sa2[i] = (f32x2_t){0.f, 0.f}; sb2[i] = (f32x2_t){0.f, 0.f}; }
#pragma unroll
            for (int k = 0; k < TOPK; ++k) { acc16(sa2, wa[k], va[k]); acc16(sb2, wb[k], vb[k]); }
            float sa[16], sb[16];
#pragma unroll
            for (int i = 0; i < 8; ++i) { sa[2 * i] = sa2[i][0]; sa[2 * i + 1] = sa2[i][1]; sb[2 * i] = sb2[i][0]; sb[2 * i + 1] = sb2[i][1]; }
            { g8::f32x4 a0, a1; g8::unpack8(sha0, a0, a1); _Pragma("unroll") for (int i = 0; i < 4; ++i) { sa[i] += a0[i]; sa[4 + i] += a1[i]; } g8::unpack8(sha1, a0, a1); _Pragma("unroll") for (int i = 0; i < 4; ++i) { sa[8 + i] += a0[i]; sa[12 + i] += a1[i]; }
              g8::unpack8(shb0, a0, a1); _Pragma("unroll") for (int i = 0; i < 4; ++i) { sb[i] += a0[i]; sb[4 + i] += a1[i]; } g8::unpack8(shb1, a0, a1); _Pragma("unroll") for (int i = 0; i < 4; ++i) { sb[8 + i] += a0[i]; sb[12 + i] += a1[i]; } }
            g8::f32x4 xav[4], xbv[4];
            g8::unpack8(xa0, xav[0], xav[1]); g8::unpack8(xa1, xav[2], xav[3]); g8::unpack8(xb0, xbv[0], xbv[1]); g8::unpack8(xb1, xbv[2], xbv[3]);
#pragma unroll
            for (int q = 0; q < 4; ++q)
#pragma unroll
                for (int i = 0; i < 4; ++i) { xav[q][i] += gt[q][i] * sa[4 * q + i]; xbv[q][i] += gt[q][i] * sb[4 * q + i]; }
            if constexpr (!NORM_NEXT) {
#pragma unroll
                for (int q = 0; q < 4; ++q) { *(g8::f32x4*)(F_out + (size_t)ra * D + l16 + 4 * q) = xav[q]; if (hb) *(g8::f32x4*)(F_out + (size_t)rb_ * D + l16 + 4 * q) = xbv[q]; }
            } else {
                *(g8::u32x4*)xa = g8::pack8(xav[0], xav[1]); *(g8::u32x4*)(xa + 8) = g8::pack8(xav[2], xav[3]);
                if (hb) { *(g8::u32x4*)xb = g8::pack8(xbv[0], xbv[1]); *(g8::u32x4*)(xb + 8) = g8::pack8(xbv[2], xbv[3]); }
#pragma unroll
                for (int t = 0; t < 2; ++t) { if (t == 1 && !hb) break; const int r = t ? rb_ : ra;
                    const g8::f32x4 v0 = t ? xbv[0] : xav[0], v1 = t ? xbv[1] : xav[1], v2 = t ? xbv[2] : xav[2], v3 = t ? xbv[3] : xav[3];
                    const float rstd = 1.0f / sqrtf(wave_sum(sumsq8(v0, v1) + sumsq8(v2, v3)) * (1.0f / D) + EPS);
                    *(g8::u32x4*)(F_H + (size_t)r * D + l16) = g8::pack8(v0 * rstd * gs[0] + sh[0], v1 * rstd * gs[1] + sh[1]);
                    *(g8::u32x4*)(F_H + (size_t)r * D + l16 + 8) = g8::pack8(v2 * rstd * gs[2] + sh[2], v3 * rstd * gs[3] + sh[3]); }
            }
        }
    }
}
__device__ __forceinline__ void cvt_item(const float* W, int ldw, int k0, int n0, bf16_t* dst  , int ldt, LAS float* scr, int lane, const float* gk = nullptr  ) {
#pragma unroll 8
    for (int i = 0; i < 32; ++i) { const int kk = 2 * i + (lane >> 5); scr[kk * 33 + (lane & 31)] = W[(size_t)(k0 + kk) * ldw + n0 + (lane & 31)] * (gk ? gk[k0 + kk] : 1.0f); }
    asm volatile("s_waitcnt lgkmcnt(0)" ::: "memory");
    const int c = lane & 7;
#pragma unroll
    for (int j = 0; j < 4; ++j) { const int n = (lane >> 3) + 8 * j; const LAS float* s = scr + (8 * c) * 33 + n;
        uint4 o; o.x = g8::cvtpk(s[0 * 33], s[1 * 33]); o.y = g8::cvtpk(s[2 * 33], s[3 * 33]); o.z = g8::cvtpk(s[4 * 33], s[5 * 33]); o.w = g8::cvtpk(s[6 * 33], s[7 * 33]);
        *(uint4*)(dst + (size_t)n * ldt + k0 + 8 * c) = o; }
    asm volatile("s_waitcnt lgkmcnt(0)" ::: "memory");
}
#define CVT_JOBG(Wp, Kk, ldw_, c0_, ncols_, dstp, gk_) do { const int _nb = (ncols_) / 32, _ni = ((Kk) / 64) * _nb; \
    if (it < _ni) { const int _kb = it / _nb, _nbi = it % _nb; cvt_item((Wp), (ldw_), 64 * _kb, (c0_) + 32 * _nbi, (dstp) + (size_t)(32 * _nbi) * (Kk), (Kk), scr, lane, (gk_)); return; } it -= _ni; } while (0)
#define CVT_JOB(Wp, Kk, ldw_, c0_, ncols_, dstp) do { const int _nb = (ncols_) / 32, _ni = ((Kk) / 64) * _nb; \
    if (it < _ni) { const int _kb = it / _nb, _nbi = it % _nb; cvt_item((Wp), (ldw_), 64 * _kb, (c0_) + 32 * _nbi, (dstp) + (size_t)(32 * _nbi) * (Kk), (Kk), scr, lane); return; } it -= _ni; } while (0)
constexpr int CVT_SMALL_ITEMS = 16 * 85 + 16 * 32 + 16 * 96 + 6 * 24 + 4 * 32 + 3 * 8 * 32 + 16 * 32 + 2 * 16 * 8 + 4 * 32;
__device__ __forceinline__ void cvt_small_item(Frame& F, int l, int it, LAS float* scr, int lane) {
    unsigned char* base = ws_(F.A) + WS_WSM + (size_t)l * SMW_L;
    const float* win = FIN(I_WIN) + (size_t)l * D * N_IN;
    CVT_JOB(win, 1024, N_IN, 0, 2720, (bf16_t*)(base + SMW_WIN));
    CVT_JOB(win, 1024, N_IN, 2720, 1024, (bf16_t*)(base + SMW_WIN) + (size_t)2816 * 1024);
    CVT_JOB(win, 1024, N_IN, 3744, 3072, (bf16_t*)(base + SMW_WG));
#pragma unroll
    for (int hh = 0; hh < 8; ++hh) CVT_JOBG(FIN(I_WUQ) + (size_t)l * 384 * 768, 384, 768, hh * 96, 96, (bf16_t*)(base + SMW_WUQ) + (size_t)hh * 128 * 384, FIN(I_QAG) + l * 384);
    CVT_JOBG(FIN(I_WUKV) + (size_t)l * 256 * 1024, 256, 1024, 0, 1024, (bf16_t*)(base + SMW_WUKV), FIN(I_KVAG) + l * 256);
    CVT_JOB(FIN(I_WBRRET) + (size_t)l * 512 * D, 512, D, 0, D, (bf16_t*)(base + SMW_WBR));
    CVT_JOB(FIN(I_WBRMLA) + (size_t)l * 512 * D, 512, D, 0, D, (bf16_t*)(base + SMW_WBR) + (size_t)1024 * 512);
    CVT_JOB(FIN(I_WBRG) + (size_t)l * 512 * D, 512, D, 0, D, (bf16_t*)(base + SMW_WBR) + (size_t)2 * 1024 * 512);
    CVT_JOB(FIN(I_WOUT) + (size_t)l * D * D, 1024, D, 0, D, (bf16_t*)(base + SMW_WOUT));
    CVT_JOB(FIN(I_SG) + (size_t)l * D * DEXP, 1024, DEXP, 0, 128, (bf16_t*)(base + SMW_SHGU));
    CVT_JOB(FIN(I_SG) + (size_t)l * D * DEXP, 1024, DEXP, 128, 128, (bf16_t*)(base + SMW_SHGU) + (size_t)256 * 1024);
    CVT_JOB(FIN(I_SU) + (size_t)l * D * DEXP, 1024, DEXP, 0, 128, (bf16_t*)(base + SMW_SHGU) + (size_t)128 * 1024);
    CVT_JOB(FIN(I_SU) + (size_t)l * D * DEXP, 1024, DEXP, 128, 128, (bf16_t*)(base + SMW_SHGU) + (size_t)384 * 1024);
    CVT_JOB(FIN(I_SD) + (size_t)l * DEXP * D, 256, D, 0, D, (bf16_t*)(base + SMW_SHD));
}
constexpr int CVT_MOE_ITEMS_PER_E = 4 * 16 * 4 + 4 * 32;
__device__ __forceinline__ void cvt_moe_item(Frame& F, int l, int itg, LAS float* scr, int lane) {
    const int e = itg / CVT_MOE_ITEMS_PER_E; int it = itg % CVT_MOE_ITEMS_PER_E;
    unsigned char* base = ws_(F.A) + WS_MOEW + (size_t)e * (1536 * 1024);
    const float* wg = FIN(I_WG) + ((size_t)l * NEXP + e) * D * DEXP; const float* wu = FIN(I_WU) + ((size_t)l * NEXP + e) * D * DEXP;
    CVT_JOB(wg, 1024, DEXP, 0, 128, (bf16_t*)base);
    CVT_JOB(wg, 1024, DEXP, 128, 128, (bf16_t*)base + (size_t)256 * 1024);
    CVT_JOB(wu, 1024, DEXP, 0, 128, (bf16_t*)base + (size_t)128 * 1024);
    CVT_JOB(wu, 1024, DEXP, 128, 128, (bf16_t*)base + (size_t)384 * 1024);
    CVT_JOB(FIN(I_WD) + ((size_t)l * NEXP + e) * DEXP * D, 256, D, 0, D, (bf16_t*)(base + 1024 * 1024));
}
__device__ __forceinline__ void p_cvt_small(Frame& F) {
    LAS float* scr = (LAS float*)((LAS unsigned char*)F.lds + F.wave * 16384);
    const int gw = F.bid * NWAVES + F.wave, NGW = F.G * NWAVES;
    for (int it = gw; it < 2 * CVT_SMALL_ITEMS; it += NGW) cvt_small_item(F, it / CVT_SMALL_ITEMS, it % CVT_SMALL_ITEMS, scr, F.lane);
    for (int i = F.bid * NTHR + F.tid; i < 2 * 64 * 1024; i += F.G * NTHR) { const int l = i >> 16, e = (i >> 10) & 63, k = i & 1023;
        const float v = FIN(I_ROUTER)[(size_t)l * D * NEXP + k * NEXP + e]; const unsigned h = f2bf(v); const float vh = __builtin_bit_cast(float, h << 16);
        bf16_t* rt = (bf16_t*)(ws_(F.A) + WS_WSM + (size_t)l * SMW_L + SMW_RT); rt[e * 1024 + k] = (bf16_t)h; rt[64 * 1024 + e * 1024 + k] = (bf16_t)f2bf(v - vh); }
    for (int i = F.bid * NTHR + F.tid; i < 2 * 8 * 32 * 768 / 16; i += F.G * NTHR) { const int l = i / (8 * 32 * 48), rem = i % (8 * 32 * 48), hh = rem / (32 * 48), w = rem % (32 * 48);
        ((uint4*)(ws_(F.A) + WS_WSM + (size_t)l * SMW_L + SMW_WUQ + (size_t)(hh * 128 + 96) * 768))[w] = make_uint4(0u, 0u, 0u, 0u); }
    for (int l = 0; l < 2; ++l) { uint4* z = (uint4*)(ws_(F.A) + WS_WSM + (size_t)l * SMW_L + SMW_WIN + (size_t)2720 * 2048);
        for (int i = F.bid * NTHR + F.tid; i < 96 * 2048 / 16; i += F.G * NTHR) z[i] = make_uint4(0u, 0u, 0u, 0u); }
}
struct CvtPanel { const float* W; int ldw; bf16_t* dst0; int ldt; int gu_map, up; };
__device__ __forceinline__ CvtPanel cvt_moe_panel(Frame& F, int l, int it) {
    const int e = it / 48, p = it % 48; unsigned char* base = ws_(F.A) + WS_MOEW + (size_t)e * (1536 * 1024); CvtPanel c;
    if (p < 32) { const int up = p >> 4, kb = p & 15; c.W = FIN(up ? I_WU : I_WG) + ((size_t)l * NEXP + e) * D * DEXP + (size_t)kb * 64 * DEXP; c.ldw = DEXP; c.dst0 = (bf16_t*)base + kb * 64; c.ldt = 1024; c.gu_map = 1; c.up = up; }
    else { const int q = p - 32, kb = q >> 2, nb = q & 3; c.W = FIN(I_WD) + ((size_t)l * NEXP + e) * DEXP * D + (size_t)kb * 64 * D + nb * 256; c.ldw = D; c.dst0 = (bf16_t*)(base + 1024 * 1024) + (size_t)nb * 256 * 256 + kb * 64; c.ldt = 256; c.gu_map = 0; c.up = 0; }
    return c;
}
__device__ __forceinline__ void p_cvt_moe(Frame& F, int l) {
    LAS float* scr = (LAS float*)((LAS unsigned char*)F.lds); const int tid = F.tid;
    const int nit = NEXP * 48; int it = F.bid; if (it >= nit) return;
    CvtPanel cur = cvt_moe_panel(F, l, it); g8::f32x4 rv[8];
#pragma unroll
    for (int i = 0; i < 8; ++i) { const int idx = tid + i * 512, kk = idx >> 6, c4 = (idx & 63) * 4; rv[i] = *(const g8::f32x4*)(cur.W + (size_t)kk * cur.ldw + c4); }
    for (;;) {
        __syncthreads();
#pragma unroll
        for (int i = 0; i < 8; ++i) { const int idx = tid + i * 512, kk = idx >> 6, c4 = (idx & 63) * 4; LAS float* p = scr + kk * 257 + c4; p[0] = rv[i][0]; p[1] = rv[i][1]; p[2] = rv[i][2]; p[3] = rv[i][3]; }
        __syncthreads();
        const int nx = it + F.G; const bool more = nx < nit; CvtPanel nxt = cur;
        if (more) { nxt = cvt_moe_panel(F, l, nx);
#pragma unroll
            for (int i = 0; i < 8; ++i) { const int idx = tid + i * 512, kk = idx >> 6, c4 = (idx & 63) * 4; rv[i] = *(const g8::f32x4*)(nxt.W + (size_t)kk * nxt.ldw + c4); } }
        { const int n = tid >> 1, k0 = (tid & 1) * 32; const int row = cur.gu_map ? ((n >> 7) * 256 + cur.up * 128 + (n & 127)) : n;
          bf16_t* d = cur.dst0 + (size_t)row * cur.ldt + k0;
#pragma unroll
          for (int j = 0; j < 4; ++j) { g8::f32x4 a, b;
#pragma unroll
              for (int e = 0; e < 4; ++e) { a[e] = scr[(k0 + j * 8 + e) * 257 + n]; b[e] = scr[(k0 + j * 8 + 4 + e) * 257 + n]; }
              *(g8::u32x4*)(d + j * 8) = g8::pack8(a, b); } }
        if (!more) break;
        cur = nxt; it = nx;
    }
    __syncthreads();
}

__device__ __forceinline__ void rope8_fly(g8::f32x4& a, g8::f32x4& b, const g8::f32x4& pa, const g8::f32x4& pb, float pos, bool first) {
    const float ir[8] = {0.15915494309f, 0.05032921210f, 0.01591549431f, 0.00503292121f, 0.00159154943f, 0.00050329212f, 0.00015915494f, 0.00005032921f};
#pragma unroll
    for (int e = 0; e < 4; ++e) { const float x0 = __builtin_amdgcn_fractf(pos * ir[e]), x1 = __builtin_amdgcn_fractf(pos * ir[4 + e]);
        const float c0 = __builtin_amdgcn_cosf(x0), s0 = __builtin_amdgcn_sinf(x0), c1 = __builtin_amdgcn_cosf(x1), s1 = __builtin_amdgcn_sinf(x1);
        if (first) { a[e] = a[e] * c0 - pa[e] * s0; b[e] = b[e] * c1 - pb[e] * s1; } else { a[e] = pa[e] * s0 + a[e] * c0; b[e] = pb[e] * s1 + b[e] * c1; } }
}
__device__ __forceinline__ void rope8(g8::f32x4& a, g8::f32x4& b, const g8::f32x4& pa, const g8::f32x4& pb, const float* tab, int vi) {
    const int ax = vi >> 1; const bool first = (vi & 1) == 0;
    const g8::f32x4 c0 = *(const g8::f32x4*)(tab + ax * 16), c1 = *(const g8::f32x4*)(tab + ax * 16 + 4), s0 = *(const g8::f32x4*)(tab + ax * 16 + 8), s1 = *(const g8::f32x4*)(tab + ax * 16 + 12);
    if (first) { a = a * c0 - pa * s0; b = b * c1 - pb * s1; } else { a = pa * s0 + a * c0; b = pb * s1 + b * c1; }
}

using g8::f32x4; using g8::u32x4; using g8::GUnit;
#define EPI_ARGS const f32x4 (&acc)[2][2][4][2], const GUnit& u, int wr, int wc, int fr, int fq, int tid
#define EPI_FOR(...) do { _Pragma("unroll") for (int ai = 0; ai < 2; ++ai) _Pragma("unroll") for (int m = 0; m < 4; ++m) { const int lr = ai * 128 + wr * 64 + m * 16 + fr; \
    _Pragma("unroll") for (int bj = 0; bj < 2; ++bj) { const int lc = bj * 128 + wc * 32 + 8 * fq; f32x4 v0 = acc[ai][bj][m][0], v1 = acc[ai][bj][m][1]; const int gi = (ai * 4 + m) * 2 + bj; (void)gi; __VA_ARGS__ } asm volatile("" ::: "memory"); } } while (0)
__device__ __forceinline__ f32x4 gelu4(f32x4 x) { f32x4 o;
#pragma unroll
    for (int i = 0; i < 4; ++i) { const float t = x[i]; o[i] = t * g8::fsigmoid(1.5957691216057308f * (t + 0.044715f * t * t * t)); } return o; }

struct SchedInproj { const char* A; const char* B; int G, c;
    __device__ __forceinline__ bool get(int i, GUnit& u) const { int pm, pn; if (!g8::tile_order(i, G, c, M / 256, 15, pm, pn)) return false;
        u.A = A; u.B = B + (size_t)pn * 256 * 2048; u.rows = nullptr; u.arow0 = pm * 256; u.lda2 = 2048u; u.ldb2 = 2048u; u.nt = 16; u.pm = pm; u.pn = pn; u.tag = 0; return true; } };
__device__ __forceinline__ float fq_sum(float v, int lane) {
    v += __builtin_bit_cast(float, __builtin_amdgcn_ds_bpermute((lane ^ 16) << 2, __builtin_bit_cast(int, v)));
    v += __builtin_bit_cast(float, __builtin_amdgcn_ds_bpermute((lane ^ 32) << 2, __builtin_bit_cast(int, v))); return v; }
struct EpiInproj { bf16_t *RET, *CQ, *CKV, *KR, *UV; float *PART, *PARTV; const float *krg, *rope;
    __device__ __forceinline__ void operator()(EPI_ARGS) const {
        const int r0 = u.pm * 256, lane = tid & 63;
        if (u.pn < 8) { const float sc = (u.pn == 2 || u.pn == 3) ? 0.08838834764831845f : 1.0f;
            EPI_FOR({ *(u32x4*)(RET + (size_t)(r0 + lr) * 2048 + u.pn * 256 + lc) = g8::pack8(v0 * sc, v1 * sc); });
        } else if (u.pn < 11) {
            const bool lat = r0 < ML;
            EPI_FOR({ const int c = (u.pn - 8) * 256 + lc; const int r = r0 + lr;
                const float ss = fq_sum(sumsq8(v0, v1), lane); if (fq == 0 && c < 672) PART[(size_t)r * 24 + (c >> 5)] = ss;
                if (c < 384) *(u32x4*)(CQ + (size_t)r * 384 + c) = g8::pack8(v0, v1);
                else if (c < 640) *(u32x4*)(CKV + (size_t)r * 256 + (c - 384)) = g8::pack8(v0, v1);
                else if (c < 672) {
                    const float rstd = 1.0f / sqrtf(ss * (1.0f / 32.f) + EPS); const g8::f32x4 g0 = *(const g8::f32x4*)(krg + 8 * fq), g1 = *(const g8::f32x4*)(krg + 8 * fq + 4);
                    g8::f32x4 y0 = v0 * rstd * g0, y1 = v1 * rstd * g1, p0, p1;
                    _Pragma("unroll") for (int i = 0; i < 4; ++i) { p0[i] = __builtin_bit_cast(float, __builtin_amdgcn_ds_bpermute((lane ^ 16) << 2, __builtin_bit_cast(int, y0[i]))); p1[i] = __builtin_bit_cast(float, __builtin_amdgcn_ds_bpermute((lane ^ 16) << 2, __builtin_bit_cast(int, y1[i]))); }
                    if (lat) { const int t = r & (SEQ - 1); rope8_fly(y0, y1, p0, p1, (float)((fq >> 1) ? (t & 63) : (t >> 6)), (fq & 1) == 0); }
                    *(u32x4*)(KR + (size_t)r * 32 + 8 * fq) = g8::pack8(y0, y1); } });
        } else {
            EPI_FOR({ const g8::f32x4 z0 = gelu4(v0), z1 = gelu4(v1); const int c = (u.pn - 11) * 256 + lc; const int r = r0 + lr;
                *(u32x4*)(UV + (size_t)r * 1024 + c) = g8::pack8(z0, z1);
                if (u.pn >= 13) { const float s1 = fq_sum((z0[0] + z0[1]) + (z0[2] + z0[3]) + (z1[0] + z1[1]) + (z1[2] + z1[3]), lane), s2 = fq_sum(sumsq8(z0, z1), lane);
                    if (fq == 0) { float* pp = PARTV + ((size_t)r * 16 + ((c - 512) >> 5)) * 2; pp[0] = s1; pp[1] = s2; } } });
        }
    } };
struct SchedMlaUp { const char *CQ, *CKV, *WQ, *WKV; int G, c;
    __device__ __forceinline__ bool get(int i, GUnit& u) const { int pm, pn; if (!g8::tile_order(i, G, c, M / 256, 8, pm, pn)) return false;
        u.rows = nullptr; u.arow0 = pm * 256; u.pm = pm;
        if (pn < 4) { u.A = CQ; u.lda2 = 768u; u.B = WQ + (size_t)pn * 256 * 768; u.ldb2 = 768u; u.nt = 6; u.pn = pn; u.tag = 0; }
        else { u.A = CKV; u.lda2 = 512u; u.B = WKV + (size_t)(pn - 4) * 256 * 512; u.ldb2 = 512u; u.nt = 4; u.pn = pn - 4; u.tag = 1; }
        return true; } };
#define EPI_BAR() do { asm volatile("s_waitcnt lgkmcnt(0)" ::: "memory"); __builtin_amdgcn_s_barrier(); asm volatile("" ::: "memory"); } while (0)
struct EpiMlaFused { bf16_t *Q, *K, *V; const bf16_t* KRN; const float *qng, *kng, *rope, *PART; LAS float* SS;
    __device__ __forceinline__ void operator()(EPI_ARGS) const {
        const int r0 = u.pm * 256, lane = tid & 63;
        const bool act = (u.tag == 0) ? (wc < 3) : (wc < 2);
        float rs[8];
#pragma unroll
        for (int ai = 0; ai < 2; ++ai)
#pragma unroll
            for (int m = 0; m < 4; ++m) { const float* pp = PART + (size_t)(r0 + ai * 128 + wr * 64 + m * 16 + fr) * 24;
                if (u.tag == 0) { const g8::f32x4 a = *(const g8::f32x4*)pp, b = *(const g8::f32x4*)(pp + 4), c = *(const g8::f32x4*)(pp + 8);
                    rs[ai * 4 + m] = 1.0f / sqrtf((((a[0] + a[1]) + (a[2] + a[3])) + ((b[0] + b[1]) + (b[2] + b[3])) + ((c[0] + c[1]) + (c[2] + c[3]))) * (1.0f / 384.f) + EPS); }
                else { const g8::f32x4 a = *(const g8::f32x4*)(pp + 12), b = *(const g8::f32x4*)(pp + 16);
                    rs[ai * 4 + m] = 1.0f / sqrtf((((a[0] + a[1]) + (a[2] + a[3])) + ((b[0] + b[1]) + (b[2] + b[3]))) * (1.0f / 256.f) + EPS); } }
        EPI_FOR({ const float rsr = rs[ai * 4 + m]; v0 = v0 * rsr; v1 = v1 * rsr; float ss = sumsq8(v0, v1);
            ss += __builtin_bit_cast(float, __builtin_amdgcn_ds_bpermute((lane ^ 16) << 2, __builtin_bit_cast(int, ss)));
            ss += __builtin_bit_cast(float, __builtin_amdgcn_ds_bpermute((lane ^ 32) << 2, __builtin_bit_cast(int, ss)));
            if (fq == 0) SS[(lr * 2 + bj) * 4 + wc] = act ? ss : 0.f; });
        u32x4 krn[8];
        if (u.tag == 1 && wc == 2) {
#pragma unroll
            for (int i = 0; i < 8; ++i) krn[i] = *(const u32x4*)(KRN + (size_t)(r0 + (i >> 2) * 128 + wr * 64 + (i & 3) * 16 + fr) * 32 + 8 * fq); }
        EPI_BAR();
        const int hcg = (u.tag == 0 ? (wc < 3 ? wc : 0) : (wc & 1)) * 32 + 8 * fq; const float* gp_ = (u.tag == 0 ? qng : kng) + hcg;
        const g8::f32x4 gq0 = *(const g8::f32x4*)gp_, gq1 = *(const g8::f32x4*)(gp_ + 4);
        if (u.tag == 0) {
            const bool lat = r0 < ML;
            EPI_FOR({ const float rsr = rs[ai * 4 + m]; v0 = v0 * rsr; v1 = v1 * rsr; const g8::f32x4 t = *(const LAS g8::f32x4*)(SS + (lr * 2 + bj) * 4); const float rstd = 1.0f / sqrtf(((t[0] + t[1]) + t[2]) * (1.0f / 96.f) + EPS);
                if (wc < 3) { const int hc = wc * 32 + 8 * fq;
                    g8::f32x4 y0 = v0 * rstd * gq0, y1 = v1 * rstd * gq1;
                    if (wc == 2 && lat) { g8::f32x4 p0, p1;
                        _Pragma("unroll") for (int i = 0; i < 4; ++i) { p0[i] = __builtin_bit_cast(float, __builtin_amdgcn_ds_bpermute((lane ^ 16) << 2, __builtin_bit_cast(int, y0[i]))); p1[i] = __builtin_bit_cast(float, __builtin_amdgcn_ds_bpermute((lane ^ 16) << 2, __builtin_bit_cast(int, y1[i]))); }
                        const int t = (r0 + lr) & (SEQ - 1); rope8_fly(y0, y1, p0, p1, (float)((fq >> 1) ? (t & 63) : (t >> 6)), (fq & 1) == 0); }
                    *(u32x4*)(Q + (size_t)(r0 + lr) * 768 + (2 * u.pn + bj) * 96 + hc) = g8::pack8(y0 * QSCALE, y1 * QSCALE); } });
        } else {
            EPI_FOR({ const int h = 2 * u.pn + bj; const float rsr = rs[ai * 4 + m]; v0 = v0 * rsr; v1 = v1 * rsr;
                if (wc < 2) { const LAS float* t = SS + (lr * 2 + bj) * 4; const float rk = 1.0f / sqrtf((t[0] + t[1]) * (1.0f / 64.f) + EPS); const int hc = wc * 32 + 8 * fq;
                    *(u32x4*)(K + (size_t)(r0 + lr) * 768 + h * 96 + hc) = g8::pack8(v0 * rk * gq0, v1 * rk * gq1); }
                else { *(u32x4*)(V + (size_t)(r0 + lr) * 512 + h * 64 + (wc - 2) * 32 + 8 * fq) = g8::pack8(v0, v1);
                    if (wc == 2) *(u32x4*)(K + (size_t)(r0 + lr) * 768 + h * 96 + 64 + 8 * fq) = krn[ai * 4 + m]; } });
        }
        EPI_BAR();
    } };
struct SchedMerge { const char *H, *WG, *ABR, *WBR; unsigned lda2; int G, c, nM;
    __device__ __forceinline__ bool get(int i, GUnit& u) const { int pm, pn; if (!g8::tile_order(i >> 1, G, c, nM, 4, pm, pn)) return false;
        u.rows = nullptr; u.arow0 = pm * 256; u.pm = pm; u.pn = pn; u.tag = i & 1;
        if ((i & 1) == 0) { u.A = H; u.lda2 = 2048u; u.B = WG + (size_t)(pn * 256) * 2048; u.ldb2 = 2048u; u.nt = 16; }
        else { u.A = ABR; u.lda2 = lda2; u.B = WBR + (size_t)pn * 256 * 1024; u.ldb2 = 1024u; u.nt = 8; }
        return true; } };
template <int BR> struct EpiMerge { bf16_t* Y; u32x4* scrT;
    __device__ __forceinline__ void operator()(EPI_ARGS) const {
        const int r0 = u.pm * 256;
        if (u.tag == 0) { EPI_FOR({ f32x4 s0, s1;
                _Pragma("unroll") for (int i = 0; i < 4; ++i) { s0[i] = g8::fsigmoid(v0[i]); s1[i] = g8::fsigmoid(v1[i]); }
                scrT[gi * 512 + tid] = g8::pack8(s0, s1); });
        } else {
#pragma unroll
            for (int ai = 0; ai < 2; ++ai) { u32x4 tv[4][2], yv[4][2];
#pragma unroll
                for (int m = 0; m < 4; ++m)
#pragma unroll
                    for (int bj = 0; bj < 2; ++bj) { const int lr = ai * 128 + wr * 64 + m * 16 + fr, lc = bj * 128 + wc * 32 + 8 * fq, gi = (ai * 4 + m) * 2 + bj;
                        tv[m][bj] = scrT[gi * 512 + tid]; if (BR > 0) yv[m][bj] = *(const u32x4*)(Y + (size_t)(r0 + lr) * 1024 + u.pn * 256 + lc); }
#pragma unroll
                for (int m = 0; m < 4; ++m)
#pragma unroll
                    for (int bj = 0; bj < 2; ++bj) { const int lr = ai * 128 + wr * 64 + m * 16 + fr, lc = bj * 128 + wc * 32 + 8 * fq;
                        f32x4 t0, t1; g8::unpack8(tv[m][bj], t0, t1); f32x4 y0 = t0 * acc[ai][bj][m][0], y1 = t1 * acc[ai][bj][m][1];
                        if (BR > 0) { f32x4 p0, p1; g8::unpack8(yv[m][bj], p0, p1); y0 += p0; y1 += p1; }
                        *(u32x4*)(Y + (size_t)(r0 + lr) * 1024 + u.pn * 256 + lc) = g8::pack8(y0, y1); }
                asm volatile("" ::: "memory"); }
        }
    } };
struct SchedOut { const char *Y, *W; int G, c, nM;
    __device__ __forceinline__ bool get(int i, GUnit& u) const { int pm, pn; if (!g8::tile_order(i, G, c, nM, 4, pm, pn)) return false;
        u.A = Y; u.B = W + (size_t)pn * 256 * 2048; u.rows = nullptr; u.arow0 = pm * 256; u.lda2 = 2048u; u.ldb2 = 2048u; u.nt = 16; u.pm = pm; u.pn = pn; u.tag = 0; return true; } };
struct EpiResid { const float* xlat32; const float* xctx32; bf16_t* X16; const float* modg; int l;
    __device__ __forceinline__ void operator()(EPI_ARGS) const {
        const int r0 = u.pm * 256; const bool lat = r0 < ML;
        const float* g = modg + (size_t)(lat ? (r0 >> 13) : 4) * 6144 + u.pn * 256 + wc * 32 + 8 * fq;
        f32x4 gv[2][2];
#pragma unroll
        for (int bj = 0; bj < 2; ++bj) { gv[bj][0] = *(const f32x4*)(g + bj * 128); gv[bj][1] = *(const f32x4*)(g + bj * 128 + 4); }
        const size_t c0 = (size_t)u.pn * 256 + wc * 32 + 8 * fq;
        bf16_t* xd0 = X16 + (size_t)r0 * D + c0;
        if (l == 0) {
            const float* xs0 = (lat ? xlat32 + (size_t)r0 * D : xctx32 + (size_t)(r0 - ML) * D) + c0;
#pragma unroll
            for (int ai = 0; ai < 2; ++ai) { f32x4 xv[4][2][2];
#pragma unroll
                for (int m = 0; m < 4; ++m)
#pragma unroll
                    for (int bj = 0; bj < 2; ++bj) { const float* xp = xs0 + (size_t)(ai * 128 + wr * 64 + m * 16 + fr) * D + bj * 128;
                        xv[m][bj][0] = *(const f32x4*)xp; xv[m][bj][1] = *(const f32x4*)(xp + 4); }
#pragma unroll
                for (int m = 0; m < 4; ++m)
#pragma unroll
                    for (int bj = 0; bj < 2; ++bj)
                        *(u32x4*)(xd0 + (size_t)(ai * 128 + wr * 64 + m * 16 + fr) * D + bj * 128) = g8::pack8(xv[m][bj][0] + gv[bj][0] * acc[ai][bj][m][0], xv[m][bj][1] + gv[bj][1] * acc[ai][bj][m][1]);
                asm volatile("" ::: "memory"); }
        } else {
#pragma unroll
            for (int ai = 0; ai < 2; ++ai) { u32x4 xw[4][2];
#pragma unroll
                for (int m = 0; m < 4; ++m)
#pragma unroll
                    for (int bj = 0; bj < 2; ++bj) xw[m][bj] = *(const u32x4*)(xd0 + (size_t)(ai * 128 + wr * 64 + m * 16 + fr) * D + bj * 128);
#pragma unroll
                for (int m = 0; m < 4; ++m)
#pragma unroll
                    for (int bj = 0; bj < 2; ++bj) { f32x4 x0, x1; g8::unpack8(xw[m][bj], x0, x1);
                        *(u32x4*)(xd0 + (size_t)(ai * 128 + wr * 64 + m * 16 + fr) * D + bj * 128) = g8::pack8(x0 + gv[bj][0] * acc[ai][bj][m][0], x1 + gv[bj][1] * acc[ai][bj][m][1]); }
                asm volatile("" ::: "memory"); }
        }
    } };
__device__ __forceinline__ void moe_tiles(Frame& F, int l, LAS int* tt) {
    __syncthreads();
    if (F.tid < 64) { const int e = F.tid; const int c = (int)F_ctl[CW_CNT + l * 64 + e]; const int n = (c + 255) >> 8; int incl = n;
#pragma unroll
        for (int o = 1; o < 64; o <<= 1) { const int v = __builtin_amdgcn_ds_bpermute(((e - o) & 63) << 2, incl); if (e >= o) incl += v; }
        const int start = incl - n; for (int j = 0; j < n; ++j) tt[1 + start + j] = e; if (e == 63) tt[0] = incl; }
    __syncthreads();
}
struct SchedGateUp { const char *H, *MOEW, *SHGU; const int* rowtok; const LAS int* tt; int G, c, nsh  ;
    __device__ __forceinline__ bool get(int i, GUnit& u) const { const int ntr = __builtin_amdgcn_readfirstlane(tt[0]);
        const int xcd = c & 7, q = i * (G >> 3) + (c >> 3), g = (q >> 1) * 8 + xcd, pn = q & 1;
        u.A = H; u.lda2 = 2048u; u.ldb2 = 2048u; u.nt = 16;
        if (g < ntr) { const int e = __builtin_amdgcn_readfirstlane(tt[1 + g]); u.rows = rowtok; u.arow0 = g * 256; u.B = MOEW + (size_t)e * (1536 * 1024) + (size_t)pn * 256 * 2048; u.pm = g; u.pn = pn; u.tag = 0; return true; }
        const int g2 = g - ntr; if (g2 >= nsh) return false;
        u.rows = nullptr; u.arow0 = g2 * 256; u.B = SHGU + (size_t)pn * 256 * 2048; u.pm = g2; u.pn = pn; u.tag = 1; return true; }
};
struct EpiGateUp { bf16_t *HB, *HBS;
    __device__ __forceinline__ void operator()(EPI_ARGS) const {
        bf16_t* dst = (u.tag == 0 ? HB : HBS) + (size_t)(u.pm * 256) * DEXP + u.pn * 128;
#pragma unroll
        for (int ai = 0; ai < 2; ++ai)
#pragma unroll
            for (int m = 0; m < 4; ++m) { const int lr = ai * 128 + wr * 64 + m * 16 + fr; f32x4 h0, h1;
#pragma unroll
                for (int i = 0; i < 4; ++i) { const float g0 = acc[ai][0][m][0][i], g1 = acc[ai][0][m][1][i];
                    h0[i] = g0 * g8::fsigmoid(g0) * acc[ai][1][m][0][i]; h1[i] = g1 * g8::fsigmoid(g1) * acc[ai][1][m][1][i]; }
                *(u32x4*)(dst + (size_t)lr * DEXP + wc * 32 + 8 * fq) = g8::pack8(h0, h1); }
    } };
struct SchedDown { const char *HB, *HBS, *MOEW, *SHD; const LAS int* tt; int G, c, nsh;
    __device__ __forceinline__ bool get(int i, GUnit& u) const { const int ntr = __builtin_amdgcn_readfirstlane(tt[0]);
        const int xcd = c & 7, q = i * (G >> 3) + (c >> 3), g = (q >> 2) * 8 + xcd, pn = q & 3;
        u.rows = nullptr; u.lda2 = 512u; u.ldb2 = 512u; u.nt = 4;
        if (g < ntr) { const int e = __builtin_amdgcn_readfirstlane(tt[1 + g]); u.A = HB; u.arow0 = g * 256; u.B = MOEW + (size_t)e * (1536 * 1024) + 1024 * 1024 + (size_t)(pn * 256) * 512; u.pm = g; u.pn = pn; u.tag = 0; return true; }
        const int g2 = g - ntr; if (g2 >= nsh) return false;
        u.A = HBS; u.arow0 = g2 * 256; u.B = SHD + (size_t)pn * 256 * 512; u.pm = g2; u.pn = pn; u.tag = 1; return true; } };
__device__ __forceinline__ unsigned pack_fp8x4(const f32x4& v) { unsigned w = 0;
    w = __builtin_amdgcn_cvt_pk_fp8_f32(__builtin_amdgcn_fmed3f(v[0], -448.f, 448.f), __builtin_amdgcn_fmed3f(v[1], -448.f, 448.f), w, false);
    w = __builtin_amdgcn_cvt_pk_fp8_f32(__builtin_amdgcn_fmed3f(v[2], -448.f, 448.f), __builtin_amdgcn_fmed3f(v[3], -448.f, 448.f), w, true); return w; }
struct EpiDown { unsigned char* OUT8; bf16_t* SHOUT;
    __device__ __forceinline__ void operator()(EPI_ARGS) const {
        if (u.tag == 0) { EPI_FOR({ uint2 w; w.x = pack_fp8x4(v0); w.y = pack_fp8x4(v1); *(uint2*)(OUT8 + (size_t)(u.pm * 256 + lr) * 1024 + u.pn * 256 + lc) = w; }); }
        else { EPI_FOR({ *(u32x4*)(SHOUT + (size_t)(u.pm * 256 + lr) * 1024 + u.pn * 256 + lc) = g8::pack8(v0, v1); }); }
    } };
namespace at {
typedef short bf16x8 __attribute__((ext_vector_type(8)));
typedef short s16x4 __attribute__((ext_vector_type(4)));
typedef float f32x16 __attribute__((ext_vector_type(16)));
constexpr int KSTR = 208, VSTR = 192, KT = 128  , KBUF = KT * KSTR, VBUF = KT * VSTR, STAGE = KBUF + VBUF, LDS_WSF = 2 * STAGE;
__device__ __forceinline__ int crow(int r, int hi) { return (r & 3) + 8 * (r >> 2) + 4 * hi; }
__device__ __forceinline__ s16x4 vtr(const LAS unsigned char* p) { return __builtin_bit_cast(s16x4, __builtin_amdgcn_ds_read_tr16_b64_v4i16((LAS s16x4*)p)); }
#define AT_BAR() do { asm volatile("s_waitcnt lgkmcnt(0)" ::: "memory"); __builtin_amdgcn_s_barrier(); asm volatile("" ::: "memory"); } while (0)
__device__ __forceinline__ void attn_unit(LAS unsigned char* lds, const bf16_t* __restrict__ Q, const bf16_t* __restrict__ K, const bf16_t* __restrict__ V, bf16_t* __restrict__ O,
                                          int h, int qrow0, int kr0, int kn0, int kr1, int kn1, int tid) {
    const int lane = tid & 63, wave = __builtin_amdgcn_readfirstlane(tid >> 6), r32 = lane & 31, hi = lane >> 5;
    unsigned ko_[3], kw_[3];
#pragma unroll
    for (int i = 0; i < 3; ++i) { const int ch = tid + 512 * i, kr = ch / 12, kc = ch % 12; ko_[i] = kr * 768 + kc * 8; kw_[i] = kr * KSTR + kc * 16; }
    const int vr = tid >> 3, vc = tid & 7; const unsigned vo = vr * 512 + vc * 8, vw = KBUF + vr * VSTR + vc * 16;
    const int nt = kn0 + kn1;
    g8::u32x4 rk[3], rv[2];
#define AT_LOAD(t) do { const int _t = (t); const int _row = _t < kn0 ? kr0 + KT * _t : kr1 + KT * (_t - kn0); const bf16_t* _kb = K + (size_t)_row * 768 + h * 96; const bf16_t* _vb = V + (size_t)_row * 512 + h * 64; \
        _Pragma("unroll") for (int _i = 0; _i < 3; ++_i) rk[_i] = *(const g8::u32x4*)(_kb + ko_[_i]); \
        rv[0] = *(const g8::u32x4*)(_vb + vo); rv[1] = *(const g8::u32x4*)(_vb + vo + 64 * 512); } while (0)
#define AT_WRITE(buf) do { LAS unsigned char* _b = lds + (buf) * STAGE; _Pragma("unroll") for (int _i = 0; _i < 3; ++_i) *(LAS g8::u32x4*)(_b + kw_[_i]) = rk[_i]; \
        *(LAS g8::u32x4*)(_b + vw) = rv[0]; *(LAS g8::u32x4*)(_b + vw + 64 * VSTR) = rv[1]; } while (0)
    AT_LOAD(0);
    bf16x8 qf[6];
    { const bf16_t* qp = Q + (size_t)(qrow0 + wave * 32 + r32) * 768 + h * 96 + hi * 8;
#pragma unroll
      for (int d0 = 0; d0 < 6; ++d0) qf[d0] = *(const bf16x8*)(qp + d0 * 16); }
    AT_WRITE(0);
    if (nt > 1) AT_LOAD(1);
    AT_BAR();
    f32x16 o0 = {}, o1 = {}; float lsum = 0.f;
    const unsigned kroff = r32 * KSTR + hi * 16;
    const unsigned vroff = KBUF + (4 * hi + ((lane & 15) >> 2)) * VSTR + ((lane >> 4) & 1) * 32 + (lane & 3) * 8;
    for (int t = 0; t < nt; ++t) {
        const LAS unsigned char* sb = lds + (t & 1) * STAGE;
        f32x16 p[4] = {};
#define AT_KLD(dst, d0) do { _Pragma("unroll") for (int x = 0; x < 4; ++x) dst[x] = *(const LAS bf16x8*)(sb + kroff + 32 * x * KSTR + (d0) * 32); } while (0)
#define AT_KMM(src, d0) do { __builtin_amdgcn_s_setprio(1); _Pragma("unroll") for (int x = 0; x < 4; ++x) p[x] = __builtin_amdgcn_mfma_f32_32x32x16_bf16(src[x], qf[d0], p[x], 0, 0, 0); __builtin_amdgcn_s_setprio(0); } while (0)
        { bf16x8 ka[4], kb[4];
          AT_KLD(ka, 0); __builtin_amdgcn_sched_barrier(0);
          AT_KLD(kb, 1); __builtin_amdgcn_sched_barrier(0); AT_KMM(ka, 0); __builtin_amdgcn_sched_barrier(0);
          AT_KLD(ka, 2); __builtin_amdgcn_sched_barrier(0); AT_KMM(kb, 1); __builtin_amdgcn_sched_barrier(0);
          AT_KLD(kb, 3); __builtin_amdgcn_sched_barrier(0); AT_KMM(ka, 2); __builtin_amdgcn_sched_barrier(0);
          AT_KLD(ka, 4); __builtin_amdgcn_sched_barrier(0); AT_KMM(kb, 3); __builtin_amdgcn_sched_barrier(0);
          AT_KLD(kb, 5); __builtin_amdgcn_sched_barrier(0); AT_KMM(ka, 4); __builtin_amdgcn_sched_barrier(0);
          AT_KMM(kb, 5); __builtin_amdgcn_sched_barrier(0); }
#undef AT_KLD
#undef AT_KMM
        float s = 0.f;
#pragma unroll
        for (int x = 0; x < 4; ++x)
#pragma unroll
            for (int r = 0; r < 16; ++r) { p[x][r] = __builtin_amdgcn_exp2f(p[x][r]); s += p[x][r]; }
        lsum += s;
#define AT_VLD(dst, ks) do { _Pragma("unroll") for (int d0 = 0; d0 < 2; ++d0) { const s16x4 lo = vtr(sb + vroff + (16 * (ks)) * VSTR + d0 * 64), hh = vtr(sb + vroff + (16 * (ks) + 8) * VSTR + d0 * 64); \
            dst[d0] = (bf16x8){lo[0], lo[1], lo[2], lo[3], hh[0], hh[1], hh[2], hh[3]}; } } while (0)
#define AT_PMM(src, ks) do { unsigned w[4]; _Pragma("unroll") for (int j = 0; j < 4; ++j) { const int r = 8 * ((ks) & 1) + 2 * j; w[j] = g8::cvtpk(p[(ks) >> 1][r], p[(ks) >> 1][r + 1]); } \
            const bf16x8 pa = __builtin_bit_cast(bf16x8, (g8::u32x4){w[0], w[1], w[2], w[3]}); __builtin_amdgcn_s_setprio(1); \
            o0 = __builtin_amdgcn_mfma_f32_32x32x16_bf16(pa, src[0], o0, 0, 0, 0); o1 = __builtin_amdgcn_mfma_f32_32x32x16_bf16(pa, src[1], o1, 0, 0, 0); __builtin_amdgcn_s_setprio(0); } while (0)
        { bf16x8 va[2], vb[2];
          AT_VLD(va, 0); __builtin_amdgcn_sched_barrier(0);
          AT_VLD(vb, 1); __builtin_amdgcn_sched_barrier(0); AT_PMM(va, 0); __builtin_amdgcn_sched_barrier(0);
          AT_VLD(va, 2); __builtin_amdgcn_sched_barrier(0); AT_PMM(vb, 1); __builtin_amdgcn_sched_barrier(0);
          AT_VLD(vb, 3); __builtin_amdgcn_sched_barrier(0); AT_PMM(va, 2); __builtin_amdgcn_sched_barrier(0);
          AT_VLD(va, 4); __builtin_amdgcn_sched_barrier(0); AT_PMM(vb, 3); __builtin_amdgcn_sched_barrier(0);
          AT_VLD(vb, 5); __builtin_amdgcn_sched_barrier(0); AT_PMM(va, 4); __builtin_amdgcn_sched_barrier(0);
          AT_VLD(va, 6); __builtin_amdgcn_sched_barrier(0); AT_PMM(vb, 5); __builtin_amdgcn_sched_barrier(0);
          AT_VLD(vb, 7); __builtin_amdgcn_sched_barrier(0); AT_PMM(va, 6); __builtin_amdgcn_sched_barrier(0);
          AT_PMM(vb, 7); __builtin_amdgcn_sched_barrier(0); }
#undef AT_VLD
#undef AT_PMM
        if (t + 1 < nt) { AT_WRITE((t + 1) & 1); if (t + 2 < nt) AT_LOAD(t + 2); }
        AT_BAR();
    }
    lsum += xlane32(lsum, lane);
    LAS float* wsf = (LAS float*)(lds + LDS_WSF) + wave * 32;
    if (hi == 0) wsf[r32] = lsum;
    asm volatile("s_waitcnt lgkmcnt(0)" ::: "memory");
    bf16_t* op = O + (size_t)(qrow0 + wave * 32) * 512 + h * 64 + r32;
#pragma unroll
    for (int r = 0; r < 16; ++r) { const int q = crow(r, hi); const float rl = 1.0f / wsf[q];
        op[(size_t)q * 512] = (bf16_t)f2bf(o0[r] * rl); op[(size_t)q * 512 + 32] = (bf16_t)f2bf(o1[r] * rl); }
    AT_BAR();
#undef AT_LOAD
#undef AT_WRITE
}
#undef AT_BAR
}

namespace at16 {
using at::bf16x8; using at::s16x4; using at::vtr;
typedef float f32x4_t __attribute__((ext_vector_type(4)));
constexpr int KSTR = 256, VSTR = 160, KT = 128, KBUF = KT * KSTR, VBUF = KT * VSTR, STAGE = KBUF + VBUF, LDS_WSF = 2 * STAGE;
#define A16_BAR() do { asm volatile("s_waitcnt lgkmcnt(0)" ::: "memory"); __builtin_amdgcn_s_barrier(); asm volatile("" ::: "memory"); } while (0)
__device__ __forceinline__ void attn_unit(LAS unsigned char* lds, const bf16_t* __restrict__ Q, const bf16_t* __restrict__ K, const bf16_t* __restrict__ V, bf16_t* __restrict__ O,
                                          int h, int qrow0, int kr0, int kn0, int kr1, int kn1, int tid) {
    const int lane = tid & 63, wave = __builtin_amdgcn_readfirstlane(tid >> 6), i16 = lane & 15, g = lane >> 4;
    unsigned ko_[3], kw_[3];
#pragma unroll
    for (int i = 0; i < 3; ++i) { const int ch = tid + 512 * i, kr = ch / 12, kc = ch % 12; ko_[i] = kr * 768 + kc * 8; kw_[i] = kr * KSTR + ((kc ^ (kr & 15)) << 4); }
    const int vr = tid >> 3, vc = tid & 7; const unsigned vo = vr * 512 + vc * 8, vw = KBUF + vr * VSTR + vc * 16;
    const int nt = kn0 + kn1;
    g8::u32x4 rk[3], rv[2];
#define A16_LOAD(t) do { const int _t = (t); const int _row = _t < kn0 ? kr0 + KT * _t : kr1 + KT * (_t - kn0); const bf16_t* _kb = K + (size_t)_row * 768 + h * 96; const bf16_t* _vb = V + (size_t)_row * 512 + h * 64; \
        _Pragma("unroll") for (int _i = 0; _i < 3; ++_i) rk[_i] = *(const g8::u32x4*)(_kb + ko_[_i]); \
        rv[0] = *(const g8::u32x4*)(_vb + vo); rv[1] = *(const g8::u32x4*)(_vb + vo + 64 * 512); } while (0)
#define A16_WRITE(buf) do { LAS unsigned char* _b = lds + (buf) * STAGE; _Pragma("unroll") for (int _i = 0; _i < 3; ++_i) *(LAS g8::u32x4*)(_b + kw_[_i]) = rk[_i]; \
        *(LAS g8::u32x4*)(_b + vw) = rv[0]; *(LAS g8::u32x4*)(_b + vw + 64 * VSTR) = rv[1]; } while (0)
    A16_LOAD(0);
    bf16x8 qf[2][3];
#pragma unroll
    for (int qb = 0; qb < 2; ++qb) { const bf16_t* qp = Q + (size_t)(qrow0 + wave * 32 + qb * 16 + i16) * 768 + h * 96 + g * 8;
#pragma unroll
        for (int s = 0; s < 3; ++s) qf[qb][s] = *(const bf16x8*)(qp + s * 32); }
    A16_WRITE(0);
    if (nt > 1) A16_LOAD(1);
    A16_BAR();
    f32x4_t o[2][4] = {}, ol[2] = {};
    const bf16x8 ones = {(short)0x3F80, (short)0x3F80, (short)0x3F80, (short)0x3F80, (short)0x3F80, (short)0x3F80, (short)0x3F80, (short)0x3F80};
    unsigned kroff[3];
#pragma unroll
    for (int s2 = 0; s2 < 3; ++s2) kroff[s2] = i16 * KSTR + (((4 * s2 + g) ^ i16) << 4);
    const unsigned vroff = KBUF + (4 * g + (i16 >> 2)) * VSTR + (i16 & 3) * 8;
#define A16_KF(kbg, s) (*(const LAS bf16x8*)(sb + kroff[s] + (16 * (kbg)) * KSTR))
#define A16_VLD(vfx, hf, ks2) do { _Pragma("unroll") for (int dvb = 0; dvb < 4; ++dvb) { const LAS unsigned char* vp = sb + vroff + (64 * (hf) + 32 * (ks2)) * VSTR + dvb * 32; \
        const s16x4 lo = vtr(vp), hh = vtr(vp + 16 * VSTR); vfx[dvb] = (bf16x8){lo[0], lo[1], lo[2], lo[3], hh[0], hh[1], hh[2], hh[3]}; } } while (0)
#define A16_EXPQ(kb, qb) do { _Pragma("unroll") for (int r = 0; r < 4; ++r) st[kb][qb][r] = __builtin_amdgcn_exp2f(st[kb][qb][r]); } while (0)
#define A16_CVT(pax, ks2) do { _Pragma("unroll") for (int qb = 0; qb < 2; ++qb) { const f32x4_t a = st[2 * (ks2)][qb], b = st[2 * (ks2) + 1][qb]; \
        pax[qb] = __builtin_bit_cast(bf16x8, (g8::u32x4){g8::cvtpk(a[0], a[1]), g8::cvtpk(a[2], a[3]), g8::cvtpk(b[0], b[1]), g8::cvtpk(b[2], b[3])}); } } while (0)
#define A16_PV(pax, vfx, dvb) do { __builtin_amdgcn_s_setprio(1); _Pragma("unroll") for (int qb = 0; qb < 2; ++qb) o[qb][dvb] = __builtin_amdgcn_mfma_f32_16x16x32_bf16(pax[qb], vfx[dvb], o[qb][dvb], 0, 0, 0); __builtin_amdgcn_s_setprio(0); } while (0)
#define A16_PL(pax) do { __builtin_amdgcn_s_setprio(1); _Pragma("unroll") for (int qb = 0; qb < 2; ++qb) ol[qb] = __builtin_amdgcn_mfma_f32_16x16x32_bf16(pax[qb], ones, ol[qb], 0, 0, 0); __builtin_amdgcn_s_setprio(0); } while (0)
#define A16_SB() __builtin_amdgcn_sched_barrier(0)
    for (int t = 0; t < nt; ++t) {
        const LAS unsigned char* sb = lds + (t & 1) * STAGE;
        bf16x8 kf[2][3];
#pragma unroll
        for (int s = 0; s < 3; ++s) kf[0][s] = A16_KF(0, s);
#pragma unroll
        for (int s = 0; s < 3; ++s) kf[1][s] = A16_KF(1, s);
        A16_SB();
#pragma unroll
        for (int hf = 0; hf < 2; ++hf) {
            f32x4_t st[4][2];
            bf16x8 vf0[4], vf1[4], pa0[2], pa1[2];
#pragma unroll
            for (int kb = 0; kb < 4; ++kb) {
#pragma unroll
                for (int s = 0; s < 3; ++s) {
                    __builtin_amdgcn_s_setprio(1);
#pragma unroll
                    for (int qb = 0; qb < 2; ++qb) st[kb][qb] = __builtin_amdgcn_mfma_f32_16x16x32_bf16(kf[kb & 1][s], qf[qb][s], s == 0 ? (f32x4_t){0.f, 0.f, 0.f, 0.f} : st[kb][qb], 0, 0, 0);
                    __builtin_amdgcn_s_setprio(0);
                    if (4 * hf + kb + 2 < 8) kf[kb & 1][s] = A16_KF(4 * hf + kb + 2, s);
                    if (kb > 0 && s == 0) A16_EXPQ(kb - 1, 0);
                    if (kb > 0 && s == 1) A16_EXPQ(kb - 1, 1);
                    if (kb == 1 && s == 2) A16_VLD(vf0, hf, 0);
                    if (kb == 2 && s == 2) A16_CVT(pa0, 0);
                    if (kb == 3 && s == 2) A16_VLD(vf1, hf, 1);
                    A16_SB();
                }
            }
            A16_PV(pa0, vf0, 0); A16_EXPQ(3, 0); A16_SB();
            A16_PV(pa0, vf0, 1); A16_EXPQ(3, 1); A16_SB();
            A16_PV(pa0, vf0, 2); A16_CVT(pa1, 1); A16_SB();
            A16_PV(pa0, vf0, 3); A16_PL(pa0); A16_SB();
#pragma unroll
            for (int dvb = 0; dvb < 4; ++dvb) A16_PV(pa1, vf1, dvb);
            A16_PL(pa1);
            A16_SB();
        }
        if (t + 1 < nt) { A16_WRITE((t + 1) & 1); if (t + 2 < nt) A16_LOAD(t + 2); }
        A16_BAR();
    }
#undef A16_KF
#undef A16_VLD
#undef A16_EXPQ
#undef A16_CVT
#undef A16_PV
#undef A16_PL
#undef A16_SB
#pragma unroll
    for (int qb = 0; qb < 2; ++qb)
#pragma unroll
        for (int r = 0; r < 4; ++r) { const int q = qb * 16 + 4 * g + r; const float rl = 1.0f / ol[qb][r];
            bf16_t* op = O + (size_t)(qrow0 + wave * 32 + q) * 512 + h * 64 + i16;
#pragma unroll
            for (int dvb = 0; dvb < 4; ++dvb) op[dvb * 16] = (bf16_t)f2bf(o[qb][dvb][r] * rl); }
#undef A16_LOAD
#undef A16_WRITE
}
__device__ __forceinline__ void attn_unit64(LAS unsigned char* lds, const bf16_t* __restrict__ Q, const bf16_t* __restrict__ K, const bf16_t* __restrict__ V, bf16_t* __restrict__ O,
                                            int h, int qrow0, int kr0, int kn0, int kr1, int kn1, int tid) {
    const int lane = tid & 63, wave = __builtin_amdgcn_readfirstlane(tid >> 6), i16 = lane & 15, g = lane >> 4;
    unsigned ko_[3], kw_[3];
#pragma unroll
    for (int i = 0; i < 3; ++i) { const int ch = tid + 512 * i, kr = ch / 12, kc = ch % 12; ko_[i] = kr * 768 + kc * 8; kw_[i] = kr * KSTR + ((kc ^ (kr & 15)) << 4); }
    const int vr = tid >> 3, vc = tid & 7; const unsigned vo = vr * 512 + vc * 8, vw = KBUF + vr * VSTR + vc * 16;
    const int nt = kn0 + kn1;
    g8::u32x4 rk[3], rv[2];
#define A64_LOAD(t) do { const int _t = (t); const int _row = _t < kn0 ? kr0 + KT * _t : kr1 + KT * (_t - kn0); const bf16_t* _kb = K + (size_t)_row * 768 + h * 96; const bf16_t* _vb = V + (size_t)_row * 512 + h * 64; \
        _Pragma("unroll") for (int _i = 0; _i < 3; ++_i) rk[_i] = *(const g8::u32x4*)(_kb + ko_[_i]); \
        rv[0] = *(const g8::u32x4*)(_vb + vo); rv[1] = *(const g8::u32x4*)(_vb + vo + 64 * 512); } while (0)
#define A64_WRITE(buf) do { LAS unsigned char* _b = lds + (buf) * STAGE; _Pragma("unroll") for (int _i = 0; _i < 3; ++_i) *(LAS g8::u32x4*)(_b + kw_[_i]) = rk[_i]; \
        *(LAS g8::u32x4*)(_b + vw) = rv[0]; *(LAS g8::u32x4*)(_b + vw + 64 * VSTR) = rv[1]; } while (0)
    A64_LOAD(0);
    bf16x8 qf[4][3];
#pragma unroll
    for (int qb = 0; qb < 4; ++qb) { const bf16_t* qp = Q + (size_t)(qrow0 + wave * 64 + qb * 16 + i16) * 768 + h * 96 + g * 8;
#pragma unroll
        for (int s = 0; s < 3; ++s) qf[qb][s] = *(const bf16x8*)(qp + s * 32); }
    A64_WRITE(0);
    if (nt > 1) A64_LOAD(1);
    A16_BAR();
    f32x4_t o[4][4] = {}, ol[4] = {};
    const bf16x8 ones = {(short)0x3F80, (short)0x3F80, (short)0x3F80, (short)0x3F80, (short)0x3F80, (short)0x3F80, (short)0x3F80, (short)0x3F80};
    unsigned kroff[3];
#pragma unroll
    for (int s2 = 0; s2 < 3; ++s2) kroff[s2] = i16 * KSTR + (((4 * s2 + g) ^ i16) << 4);
    const unsigned vroff = KBUF + (4 * g + (i16 >> 2)) * VSTR + (i16 & 3) * 8;
    for (int t = 0; t < nt; ++t) {
        const LAS unsigned char* sb = lds + (t & 1) * STAGE;
        constexpr int KPD = 2;
#define A64_KF(idx) (*(const LAS bf16x8*)(sb + kroff[(idx) % 3] + (16 * ((idx) / 3)) * KSTR))
        bf16x8 kfr[KPD + 1];
#pragma unroll
        for (int i = 0; i < KPD; ++i) kfr[i] = A64_KF(i);
#pragma unroll
        for (int j = 0; j < 4; ++j) {
            f32x4_t st[2][4];
#pragma unroll
            for (int kb = 0; kb < 2; ++kb)
#pragma unroll
                for (int s = 0; s < 3; ++s) { const int idx = 3 * (2 * j + kb) + s;
                    if (idx + KPD < 24) kfr[(idx + KPD) % (KPD + 1)] = A64_KF(idx + KPD);
                    __builtin_amdgcn_s_setprio(1);
#pragma unroll
                    for (int qb = 0; qb < 4; ++qb) st[kb][qb] = __builtin_amdgcn_mfma_f32_16x16x32_bf16(kfr[idx % (KPD + 1)], qf[qb][s], s == 0 ? (f32x4_t){0.f, 0.f, 0.f, 0.f} : st[kb][qb], 0, 0, 0);
                    __builtin_amdgcn_s_setprio(0); }
            bf16x8 vf[4];
#pragma unroll
            for (int dvb = 0; dvb < 4; ++dvb) { const LAS unsigned char* vp = sb + vroff + (32 * j) * VSTR + dvb * 32;
                const s16x4 lo = vtr(vp), hh = vtr(vp + 16 * VSTR); vf[dvb] = (bf16x8){lo[0], lo[1], lo[2], lo[3], hh[0], hh[1], hh[2], hh[3]}; }
            bf16x8 pa[4];
#pragma unroll
            for (int qb = 0; qb < 4; ++qb) { f32x4_t a = st[0][qb], b = st[1][qb];
#pragma unroll
                for (int r = 0; r < 4; ++r) { a[r] = __builtin_amdgcn_exp2f(a[r]); b[r] = __builtin_amdgcn_exp2f(b[r]); }
                pa[qb] = __builtin_bit_cast(bf16x8, (g8::u32x4){g8::cvtpk(a[0], a[1]), g8::cvtpk(a[2], a[3]), g8::cvtpk(b[0], b[1]), g8::cvtpk(b[2], b[3])}); }
            __builtin_amdgcn_s_setprio(1);
#pragma unroll
            for (int dvb = 0; dvb < 4; ++dvb)
#pragma unroll
                for (int qb = 0; qb < 4; ++qb) o[qb][dvb] = __builtin_amdgcn_mfma_f32_16x16x32_bf16(pa[qb], vf[dvb], o[qb][dvb], 0, 0, 0);
#pragma unroll
            for (int qb = 0; qb < 4; ++qb) ol[qb] = __builtin_amdgcn_mfma_f32_16x16x32_bf16(pa[qb], ones, ol[qb], 0, 0, 0);
            __builtin_amdgcn_s_setprio(0);
        }
        if (t + 1 < nt) { A64_WRITE((t + 1) & 1); if (t + 2 < nt) A64_LOAD(t + 2); }
        A16_BAR();
    }
#pragma unroll
    for (int qb = 0; qb < 4; ++qb)
#pragma unroll
        for (int r = 0; r < 4; ++r) { const int q = qb * 16 + 4 * g + r; const float rl = 1.0f / ol[qb][r];
            bf16_t* op = O + (size_t)(qrow0 + wave * 64 + q) * 512 + h * 64 + i16;
#pragma unroll
            for (int dvb = 0; dvb < 4; ++dvb) op[dvb * 16] = (bf16_t)f2bf(o[qb][dvb][r] * rl); }
#undef A64_LOAD
#undef A64_WRITE
#undef A64_KF
}
#undef A16_BAR
}

namespace rt {
using at::bf16x8; using at::s16x4; using at::f32x16; using at::crow; using at::vtr;
constexpr int TSTR = 320;
constexpr int KSTR2 = 272;
constexpr size_t SLOT = 32768;
__device__ __forceinline__ bf16_t* slot_ptr(bf16_t* ST, int dir, int bh, int c) { return ST + ((size_t)((dir * 16 + bh) * 66 + c)) * 16384; }
__device__ __forceinline__ float log2_decay(const float* dec, int l, int h) { const float x = dec[l * 4 + h]; return -log1pf(expf(-x)) * 1.4426950408889634f; }
#define RT_BAR() do { asm volatile("s_waitcnt vmcnt(0) lgkmcnt(0)" ::: "memory"); __builtin_amdgcn_s_barrier(); asm volatile("" ::: "memory"); } while (0)
__device__ __forceinline__ g8::u32x4 scale8(const g8::u32x4& w, float s) { g8::f32x4 a, b; g8::unpack8(w, a, b); return g8::pack8(a * s, b * s); }
__device__ __forceinline__ bf16x8 tr_frag(const LAS unsigned char* tile, int k0, int cb, int lane) {
    const int hi = lane >> 5, q = (lane & 15) >> 2, p = lane & 3, g1 = (lane >> 4) & 1;
    const LAS unsigned char* a = tile + (k0 + 8 * hi + q) * TSTR + (cb * 32 + 16 * g1 + 4 * p) * 2;
    const s16x4 lo = vtr(a), hh = vtr(a + 4 * TSTR);
    return (bf16x8){lo[0], lo[1], lo[2], lo[3], hh[0], hh[1], hh[2], hh[3]};
}
__device__ __forceinline__ bf16x8 tr_frag_perm(const LAS unsigned char* tile, int k0, int cb, int lane) {
    const int hi = lane >> 5, q = (lane & 15) >> 2, p = lane & 3, g1 = (lane >> 4) & 1;
    const LAS unsigned char* a = tile + (k0 + 4 * hi + q) * TSTR + (cb * 32 + 16 * g1 + 4 * p) * 2;
    const s16x4 lo = vtr(a), hh = vtr(a + 8 * TSTR);
    return (bf16x8){lo[0], lo[1], lo[2], lo[3], hh[0], hh[1], hh[2], hh[3]};
}
__device__ __forceinline__ void chunk_kv_unit(LAS unsigned char* lds, const bf16_t* RET, bf16_t* ST, float lf, float lb, int bh, int c, int tid) {
    const int lane = tid & 63, wave = __builtin_amdgcn_readfirstlane(tid >> 6), b = bh >> 2, h = bh & 3;
    const int r0 = c < 2 ? ML + b * CTX + c * 128 : b * SEQ + (c - 2) * 128;
    LAS unsigned char* Kf = lds; LAS unsigned char* Kb = lds + 128 * TSTR; LAS unsigned char* Vt = lds + 2 * 128 * TSTR;
#pragma unroll
    for (int i = 0; i < 4; ++i) { const int ch = tid + i * 512, row = ch >> 4, cc = ch & 15;
        const g8::u32x4 kv = *(const g8::u32x4*)(RET + (size_t)(r0 + row) * 2048 + 512 + h * 128 + cc * 8), vv = *(const g8::u32x4*)(RET + (size_t)(r0 + row) * 2048 + 1024 + h * 128 + cc * 8);
        *(LAS g8::u32x4*)(Kf + row * TSTR + cc * 16) = scale8(kv, __builtin_amdgcn_exp2f(lf * (float)(127 - row)));
        *(LAS g8::u32x4*)(Kb + row * TSTR + cc * 16) = scale8(kv, __builtin_amdgcn_exp2f(lb * (float)row));
        *(LAS g8::u32x4*)(Vt + row * TSTR + cc * 16) = vv; }
    RT_BAR();
    const int dir = wave >> 2, db = wave & 3; const LAS unsigned char* Kt = dir ? Kb : Kf;
    f32x16 acc[4] = {};
#pragma unroll
    for (int s = 0; s < 8; ++s) { const bf16x8 a = tr_frag(Kt, 16 * s, db, lane);
#pragma unroll
        for (int vb = 0; vb < 4; ++vb) acc[vb] = __builtin_amdgcn_mfma_f32_32x32x16_bf16(a, tr_frag(Vt, 16 * s, vb, lane), acc[vb], 0, 0, 0); }
    bf16_t* dst = slot_ptr(ST, dir, bh, c) + (lane & 31);
#pragma unroll
    for (int vb = 0; vb < 4; ++vb)
#pragma unroll
        for (int r = 0; r < 16; ++r) dst[(size_t)(32 * db + crow(r, lane >> 5)) * 128 + vb * 32] = (bf16_t)f2bf(acc[vb][r]);
    RT_BAR();
}
__device__ __forceinline__ void scan_states(bf16_t* ST, const float* decf, const float* decb, int l, int gtid, int gsize) {
    for (int v = gtid; v < 2 * 16 * 2048; v += gsize) {
        const int dir = v >> 15, bh = (v >> 11) & 15, e = v & 2047, h = bh & 3;
        const float cdec = __builtin_amdgcn_exp2f(128.0f * log2_decay(dir ? decb : decf, l, h));
        g8::u32x4* base = (g8::u32x4*)slot_ptr(ST, dir, bh, 0) + e;
        g8::f32x4 s0, s1, a0, a1, b0, b1;
        g8::unpack8(base[0], a0, a1); g8::unpack8(base[2048], b0, b1);
        if (dir == 0) { s0 = a0 * cdec + b0; s1 = a1 * cdec + b1; } else { s0 = a0 + b0 * cdec; s1 = a1 + b1 * cdec; }
#pragma unroll 16
        for (int n = 0; n < 64; ++n) { g8::u32x4* p = base + (size_t)(2 + (dir ? 63 - n : n)) * 2048; g8::f32x4 k0, k1; g8::unpack8(*p, k0, k1);
            *p = g8::pack8(s0, s1); s0 = s0 * cdec + k0; s1 = s1 * cdec + k1; }
    }
}
__device__ __forceinline__ void chunk_out_unit(LAS unsigned char* lds, bf16_t* RET, const bf16_t* ST, const float* gng, const float* gnb, float lf, float lb, int bh, int c, int tid, bool dry = false) {
    const int lane = tid & 63, wave = __builtin_amdgcn_readfirstlane(tid >> 6), r32 = lane & 31, hi = lane >> 5, b = bh >> 2, h = bh & 3;
    const int r0 = c < 2 ? ML + b * CTX + c * 128 : b * SEQ + (c - 2) * 128;
    const int qb = wave & 3, dvh = wave >> 2;
    LAS unsigned char* Kt = lds; LAS unsigned char* Vt = lds + 128 * KSTR2; LAS unsigned char* St = Vt + 128 * TSTR;
    const bool has_f = (c != 0), has_b = (c != 1);
    const bf16_t* sf = slot_ptr((bf16_t*)ST, 0, bh, c == 1 ? 0 : c); const bf16_t* sb = slot_ptr((bf16_t*)ST, 1, bh, c == 0 ? 1 : c);
#pragma unroll
    for (int i = 0; i < 4; ++i) { const int ch = tid + i * 512, row = ch >> 4, cc = ch & 15;
        *(LAS g8::u32x4*)(Kt + row * KSTR2 + cc * 16) = *(const g8::u32x4*)(RET + (size_t)(r0 + row) * 2048 + 512 + h * 128 + cc * 8);
        *(LAS g8::u32x4*)(Vt + row * TSTR + cc * 16) = *(const g8::u32x4*)(RET + (size_t)(r0 + row) * 2048 + 1024 + h * 128 + cc * 8);
        if (has_f) *(LAS g8::u32x4*)(St + row * TSTR + cc * 16) = *(const g8::u32x4*)(sf + (size_t)row * 128 + cc * 8); }
    g8::u32x4 sbr[4];
    if (has_b) {
#pragma unroll
        for (int i = 0; i < 4; ++i) { const int ch = tid + i * 512, row = ch >> 4, cc = ch & 15; sbr[i] = *(const g8::u32x4*)(sb + (size_t)row * 128 + cc * 8); } }
    bf16x8 qf[8];
    { const bf16_t* qp = RET + (size_t)(r0 + qb * 32 + r32) * 2048 + h * 128 + hi * 8;
#pragma unroll
      for (int d0 = 0; d0 < 8; ++d0) qf[d0] = *(const bf16x8*)(qp + d0 * 16); }
    RT_BAR();
    f32x16 o[2] = {}, af[2] = {}, ab[2] = {};
    const int iq = qb * 32 + r32;
#pragma unroll
    for (int kt = 0; kt < 2; ++kt) {
        f32x16 p0 = {}, p1 = {};
#pragma unroll
        for (int d0 = 0; d0 < 8; ++d0) {
            const bf16x8 a0 = *(const LAS bf16x8*)(Kt + (64 * kt + r32) * KSTR2 + d0 * 32 + hi * 16), a1 = *(const LAS bf16x8*)(Kt + (64 * kt + 32 + r32) * KSTR2 + d0 * 32 + hi * 16);
            p0 = __builtin_amdgcn_mfma_f32_32x32x16_bf16(a0, qf[d0], p0, 0, 0, 0);
            p1 = __builtin_amdgcn_mfma_f32_32x32x16_bf16(a1, qf[d0], p1, 0, 0, 0);
        }
#pragma unroll
        for (int r = 0; r < 16; ++r) { const int j0 = 64 * kt + crow(r, hi), d0_ = iq - j0, d1_ = d0_ - 32;
            p0[r] *= __builtin_amdgcn_exp2f(d0_ >= 0 ? lf * (float)d0_ : lb * (float)(-d0_));
            p1[r] *= __builtin_amdgcn_exp2f(d1_ >= 0 ? lf * (float)d1_ : lb * (float)(-d1_)); }
        bf16x8 pa[4];
#pragma unroll
        for (int ks = 0; ks < 4; ++ks) { unsigned w[4];
#pragma unroll
            for (int j = 0; j < 4; ++j) { const int r = 8 * (ks & 1) + 2 * j; w[j] = (ks < 2) ? g8::cvtpk(p0[r], p0[r + 1]) : g8::cvtpk(p1[r], p1[r + 1]); }
            pa[ks] = __builtin_bit_cast(bf16x8, (g8::u32x4){w[0], w[1], w[2], w[3]}); }
#pragma unroll
        for (int ks = 0; ks < 4; ++ks)
#pragma unroll
            for (int d0 = 0; d0 < 2; ++d0) o[d0] = __builtin_amdgcn_mfma_f32_32x32x16_bf16(pa[ks], tr_frag_perm(Vt, 64 * kt + 16 * ks, dvh * 2 + d0, lane), o[d0], 0, 0, 0);
    }
    if (has_f) {
#pragma unroll
        for (int s = 0; s < 8; ++s)
#pragma unroll
            for (int d0 = 0; d0 < 2; ++d0) af[d0] = __builtin_amdgcn_mfma_f32_32x32x16_bf16(qf[s], tr_frag(St, 16 * s, dvh * 2 + d0, lane), af[d0], 0, 0, 0);
    }
    RT_BAR();
    if (has_b) {
#pragma unroll
        for (int i = 0; i < 4; ++i) { const int ch = tid + i * 512, row = ch >> 4, cc = ch & 15;
            *(LAS g8::u32x4*)(St + row * TSTR + cc * 16) = sbr[i]; }
    }
    RT_BAR();
    if (has_b) {
#pragma unroll
        for (int s = 0; s < 8; ++s)
#pragma unroll
            for (int d0 = 0; d0 < 2; ++d0) ab[d0] = __builtin_amdgcn_mfma_f32_32x32x16_bf16(qf[s], tr_frag(St, 16 * s, dvh * 2 + d0, lane), ab[d0], 0, 0, 0);
    }
    LAS float* Ot = (LAS float*)lds;
#pragma unroll
    for (int r = 0; r < 16; ++r) { const int i = qb * 32 + crow(r, hi); const float qdf = __builtin_amdgcn_exp2f(lf * (float)(i + 1)), qdb = __builtin_amdgcn_exp2f(lb * (float)(128 - i));
#pragma unroll
        for (int d0 = 0; d0 < 2; ++d0) Ot[i * 132 + dvh * 64 + d0 * 32 + r32] = o[d0][r] + qdf * af[d0][r] + qdb * ab[d0][r]; }
    RT_BAR();
    { const int row = tid >> 2, qt = tid & 3; const LAS float* op = Ot + row * 132 + qt * 32; float v[32]; float s = 0.f;
#pragma unroll
      for (int j = 0; j < 32; ++j) { v[j] = op[j]; s += v[j]; }
      s += dppx<0xB1>(s); s += dppx<0x4E>(s); const float mu = s * (1.0f / 128.f); float q = 0.f;
#pragma unroll
      for (int j = 0; j < 32; ++j) { v[j] -= mu; q += v[j] * v[j]; }
      q += dppx<0xB1>(q); q += dppx<0x4E>(q); const float rstd = 1.0f / sqrtf(q * (1.0f / 128.f) + EPS);
      bf16_t* rowp = RET + (size_t)(r0 + row) * 2048 + h * 128 + qt * 32; const float* gg = gng + h * 128 + qt * 32; const float* gb = gnb + h * 128 + qt * 32;
#pragma unroll
      for (int j8 = 0; j8 < 4; ++j8) { g8::f32x4 g0, g1; g8::unpack8(*(const g8::u32x4*)(rowp + 1536 + j8 * 8), g0, g1); g8::f32x4 y0, y1;
#pragma unroll
          for (int j = 0; j < 4; ++j) { const float ga = g0[j], gb_ = g1[j];
              y0[j] = ga * g8::fsigmoid(ga) * (v[j8 * 8 + j] * rstd * gg[j8 * 8 + j] + gb[j8 * 8 + j]);
              y1[j] = gb_ * g8::fsigmoid(gb_) * (v[j8 * 8 + 4 + j] * rstd * gg[j8 * 8 + 4 + j] + gb[j8 * 8 + 4 + j]); }
          if (!dry) *(g8::u32x4*)(rowp + j8 * 8) = g8::pack8(y0, y1); } }
    RT_BAR();
}
__device__ __forceinline__ void gmlp_unit(LAS unsigned char* lds, bf16_t* UV, const float* ws, const float* bs, const float* PARTV, const float* lng, const float* lnb, int cidx, int g, int tid, bool dry = false) {
    const int lane = tid & 63, wave = __builtin_amdgcn_readfirstlane(tid >> 6), r32 = lane & 31, hi = lane >> 5, r0 = cidx * 128;
    LAS unsigned char* Wt = lds; LAS unsigned char* Vt = lds + 128 * KSTR2;
    LAS float* st = (LAS float*)(lds + 128 * KSTR2 + 128 * TSTR);
    if (tid < 128) { const float* pp = PARTV + (size_t)(r0 + tid) * 32; float s1 = 0.f, s2 = 0.f;
#pragma unroll
        for (int q = 0; q < 8; ++q) { const g8::f32x4 a = *(const g8::f32x4*)(pp + 4 * q); s1 += a[0] + a[2]; s2 += a[1] + a[3]; }
        const float mu = s1 * (1.0f / 512.f), var = s2 * (1.0f / 512.f) - mu * mu; st[tid * 2] = mu; st[tid * 2 + 1] = 1.0f / sqrtf((var > 0.f ? var : 0.f) + EPS); }
#pragma unroll
    for (int i = 0; i < 4; ++i) { const int ch = tid + i * 512, row = ch >> 4, cc = ch & 15;
        const g8::f32x4 w0 = *(const g8::f32x4*)(ws + row * 128 + cc * 8), w1 = *(const g8::f32x4*)(ws + row * 128 + cc * 8 + 4);
        *(LAS g8::u32x4*)(Wt + row * KSTR2 + cc * 16) = g8::pack8(w0, w1); }
    g8::u32x4 vraw[4];
#pragma unroll
    for (int i = 0; i < 4; ++i) { const int ch = tid + i * 512, row = ch >> 4, cc = ch & 15; vraw[i] = *(const g8::u32x4*)(UV + (size_t)(r0 + row) * 1024 + 512 + g * 128 + cc * 8); }
    RT_BAR();
#pragma unroll
    for (int i = 0; i < 4; ++i) { const int ch = tid + i * 512, row = ch >> 4, cc = ch & 15; g8::f32x4 x0, x1;
        g8::unpack8(vraw[i], x0, x1);
        const float mu = st[row * 2], rstd = st[row * 2 + 1]; const float* gg = lng + g * 128 + cc * 8; const float* gb = lnb + g * 128 + cc * 8;
        const g8::f32x4 g0 = *(const g8::f32x4*)gg, g1 = *(const g8::f32x4*)(gg + 4), b0 = *(const g8::f32x4*)gb, b1 = *(const g8::f32x4*)(gb + 4);
        *(LAS g8::u32x4*)(Vt + row * TSTR + cc * 16) = g8::pack8((x0 - mu) * rstd * g0 + b0, (x1 - mu) * rstd * g1 + b1); }
    RT_BAR();
    const int ib = wave & 3, cb0 = (wave >> 2) * 2;
    f32x16 acc[2] = {};
#pragma unroll
    for (int s = 0; s < 8; ++s) { const bf16x8 a = *(const LAS bf16x8*)(Wt + (32 * ib + r32) * KSTR2 + s * 32 + hi * 16);
#pragma unroll
        for (int d0 = 0; d0 < 2; ++d0) acc[d0] = __builtin_amdgcn_mfma_f32_32x32x16_bf16(a, tr_frag(Vt, 16 * s, cb0 + d0, lane), acc[d0], 0, 0, 0); }
#pragma unroll
    for (int r = 0; r < 16; ++r) { const int i = 32 * ib + crow(r, hi); const float bi = bs[i];
#pragma unroll
        for (int d0 = 0; d0 < 2; ++d0) { bf16_t* up = UV + (size_t)(r0 + i) * 1024 + g * 128 + (cb0 + d0) * 32 + r32; const bf16_t nv = (bf16_t)f2bf(bf2f(*up) * (acc[d0][r] + bi)); if (!dry) *up = nv; } }
    RT_BAR();
}
#undef RT_BAR
}

__device__ __forceinline__ float grp_sum(float v, int width) {
#pragma unroll
    for (int o = 1; o < 64; o <<= 1) if (o < width) v += __shfl_xor(v, o);
    return v;
}
__device__ __forceinline__ void p_rowpass_a_vec(Frame& F, int l) {
    const int gw = F.bid * NWAVES + F.wave, NGW = F.G * NWAVES, lane = F.lane;
    const float* qag = FIN(I_QAG) + l * 384; const float* kvag = FIN(I_KVAG) + l * 256; const float* krg = FIN(I_KRG) + l * 32;
    const float* lng = FIN(I_LNG) + l * 512; const float* lnb = FIN(I_LNB) + l * 512;
    for (int r = gw; r < M; r += NGW) {
        g8::u32x4* pq = (g8::u32x4*)(F_CQ + (size_t)r * 384) + lane; g8::u32x4* pk = (g8::u32x4*)(F_CKV + (size_t)r * 256) + lane;
        g8::u32x4* pr = (g8::u32x4*)(F_KR + (size_t)r * 32) + lane; g8::u32x4* pv = (g8::u32x4*)(F_UV + (size_t)r * 1024 + 512) + lane;
        g8::u32x4 wq = {0u, 0u, 0u, 0u}, wk = wq, wr = wq; if (lane < 48) wq = *pq; if (lane < 32) wk = *pk; if (lane < 4) wr = *pr; const g8::u32x4 wv = *pv;
        g8::f32x4 q0, q1, k0, k1, r0, r1, v0, v1; g8::unpack8(wq, q0, q1); g8::unpack8(wk, k0, k1); g8::unpack8(wr, r0, r1); g8::unpack8(wv, v0, v1);
        const float rsq = 1.0f / sqrtf(wave_sum(sumsq8(q0, q1)) * (1.0f / 384.f) + EPS), rsk = 1.0f / sqrtf(wave_sum(sumsq8(k0, k1)) * (1.0f / 256.f) + EPS);
        const float rsr = 1.0f / sqrtf(wave_sum(sumsq8(r0, r1)) * (1.0f / 32.f) + EPS);
        const float mu = wave_sum((v0[0] + v0[1]) + (v0[2] + v0[3]) + (v1[0] + v1[1]) + (v1[2] + v1[3])) * (1.0f / 512.f);
        v0 = v0 - mu; v1 = v1 - mu; const float rsv = 1.0f / sqrtf(wave_sum(sumsq8(v0, v1)) * (1.0f / 512.f) + EPS);
        if (lane < 48) { const g8::f32x4 g0 = *(const g8::f32x4*)(qag + lane * 8), g1 = *(const g8::f32x4*)(qag + lane * 8 + 4); *pq = g8::pack8(q0 * rsq * g0, q1 * rsq * g1); }
        if (lane < 32) { const g8::f32x4 g0 = *(const g8::f32x4*)(kvag + lane * 8), g1 = *(const g8::f32x4*)(kvag + lane * 8 + 4); *pk = g8::pack8(k0 * rsk * g0, k1 * rsk * g1); }
        { const int vi = lane & 3; const g8::f32x4 g0 = *(const g8::f32x4*)(krg + vi * 8), g1 = *(const g8::f32x4*)(krg + vi * 8 + 4);
          g8::f32x4 y0 = r0 * rsr * g0, y1 = r1 * rsr * g1, p0, p1;
#pragma unroll
          for (int i = 0; i < 4; ++i) { p0[i] = dppx<0xB1>(y0[i]); p1[i] = dppx<0xB1>(y1[i]); }
          if (r < ML) rope8(y0, y1, p0, p1, F_ROPE + (size_t)(r & (SEQ - 1)) * 32, vi);
          if (lane < 4) *pr = g8::pack8(y0, y1); }
        { const g8::f32x4 g0 = *(const g8::f32x4*)(lng + lane * 8), g1 = *(const g8::f32x4*)(lng + lane * 8 + 4), b0 = *(const g8::f32x4*)(lnb + lane * 8), b1 = *(const g8::f32x4*)(lnb + lane * 8 + 4);
          *pv = g8::pack8(v0 * rsv * g0 + b0, v1 * rsv * g1 + b1); }
    }
}
__device__ __forceinline__ void p_rowpass_b_vec(Frame& F, int l) {
    const int gw = F.bid * NWAVES + F.wave, NGW = F.G * NWAVES, lane = F.lane, grp = lane >> 4, i = lane & 15;
    const float* qng = FIN(I_QNG) + l * 96; const float* kng = FIN(I_KNG) + l * 64;
    g8::f32x4 gq0 = {0.f, 0.f, 0.f, 0.f}, gq1 = gq0, gk0 = gq0, gk1 = gq0;
    if (i < 12) { gq0 = *(const g8::f32x4*)(qng + i * 8); gq1 = *(const g8::f32x4*)(qng + i * 8 + 4); }
    if (i < 8) { gk0 = *(const g8::f32x4*)(kng + i * 8); gk1 = *(const g8::f32x4*)(kng + i * 8 + 4); }
    for (int r = gw; r < M; r += NGW) {
        const float* tab = F_ROPE + (size_t)(r & (SEQ - 1)) * 32;
#pragma unroll
        for (int it = 0; it < 2; ++it) { const int h = it * 4 + grp;
            g8::u32x4* qp = (g8::u32x4*)(F_Q + (size_t)r * 768 + h * 96) + i;
            g8::u32x4 wq = {0u, 0u, 0u, 0u}; if (i < 12) wq = *qp;
            const g8::u32x4 wkv = *((const g8::u32x4*)(F_KVR + (size_t)r * 1024 + h * 128) + i);
            g8::u32x4 wkr = {0u, 0u, 0u, 0u}; if (i >= 8 && i < 12) wkr = *((const g8::u32x4*)(F_KR + (size_t)r * 32) + (i - 8));
            g8::f32x4 q0, q1, k0, k1; g8::unpack8(wq, q0, q1); g8::unpack8(wkv, k0, k1);
            const float rq = 1.0f / sqrtf(row16_sum(sumsq8(q0, q1)) * (1.0f / 96.f) + EPS);
            const float rk = 1.0f / sqrtf(row16_sum(i < 8 ? sumsq8(k0, k1) : 0.f) * (1.0f / 64.f) + EPS);
            g8::f32x4 y0 = q0 * rq * gq0, y1 = q1 * rq * gq1, p0, p1;
#pragma unroll
            for (int j = 0; j < 4; ++j) { p0[j] = dppx<0xB1>(y0[j]); p1[j] = dppx<0xB1>(y1[j]); }
            if (r < ML && i >= 8 && i < 12) rope8(y0, y1, p0, p1, tab, i - 8);
            if (i < 12) *qp = g8::pack8(y0 * QSCALE, y1 * QSCALE);
            g8::u32x4* kp = (g8::u32x4*)(F_K + (size_t)r * 768 + h * 96) + i;
            if (i < 8) *kp = g8::pack8(k0 * rk * gk0, k1 * rk * gk1);
            else if (i < 12) *kp = wkr;
            if (i >= 8) *((g8::u32x4*)(F_V + (size_t)r * 512 + h * 64) + (i - 8)) = wkv;
        }
    }
}

constexpr int LDS_TT = 131072;
__device__ __forceinline__ const char* smw(const Frame& F, int l, size_t off) { return (const char*)(ws_(F.A) + WS_WSM + (size_t)l * SMW_L + off); }
__device__ __forceinline__ void p_router_fast(Frame& F, int l, int ntok) {
    using at::bf16x8; using at::f32x16; using at::crow;
    LAS int* hist = (LAS int*)((LAS unsigned char*)F.lds);
    const int lane = F.lane, r32 = lane & 31, hi = lane >> 5;
    __syncthreads();
    if (F.tid < 64) hist[F.tid] = 0;
    __syncthreads();
    const bf16_t* Rh = (const bf16_t*)smw(F, l, SMW_RT); const bf16_t* Rl = Rh + 64 * 1024;
    const float* bias = FIN(I_MBIAS) + l * NEXP;
    LAS float* part = (LAS float*)((LAS unsigned char*)F.lds + 1024);
    LAS unsigned char* wb = (LAS unsigned char*)F.lds + 36864;
    constexpr int WBUF = 128 * 272;
    const int pair = F.wave & 3, half = F.wave >> 2, ntask = (ntok + 31) >> 5;
    const bf16_t* wsrc = Rh + (size_t)(F.tid >> 4) * 1024 + (F.tid & 15) * 8;
    const unsigned wdst = (unsigned)(F.tid >> 4) * 272u + (unsigned)(F.tid & 15) * 16u;
    for (int it = 0; (it * F.G) * 4 < ntask; ++it) {
        const int w = (it * F.G + F.bid) * 4 + pair; const bool live = w < ntask;
        const int tok = (live ? w : 0) * 32 + r32;
        const bf16_t* hp = F_H + (size_t)tok * D + hi * 8 + half * 64;
        g8::u32x4 wr[4]; bf16x8 hq[4], hn[4];
#pragma unroll
        for (int i = 0; i < 4; ++i) wr[i] = *(const g8::u32x4*)(wsrc + (size_t)i * 32 * 1024);
#pragma unroll
        for (int s2 = 0; s2 < 4; ++s2) hq[s2] = *(const bf16x8*)(hp + s2 * 16);
        __syncthreads();
#pragma unroll
        for (int i = 0; i < 4; ++i) *(LAS g8::u32x4*)(wb + wdst + i * 32 * 272) = wr[i];
        __syncthreads();
        f32x16 acc0 = {}, acc1 = {};
        for (int c = 0; c < 8; ++c) {
            const LAS unsigned char* ap = wb + (c & 1) * WBUF + r32 * 272 + (half * 64 + hi * 8) * 2;
            if (c + 1 < 8) {
#pragma unroll
                for (int i = 0; i < 4; ++i) wr[i] = *(const g8::u32x4*)(wsrc + (c + 1) * 128 + (size_t)i * 32 * 1024);
#pragma unroll
                for (int s2 = 0; s2 < 4; ++s2) hn[s2] = *(const bf16x8*)(hp + (c + 1) * 128 + s2 * 16); }
#pragma unroll
            for (int s2 = 0; s2 < 4; ++s2) {
                acc0 = __builtin_amdgcn_mfma_f32_32x32x16_bf16(*(const LAS bf16x8*)(ap + s2 * 32), hq[s2], acc0, 0, 0, 0);
                acc1 = __builtin_amdgcn_mfma_f32_32x32x16_bf16(*(const LAS bf16x8*)(ap + 32 * 272 + s2 * 32), hq[s2], acc1, 0, 0, 0);
                acc0 = __builtin_amdgcn_mfma_f32_32x32x16_bf16(*(const LAS bf16x8*)(ap + 64 * 272 + s2 * 32), hq[s2], acc0, 0, 0, 0);
                acc1 = __builtin_amdgcn_mfma_f32_32x32x16_bf16(*(const LAS bf16x8*)(ap + 96 * 272 + s2 * 32), hq[s2], acc1, 0, 0, 0); }
            if (c + 1 < 8) {
#pragma unroll
                for (int i = 0; i < 4; ++i) *(LAS g8::u32x4*)(wb + ((c + 1) & 1) * WBUF + wdst + i * 32 * 272) = wr[i];
#pragma unroll
                for (int s2 = 0; s2 < 4; ++s2) hq[s2] = hn[s2]; }
            __syncthreads();
        }
        if (half == 1) {
#pragma unroll
            for (int r = 0; r < 16; ++r) { part[(pair * 32 + r) * 64 + lane] = acc0[r]; part[(pair * 32 + 16 + r) * 64 + lane] = acc1[r]; } }
        __syncthreads();
        if (half == 0) {
#pragma unroll
            for (int r = 0; r < 16; ++r) { acc0[r] += part[(pair * 32 + r) * 64 + lane]; acc1[r] += part[(pair * 32 + 16 + r) * 64 + lane]; } }
        __syncthreads();
        if (half == 1 || !live) continue;
        float sel[32];
#pragma unroll
        for (int r = 0; r < 16; ++r) { const int e0 = crow(r, hi), e1 = 32 + e0;
            sel[r] = 1.0f / (1.0f + expf(-acc0[r])) + bias[e0]; sel[16 + r] = 1.0f / (1.0f + expf(-acc1[r])) + bias[e1]; }
        float wk[TOPK]; int ek[TOPK]; float wsum = 0.f;
#pragma unroll
        for (int k = 0; k < TOPK; ++k) {
            float bv = -INFINITY; int bi = 0;
#pragma unroll
            for (int j = 0; j < 32; ++j) { const int e = (j >> 4) * 32 + crow(j & 15, hi); if (sel[j] > bv || (sel[j] == bv && e < bi)) { bv = sel[j]; bi = e; } }
            const float ov = xlane32(bv, lane); const int oi = xlane32i(bi, lane);
            if (ov > bv || (ov == bv && oi < bi)) { bv = ov; bi = oi; }
#pragma unroll
            for (int j = 0; j < 32; ++j) { const int e = (j >> 4) * 32 + crow(j & 15, hi); sel[j] = (e == bi) ? -INFINITY : sel[j]; }
            ek[k] = bi; wk[k] = bv - bias[bi]; wsum += wk[k];
        }
        if (hi == 0) {
            const float sc = 2.5f / wsum;
#pragma unroll
            for (int k = 0; k < TOPK; ++k) { F_IDX[tok * TOPK + k] = ek[k]; F_WTS[tok * TOPK + k] = wk[k] * sc; F_SLOT[tok * TOPK + k] = atomicAdd((int*)&hist[ek[k]], 1) | (F.bid << 20); }
        }
    }
    __syncthreads();
    if (F.tid < 64) F_BLKBASE[(l * 256 + F.bid) * 64 + F.tid] = (int)atomicAdd(F_ctl + CW_CNT + l * 64 + F.tid, (unsigned)hist[F.tid]);
    for (int i = F.bid * NTHR + F.tid; i < APAD; i += F.G * NTHR) F_ROWTOK[i] = 0;
}

__device__ __forceinline__ void p_inproj_fast(Frame& F, int l) {
    SchedInproj S{(const char*)F_H, smw(F, l, SMW_WIN), F.G, F.bid}; EpiInproj E{F_RET, F_CQ, F_CKV, F_KR, F_UV, FWS(float, WS_PART), FWS(float, WS_PARTV), FIN(I_KRG) + l * 32, F_ROPE};
    g8::gemm_phase<false>((LAS unsigned char*)F.lds, S, E, F.tid);
}
__device__ __forceinline__ void p_mlaup_fast(Frame& F, int l) {
    SchedMlaUp S{(const char*)F_CQ, (const char*)F_CKV, smw(F, l, SMW_WUQ), smw(F, l, SMW_WUKV), F.G, F.bid}; EpiMlaFused E{F_Q, F_K, F_V, F_KR, FIN(I_QNG) + l * 96, FIN(I_KNG) + l * 64, F_ROPE, FWS(float, WS_PART), (LAS float*)((LAS unsigned char*)F.lds + LDS_TT)};
    g8::gemm_phase<false>((LAS unsigned char*)F.lds, S, E, F.tid);
}
template <int BR> __device__ __forceinline__ void p_merge_br(Frame& F, int l, int nrows) {
    const char* abr = BR == 0 ? (const char*)F_RET : (BR == 1 ? (const char*)F_AO : (const char*)F_UV);
    SchedMerge S{(const char*)F_H, smw(F, l, SMW_WG) + (size_t)BR * 1024 * 2048, abr, smw(F, l, SMW_WBR) + (size_t)BR * 1024 * 1024, BR == 0 ? 4096u : (BR == 1 ? 1024u : 2048u), F.G, F.bid, nrows / 256};
    EpiMerge<BR> E{F_Y, (u32x4*)(ws_(F.A) + WS_SCR + (size_t)F.bid * 131072)};
    g8::gemm_phase<false>((LAS unsigned char*)F.lds, S, E, F.tid);
}
__device__ __forceinline__ void p_merge_fast(Frame& F, int l, int nrows) {
    p_merge_br<0>(F, l, nrows); asm volatile("" : "+v"(F.tid));
    p_merge_br<1>(F, l, nrows); asm volatile("" : "+v"(F.tid));
    p_merge_br<2>(F, l, nrows);
}
__device__ __forceinline__ void p_out_fast(Frame& F, int l, int nrows) {
    SchedOut S{(const char*)F_Y, smw(F, l, SMW_WOUT), F.G, F.bid, nrows / 256};
    EpiResid E{FIN(I_X), FIN(I_CTX), F_X16, F_MOD + (size_t)l * 5 * 6144 + 2 * D, l};
    g8::gemm_phase<false>((LAS unsigned char*)F.lds, S, E, F.tid);
}
__device__ __forceinline__ void p_gateup_fast(Frame& F, int l, int ntok) {
    LAS int* tt = (LAS int*)((LAS unsigned char*)F.lds + LDS_TT); moe_tiles(F, l, tt);
    SchedGateUp S{(const char*)F_H, (const char*)(ws_(F.A) + WS_MOEW), smw(F, l, SMW_SHGU), F_ROWTOK, tt, F.G, F.bid, ntok / 256}; EpiGateUp E{F_HB, F_HBS};
    g8::gemm_phase<true>((LAS unsigned char*)F.lds, S, E, F.tid);
}
__device__ __forceinline__ void p_down_fast(Frame& F, int l, int ntok, bool routed_only = false) {
    LAS int* tt = (LAS int*)((LAS unsigned char*)F.lds + LDS_TT); moe_tiles(F, l, tt);
    SchedDown S{(const char*)F_HB, (const char*)F_HBS, (const char*)(ws_(F.A) + WS_MOEW), smw(F, l, SMW_SHD), tt, F.G, F.bid, routed_only ? 0 : ntok / 256};
    EpiDown E{(unsigned char*)F_OUT, FWS(bf16_t, WS_SCR)};
    g8::gemm_phase<false>((LAS unsigned char*)F.lds, S, E, F.tid);
}
#ifndef FAST_INPROJ
#define FAST_INPROJ 1
#endif
#ifndef FAST_MLAUP
#define FAST_MLAUP 1
#endif
#ifndef FAST_MERGE
#define FAST_MERGE 1
#endif
#ifndef FAST_OUT
#define FAST_OUT 1
#endif
#ifndef FAST_MOE
#define FAST_MOE 1
#endif
#ifndef FAST_ATTN
#define FAST_ATTN 1
#endif
#ifndef FAST_RET
#define FAST_RET 1
#endif
#ifndef FAST_ROWPASS
#define FAST_ROWPASS 1
#endif

constexpr int NPL = 14;
constexpr int NPH = 1 + DEPTH * NPL;
#define REFRESH() do { int ln_; asm volatile("v_mbcnt_lo_u32_b32 %0, -1, 0\n\tv_mbcnt_hi_u32_b32 %0, -1, %0" : "=v"(ln_)); F.lane = ln_; F.tid = F.wave * 64 + ln_; } while (0)
#define IN(k) (lo <= (k) && (k) < hi)
#ifdef PROBE_A
#define STAMP(k) do { if (F.bid == 0 && F.tid == 0) ((unsigned long long*)(ws_(F.A) + WS_CTL + 262144))[(k)] = __builtin_amdgcn_s_memrealtime(); } while (0)
#else
#define STAMP(k) do {} while (0)
#endif
#ifndef REP_BAR
#define REP_BAR 1
#endif
#define SEAM(k) do { if (lo <= (k) && (k) + 1 < hi) { for (int rb_ = 0; rb_ < REP_BAR; ++rb_) xcd_barrier(bar, F.tid); } STAMP((k) + 1); REFRESH(); } while (0)


template <int L> __device__ __forceinline__ void layer_body(Frame& F, int& lo, int& hi, const XcdBarrier& bar) {
    constexpr int l = L;
    {
        asm volatile("" : "+s"(lo), "+s"(hi));
        const int pb = 1 + l * NPL;
        const int nrows_mix = (l == 0) ? M : ML;
        if (l == 0) { if (IN(pb + 0)) { p_norm(F, l, 0, M); } SEAM(pb + 0); }
        if (IN(pb + 1)) { for (int rep = 0; rep < REP_INPROJ; ++rep) { if (FAST_INPROJ) p_inproj_fast(F, l); else p_inproj_naive(F, l); asm volatile("" : "+v"(F.tid)); } } SEAM(pb + 1);
        if (IN(pb + 2)) {
#if FAST_RET
            REFRESH();
            { const float* decf = FIN(I_DECF); const float* decb = FIN(I_DECB);
              for (int rep = 0; rep < REP_R1; ++rep)
              for (int u = F.bid; u < 16 * 66; u += F.G) { const int bh = u / 66, c = u % 66;
                  rt::chunk_kv_unit((LAS unsigned char*)F.lds, F_RET, F_ST, rt::log2_decay(decf, l, bh & 3), rt::log2_decay(decb, l, bh & 3), bh, c, F.tid); } }
#endif
        } SEAM(pb + 2);
        if (IN(pb + 3)) {
#if FAST_RET
            if (F.tid < 256) rt::scan_states(F_ST, FIN(I_DECF), FIN(I_DECB), l, F.bid * 256 + F.tid, F.G * 256);
            __syncthreads();
            REFRESH();
#endif
            for (int rep = 0; rep < REP_MLAUP; ++rep) { if (FAST_MLAUP) p_mlaup_fast(F, l); else p_mlaup_naive(F, l); asm volatile("" : "+v"(F.tid)); } } SEAM(pb + 3);
        STAMP(pb + 5);
        if (IN(pb + 5)) {
#if FAST_ATTN
            {
                const int vcu = (F.G % 8 == 0) ? (F.bid % 8) * (F.G / 8) + F.bid / 8 : F.bid;
                for (int rep = 0; rep < REP_ATTN; ++rep)
                for (int u = vcu; u < NB * 8 * 16; u += F.G) {
                    const int bh = u >> 4, qb = u & 15, b = bh >> 3, h = bh & 7;
                    at16::attn_unit64((LAS unsigned char*)F.lds, F_Q, F_K, F_V, F_AO, h, b * SEQ + qb * 512, ML + b * CTX, CTX / at::KT, b * SEQ, SEQ / at::KT, F.tid); }
                REFRESH();
                if (l == 0 && F.bid < NB * 8) { const int b = F.bid >> 3, h = F.bid & 7;
                    ATTN_NS::attn_unit((LAS unsigned char*)F.lds, F_Q, F_K, F_V, F_AO, h, ML + b * CTX, ML + b * CTX, CTX / at::KT, 0, 0, F.tid); }
            }
#else
            const int nu_att = NB * 8 * 256 + (l == 0 ? NB * 8 * 8 : 0);
            for (int u = F.bid; u < nu_att; u += F.G) {
                if (u < NB * 8 * 256) { const int qt = u & 255, h = (u >> 8) & 7, b = u >> 11; attn_unit_naive(F, h, b * SEQ + qt * 32, ML + b * CTX, CTX, b * SEQ, SEQ); }
                else { const int v = u - NB * 8 * 256; const int qt = v & 7, h = (v >> 3) & 7, b = v >> 6; attn_unit_naive(F, h, ML + b * CTX + qt * 32, ML + b * CTX, CTX, 0, 0); }
            }
#endif
#if FAST_RET
            REFRESH();
            { const float* decf = FIN(I_DECF); const float* decb = FIN(I_DECB); const float* gng = FIN(I_GNG) + l * 512; const float* gnb = FIN(I_GNB) + l * 512;
              const int ncr = (l == 0) ? 66 : 64, c0r = (l == 0) ? 0 : 2;
              for (int rep = REP_R3 - 1; rep >= 0; --rep)
              for (int u = (F.bid + F.G - 32) % F.G; u < 16 * ncr; u += F.G) { const int bh = u / ncr, c = c0r + u % ncr;
                  rt::chunk_out_unit((LAS unsigned char*)F.lds, F_RET, F_ST, gng, gnb, rt::log2_decay(decf, l, bh & 3), rt::log2_decay(decb, l, bh & 3), bh, c, F.tid, rep > 0); }
              REFRESH();
              const int nch = nrows_mix / 128;
              for (int rep = REP_GMLP - 1; rep >= 0; --rep)
              for (int u = (F.bid + F.G - 64) % F.G; u < nch * 4; u += F.G) { const int g = u & 3; rt::gmlp_unit((LAS unsigned char*)F.lds, F_UV, FIN(I_GWS) + ((size_t)l * 4 + g) * 128 * 128, FIN(I_GBS) + (l * 4 + g) * 128, FWS(float, WS_PARTV), FIN(I_LNG) + l * 512, FIN(I_LNB) + l * 512, u >> 2, g, F.tid, rep > 0); } }
#else
            const int nu_ret = NB * 4 * 256 + (l == 0 ? NB * 4 * 8 : 0);
            for (int u = F.bid; u < nu_ret; u += F.G) {
                if (u < NB * 4 * 256) { const int qt = u & 255, h = (u >> 8) & 3, b = u >> 10; ret_unit_naive(F, l, b, h, qt * 32, false); }
                else { const int v = u - NB * 4 * 256; const int qt = v & 7, h = (v >> 3) & 3, b = v >> 5; ret_unit_naive(F, l, b, h, qt * 32, true); }
            }
            const int nch = nrows_mix / 128;
            for (int u = F.bid; u < nch * 4; u += F.G) gmlp_unit_naive(F, l, u >> 2, u & 3);
#endif
        } SEAM(pb + 5);
        if (IN(pb + 6)) { for (int rep = 0; rep < REP_MERGE; ++rep) { if (FAST_MERGE) p_merge_fast(F, l, nrows_mix); else p_merge_naive(F, l, nrows_mix); asm volatile("" : "+v"(F.tid)); } } SEAM(pb + 6);
        if (IN(pb + 7)) { if (FAST_OUT) p_out_fast(F, l, nrows_mix); else p_out_naive(F, l, nrows_mix); REFRESH(); if (FAST_MOE) for (int rep = 0; rep < REP_CVTMOE; ++rep) p_cvt_moe(F, l); } SEAM(pb + 7);
        if (IN(pb + 8)) { for (int rep = 0; rep < REP_NORM2; ++rep) { p_norm2(F, l, nrows_mix); asm volatile("" : "+v"(F.tid)); } } SEAM(pb + 8);
        if (IN(pb + 9)) { for (int rep = 0; rep < REP_ROUTER; ++rep) { if (FAST_ROUTER) p_router_fast(F, l, nrows_mix); else p_router(F, l, nrows_mix); asm volatile("" : "+v"(F.tid)); __syncthreads(); } } SEAM(pb + 9);
        if (IN(pb + 10)) { p_scatter(F, l, nrows_mix); } SEAM(pb + 10);
        if (IN(pb + 11)) { for (int rep = 0; rep < REP_GATEUP; ++rep) { if (FAST_MOE) p_gateup_fast(F, l, nrows_mix); else p_moe_gateup_naive(F, l, nrows_mix); asm volatile("" : "+v"(F.tid)); } } SEAM(pb + 11);
        if (IN(pb + 12)) { for (int rep = REP_DOWN1 - 1; rep >= 0; --rep) { p_down_fast(F, l, nrows_mix, rep > 0); asm volatile("" : "+v"(F.tid)); } } SEAM(pb + 12);
        if (IN(pb + 13)) { if (l + 1 < DEPTH) p_combine<true>(F, l, nrows_mix); else p_combine<false>(F, l, nrows_mix); } SEAM(pb + 13);
    }
}

__global__ void __launch_bounds__(NTHR, 2) fwd_kernel(Args args) {
    extern __shared__ __attribute__((aligned(16))) unsigned char lds[];
    Frame F;
    F.lds = lds; F.tid = threadIdx.x; F.lane = F.tid & 63; F.wave = __builtin_amdgcn_readfirstlane(F.tid >> 6); F.G = gridDim.x; F.bid = blockIdx.x;
    F.A = &args;
    volatile LAS unsigned* MISC = (volatile LAS unsigned*)((LAS unsigned char*)lds + MISC_OFF);
    if (F.tid < 32) MISC[F.tid] = 0u;
    __syncthreads();
    int lo = args.ph_lo, hi = args.ph_hi;
    XcdBarrier bar; bar.bar = F_ctl + CW_BAR; bar.x = 0; bar.st = nullptr;
    if (hi - lo > 1) bar = xcd_barrier_post(F_ctl + CW_BAR, MISC + 8);
    STAMP(0);
    if (IN(0)) { for (int rep = 0; rep < REP_PRO; ++rep) { p_prologue(F); p_cvt_small(F); __syncthreads(); } } SEAM(0);
    static_assert(DEPTH == 2, "two explicit layer bodies");
    layer_body<0>(F, lo, hi, bar); layer_body<1>(F, lo, hi, bar);
#ifdef PROBE_A
    xcd_barrier(bar, F.tid);
    { const unsigned long long* ts = (const unsigned long long*)(ws_(F.A) + WS_CTL + 262144);
      float r = 1.0f; if (PROBE_A >= 0) { const float tus = (float)(ts[PROBE_A + 1] - ts[PROBE_A]) * 0.01f;
          const float q = exp2f(rintf(log2f(tus > 1.0f ? tus : 1.0f) * 3.1062837f) * (1.0f / 3.1062837f)); r = q / (float)(PROBE_TMAX); r = r > 1.0f ? 1.0f : r; }
      const float eps = 0.08f * r; float4* o = (float4*)F_out;
      for (int i = F.bid * NTHR + F.tid; i < ML * D / 4; i += F.G * NTHR) { float4 v = o[i]; v.x += eps; v.y += eps; v.z += eps; v.w += eps; o[i] = v; } }
#endif
#undef IN
#undef SEAM
}

#ifndef MK_PER_PHASE
#define MK_PER_PHASE 0
#endif
extern "C" void kernel_launch(void* const* d_in, const int* in_sizes, int n_in, void* d_out, int out_size, void* d_ws, size_t ws_size, hipStream_t stream) {
    static int grid = 0;
    if (grid == 0) {
        if (n_in != 36 || out_size != ML * D || ws_size < WS_END) { fprintf(stderr, "kernel_launch: unexpected problem (n_in %d out %d ws %zu)\n", n_in, out_size, ws_size); grid = -1; return; }
        int dev = 0, cus = 0;
        if (hipGetDevice(&dev) != hipSuccess || hipDeviceGetAttribute(&cus, hipDeviceAttributeMultiprocessorCount, dev) != hipSuccess) { grid = -1; return; }
        if (hipFuncSetAttribute((const void*)fwd_kernel, hipFuncAttributeMaxDynamicSharedMemorySize, LDS_BYTES) != hipSuccess) { fprintf(stderr, "kernel_launch: hipFuncSetAttribute failed\n"); grid = -1; return; }
        int per_cu = 0;
        if (hipOccupancyMaxActiveBlocksPerMultiprocessor(&per_cu, (const void*)fwd_kernel, NTHR, LDS_BYTES) != hipSuccess || per_cu < 1) fprintf(stderr, "kernel_launch: occupancy query says %d\n", per_cu);
        (void)hipGetLastError();
        grid = cus > 256 ? 256 : cus;
    }
    if (grid < 0) return;
    (void)hipMemsetAsync((char*)d_ws + WS_CTL, 0, CTL_ZERO_BYTES, stream);
    Args a{};
    for (int i = 0; i < 36; ++i) a.in[i] = (const float*)d_in[i];
    a.out = (float*)d_out; a.ws = (unsigned char*)d_ws;
#if MK_PER_PHASE
    for (int p = 0; p < NPH; ++p) { a.ph_lo = p; a.ph_hi = p + 1; hipLaunchKernelGGL(fwd_kernel, dim3(grid), dim3(NTHR), LDS_BYTES, stream, a); }
#else
    a.ph_lo = 0; a.ph_hi = NPH; hipLaunchKernelGGL(fwd_kernel, dim3(grid), dim3(NTHR), LDS_BYTES, stream, a);
#endif
}
```

```cpp
#include <hip/hip_runtime.h>
#include <cstdio>
#include <cstdint>

constexpr int D = 1024, NB = 4, SEQ = 8192, CTX = 256, DEPTH = 2;
constexpr int ML = NB * SEQ;
constexpr int MC = NB * CTX;
constexpr int M = ML + MC;
constexpr int N_IN = 6816, OFF_CQ = 2048, OFF_CKV = 2432, OFF_KR = 2688, OFF_UV = 2720, OFF_MERGE = 3744;
constexpr int NEXP = 64, TOPK = 6, DEXP = 256;
constexpr int APAD = 219136;
constexpr float EPS = 1e-6f;
#ifndef FAST_ROUTER
#define FAST_ROUTER 1
#endif
#ifndef ATTN_NS
#define ATTN_NS at16
#endif
#ifndef REP_ATTN
#define REP_ATTN 1
#endif
#ifndef REP_R3
#define REP_R3 1
#endif
#ifndef REP_GMLP
#define REP_GMLP 1
#endif
#ifndef REP_NORM1
#define REP_NORM1 1
#endif
#ifndef REP_CVTMOE
#define REP_CVTMOE 1
#endif
#ifndef REP_R1
#define REP_R1 1
#endif
#ifndef REP_PRO
#define REP_PRO 1
#endif
#ifndef REP_MERGE
#define REP_MERGE 1
#endif
#ifndef REP_GATEUP
#define REP_GATEUP 1
#endif
#ifndef REP_MLAUP
#define REP_MLAUP 1
#endif
#ifndef REP_DOWN1
#define REP_DOWN1 1
#endif
#ifndef REP_INPROJ
#define REP_INPROJ 1
#endif
#ifndef REP_NORM2
#define REP_NORM2 1
#endif
#ifndef REP_ROUTER
#define REP_ROUTER 1
#endif
constexpr float QSCALE = 0.14724649622f;

constexpr size_t MiB = 1u << 20;
constexpr size_t WS_CTL = 0, CTL_ZERO_BYTES = 1 * MiB;
constexpr size_t WS_MOD = 1 * MiB;
constexpr size_t WS_ROPE = 2 * MiB;
constexpr size_t WS_XC = 4 * MiB;
constexpr size_t WS_IDX = 8 * MiB;
constexpr size_t WS_WTS = 9 * MiB;
constexpr size_t WS_SLOT = 10 * MiB;
constexpr size_t WS_INV = 11 * MiB;
constexpr size_t WS_ROWTOK = 12 * MiB;
constexpr size_t WS_BLKBASE = 13 * MiB;
constexpr size_t WS_WSM = 14 * MiB;
constexpr size_t SMW_WIN = 0, SMW_WG = SMW_WIN + (size_t)3840 * 2048, SMW_WUQ = SMW_WG + (size_t)3072 * 2048, SMW_WUKV = SMW_WUQ + (size_t)1024 * 768,
                 SMW_WBR = SMW_WUKV + (size_t)1024 * 512, SMW_WOUT = SMW_WBR + (size_t)3 * 1024 * 1024, SMW_SHGU = SMW_WOUT + (size_t)1024 * 2048,
                 SMW_SHD = SMW_SHGU + (size_t)512 * 2048, SMW_RT = SMW_SHD + (size_t)1024 * 512, SMW_L = SMW_RT + (size_t)2 * 64 * 1024 * 2;
static_assert(WS_WSM + 2 * SMW_L <= 60 * MiB, "small weights");
constexpr size_t WS_MOEW = 126 * MiB;
constexpr size_t WS_SCR = 566 * MiB;
constexpr size_t WS_H = 60 * MiB;
constexpr size_t WS_RET = 126 * MiB;
constexpr size_t WS_CQ = 258 * MiB;
constexpr size_t WS_CKV = WS_CQ + (size_t)M * 384 * 2;
constexpr size_t WS_KR = WS_CKV + (size_t)M * 256 * 2;
constexpr size_t WS_AO = 258 * MiB;
constexpr size_t WS_UV = 302 * MiB;
constexpr size_t WS_Q = 368 * MiB;
constexpr size_t WS_K = WS_Q + (size_t)M * 768 * 2;
constexpr size_t WS_Y = 368 * MiB;
constexpr size_t WS_V = 467 * MiB;
constexpr size_t WS_ST = 500 * MiB;
constexpr size_t WS_HB = 222 * MiB;
constexpr size_t WS_HBS = 329 * MiB;
constexpr size_t WS_OUT = 346 * MiB;
constexpr size_t WS_PART = 632 * MiB;
constexpr size_t WS_PARTV = 636 * MiB;
constexpr size_t WS_END = 642 * MiB;
static_assert(WS_KR + (size_t)M * 32 * 2 <= WS_UV && WS_K + (size_t)M * 768 * 2 <= WS_V && WS_V + (size_t)M * 512 * 2 <= WS_ST, "ws map");
static_assert(WS_HB + (size_t)APAD * 256 * 2 <= WS_HBS && WS_HBS + (size_t)M * 256 * 2 <= WS_OUT && WS_OUT + (size_t)APAD * 512 * 2 <= WS_END, "ws map moe");
constexpr int CW_BAR = 4096;
constexpr int CW_CNT = 16384;

constexpr int NWAVES = 8, NTHR = 512;
constexpr int LDS_BYTES = 147456;
constexpr int MISC_OFF = 139264;

#define LAS __attribute__((address_space(3)))
#define GAS __attribute__((address_space(1)))
typedef unsigned short bf16_t;
__device__ __forceinline__ unsigned f2bf(float f) { unsigned u = __builtin_bit_cast(unsigned, f); return (u + 0x7fffu + ((u >> 16) & 1u)) >> 16; }
__device__ __forceinline__ float bf2f(bf16_t h) { return __builtin_bit_cast(float, (unsigned)h << 16); }
__device__ __forceinline__ float sigmoidf_(float x) { return 1.0f / (1.0f + expf(-x)); }
__device__ __forceinline__ float siluf_(float x) { return x / (1.0f + expf(-x)); }
__device__ __forceinline__ float gelu_tanh(float x) { const float u = 0.7978845608028654f * (x + 0.044715f * x * x * x); return 0.5f * x * (1.0f + tanhf(u)); }
__device__ __forceinline__ float xlane32(float v, int lane) { return __builtin_bit_cast(float, __builtin_amdgcn_ds_bpermute((lane ^ 32) << 2, __builtin_bit_cast(int, v))); }
__device__ __forceinline__ int xlane32i(int v, int lane) { return __builtin_amdgcn_ds_bpermute((lane ^ 32) << 2, v); }
template <int CTRL> __device__ __forceinline__ float dppx(float v) { return __builtin_bit_cast(float, __builtin_amdgcn_update_dpp(0, __builtin_bit_cast(int, v), CTRL, 0xf, 0xf, true)); }
__device__ __forceinline__ float row16_sum(float v) { v += dppx<0xB1>(v); v += dppx<0x4E>(v); v += dppx<0x141>(v); v += dppx<0x140>(v); return v; }
__device__ __forceinline__ float wave_sum(float v) {
    v = row16_sum(v);
    const float a = __builtin_bit_cast(float, __builtin_amdgcn_readlane(__builtin_bit_cast(int, v), 0)), b = __builtin_bit_cast(float, __builtin_amdgcn_readlane(__builtin_bit_cast(int, v), 16));
    const float c = __builtin_bit_cast(float, __builtin_amdgcn_readlane(__builtin_bit_cast(int, v), 32)), d = __builtin_bit_cast(float, __builtin_amdgcn_readlane(__builtin_bit_cast(int, v), 48));
    return (a + b) + (c + d);
}

#define XB_TMO      128
#define XB_XCNT(j)  (256  + 64 * (j))
#define XB_XSUB(j)  (1280 + 64 * (j))
#define XB_XGEN(j)  (2304 + 64 * (j))
#define XB_TOP      3328
#define XB_TOPGEN   3392
#define XCD_BAR_WORDS 3456
#define XB_SPIN_CAP (1u << 22)
__device__ __forceinline__ unsigned xb_ld(unsigned* p)              { return __hip_atomic_load(p, __ATOMIC_RELAXED, __HIP_MEMORY_SCOPE_AGENT); }
__device__ __forceinline__ unsigned xb_add(unsigned* p, unsigned v) { return __hip_atomic_fetch_add(p, v, __ATOMIC_RELAXED, __HIP_MEMORY_SCOPE_AGENT); }
__device__ __forceinline__ unsigned xb_xcc_id() { return (unsigned)__builtin_amdgcn_s_getreg((3 << 11) | 20) & 0xFu; }
#define XB_SPIN(cond, bar) do { unsigned _sp = 0; while (cond) { __builtin_amdgcn_s_sleep(1); \
    if ((++_sp & 255u) == 0u) { if (xb_ld(&(bar)[XB_TMO])) break; if (_sp > XB_SPIN_CAP) { atomicAdd(&(bar)[XB_TMO], 1u); break; } } } } while (0)
struct XcdBarrier { unsigned* bar; unsigned x; volatile LAS unsigned* st; };
__device__ __forceinline__ XcdBarrier xcd_barrier_post(unsigned* bar, volatile LAS unsigned* st) {
    XcdBarrier b; b.bar = bar; b.x = xb_xcc_id(); b.st = st;
    if (threadIdx.x == 0) (void)xb_add(&bar[XB_XCNT(b.x)], 1u);
    return b;
}
__device__ __forceinline__ void xcd_barrier_complete(unsigned* bar, unsigned x, unsigned& nloc, unsigned& nx) {
    const unsigned G = gridDim.x * gridDim.y * gridDim.z;
    unsigned sum, cnt, mine, sp = 0u;
    for (;;) {
        sum = 0u; cnt = 0u; mine = 0u;
#pragma unroll
        for (unsigned j = 0; j < 16; ++j) { const unsigned c = xb_ld(&bar[XB_XCNT(j)]); sum += c; cnt += (c > 0u) ? 1u : 0u; mine = (j == x) ? c : mine; }
        if (sum == G) break;
        __builtin_amdgcn_s_sleep(1);
        if ((++sp & 255u) == 0u) { if (xb_ld(&bar[XB_TMO])) break; if (sp > XB_SPIN_CAP) { atomicAdd(&bar[XB_TMO], 1u); break; } }
    }
    nloc = mine > 0u ? mine : 1u; nx = cnt > 0u ? cnt : 1u;
}
__device__ __forceinline__ void xcd_barrier(const XcdBarrier& b, int tid) {
    asm volatile("s_waitcnt vmcnt(0)" ::: "memory");
    __syncthreads();
    if (tid == 0) {
        GAS unsigned* barg = (GAS unsigned*)b.bar; unsigned bx = b.x;
        asm volatile("" : "+s"(barg), "+s"(bx));
        unsigned* bar = (unsigned*)barg;
        __builtin_amdgcn_s_waitcnt(0);
        unsigned nloc = b.st[0], nx = b.st[1];
        if (nloc == 0u) { xcd_barrier_complete(bar, bx, nloc, nx); b.st[0] = nloc; b.st[1] = nx; }
        const unsigned old = xb_add(&bar[XB_XSUB(bx)], 1u);
        const unsigned gen = old / nloc;
        if (old + 1u == (gen + 1u) * nloc) {
            __builtin_amdgcn_fence(__ATOMIC_RELEASE, "agent");
            asm volatile("s_waitcnt vmcnt(0)" ::: "memory");
            const unsigned og = xb_add(&bar[XB_TOP], 1u);
            const unsigned tg = og / nx;
            if (og + 1u == (tg + 1u) * nx) xb_add(&bar[XB_TOPGEN], 1u);
            else XB_SPIN(xb_ld(&bar[XB_TOPGEN]) == tg, bar);
            __builtin_amdgcn_fence(__ATOMIC_ACQUIRE, "agent");
            xb_add(&bar[XB_XGEN(bx)], 1u);
            asm volatile("s_waitcnt vmcnt(0)" ::: "memory");
        } else {
            XB_SPIN(xb_ld(&bar[XB_XGEN(bx)]) == gen, bar);
            __builtin_amdgcn_fence(__ATOMIC_ACQUIRE, "agent");
            asm volatile("s_waitcnt vmcnt(0)" ::: "memory");
        }
    }
    __syncthreads();
}

struct Args {
    const float* in[36]; float* out; unsigned char* ws; int ph_lo, ph_hi;
};
enum { I_X = 0, I_C, I_CTX, I_CCTX, I_ADAW, I_ADAB, I_N1G, I_N2G, I_WIN, I_DECF, I_DECB, I_GNG, I_GNB, I_WBRRET,
       I_QAG, I_WUQ, I_KVAG, I_WUKV, I_QNG, I_KNG, I_KRG, I_WBRMLA, I_LNG, I_LNB, I_GWS, I_GBS, I_WBRG, I_WOUT,
       I_ROUTER, I_MBIAS, I_WG, I_WU, I_WD, I_SG, I_SU, I_SD };

struct Frame {
    unsigned char* lds; int tid, lane, wave, G, bid;
    const Args* A;
};
__device__ __forceinline__ unsigned long long uni64_(unsigned long long v) { const unsigned a = __builtin_amdgcn_readfirstlane((unsigned)v), b = __builtin_amdgcn_readfirstlane((unsigned)(v >> 32)); return ((unsigned long long)b << 32) | a; }
__device__ __forceinline__ const float* fin_(const Args* A, int i) { asm volatile("" : "+v"(i)); i = __builtin_amdgcn_readfirstlane(i); const GAS float* g = (const GAS float*)uni64_((unsigned long long)A->in[i]); asm volatile("" : "+s"(g)); return (const float*)g; }
#define FIN(i) fin_(F.A, (i))
__device__ __forceinline__ unsigned char* ws_(const Args* A) { GAS unsigned char* g = (GAS unsigned char*)uni64_((unsigned long long)A->ws); asm volatile("" : "+s"(g)); return (unsigned char*)g; }
#define FWS(T, off) ((T*)(ws_(F.A) + (off)))
__device__ __forceinline__ float* out_(const Args* A) { GAS float* g = (GAS float*)uni64_((unsigned long long)A->out); asm volatile("" : "+s"(g)); return (float*)g; }
#define F_out out_(F.A)
#define F_ctl FWS(unsigned, WS_CTL)
#define F_MOD FWS(float, WS_MOD)
#define F_ROPE FWS(float, WS_ROPE)
#define F_XC FWS(float, WS_XC)
#define F_IDX FWS(int, WS_IDX)
#define F_WTS FWS(float, WS_WTS)
#define F_SLOT FWS(int, WS_SLOT)
#define F_INV FWS(int, WS_INV)
#define F_ROWTOK FWS(int, WS_ROWTOK)
#define F_BLKBASE FWS(int, WS_BLKBASE)
#define F_H ((bf16_t*)out_(F.A))
#define F_X16 FWS(bf16_t, WS_H)
#define F_RET FWS(bf16_t, WS_RET)
#define F_CQ FWS(bf16_t, WS_CQ)
#define F_CKV FWS(bf16_t, WS_CKV)
#define F_KR FWS(bf16_t, WS_KR)
#define F_AO FWS(bf16_t, WS_AO)
#define F_UV FWS(bf16_t, WS_UV)
#define F_Q FWS(bf16_t, WS_Q)
#define F_K FWS(bf16_t, WS_K)
#define F_V FWS(bf16_t, WS_V)
#define F_Y FWS(bf16_t, WS_Y)
#define F_ST FWS(bf16_t, WS_ST)
#define F_KVR FWS(bf16_t, WS_SCR)
#define F_HB FWS(bf16_t, WS_HB)
#define F_HBS FWS(bf16_t, WS_HBS)
#define F_OUT FWS(bf16_t, WS_OUT)
__device__ __forceinline__ int row_batch(int r) { return r < ML ? (r >> 13) : 4; }
__device__ __forceinline__ const float* x_row_src(const Frame& F, int l, int r) { return r < ML ? ((l == 0 ? FIN(I_X) : F_out) + (size_t)r * D) : (F_XC + (size_t)(r - ML) * D); }
__device__ __forceinline__ float* x_row_dst(const Frame& F, int r) { return r < ML ? (F_out + (size_t)r * D) : (F_XC + (size_t)(r - ML) * D); }

__device__ __forceinline__ void ngemm_acc(float (&acc)[4][4], const bf16_t* A, int lda, const int* rowidx, int row0, int nrows,
                                          const float* W, int ldw, int col0, int ncols, int K, float* sA, float* sW, int tid) {
    const int ty = tid >> 4, tx = tid & 15;
    const int lr = tid >> 2, lk = (tid & 3) * 8;
    const int wk = tid >> 4, wc = (tid & 15) * 4;
    const bool rv = (row0 + lr) < nrows;
    const bf16_t* arow = nullptr;
    if (rv) { const int rr = rowidx ? rowidx[row0 + lr] : (row0 + lr); arow = A + (size_t)rr * lda; }
    const bool cv = (col0 + wc) < ncols;
    for (int k0 = 0; k0 < K; k0 += 32) {
        uint4 av = make_uint4(0u, 0u, 0u, 0u);
        if (rv) av = *(const uint4*)(arow + k0 + lk);
        float4 wv = make_float4(0.f, 0.f, 0.f, 0.f);
        if (cv) wv = *(const float4*)(W + (size_t)(k0 + wk) * ldw + col0 + wc);
        __syncthreads();
        float* sa = sA + lr * 33 + lk;
        sa[0] = __builtin_bit_cast(float, av.x << 16); sa[1] = __builtin_bit_cast(float, av.x & 0xffff0000u);
        sa[2] = __builtin_bit_cast(float, av.y << 16); sa[3] = __builtin_bit_cast(float, av.y & 0xffff0000u);
        sa[4] = __builtin_bit_cast(float, av.z << 16); sa[5] = __builtin_bit_cast(float, av.z & 0xffff0000u);
        sa[6] = __builtin_bit_cast(float, av.w << 16); sa[7] = __builtin_bit_cast(float, av.w & 0xffff0000u);
        *(float4*)(sW + wk * 64 + wc) = wv;
        __syncthreads();
#pragma unroll 8
        for (int kk = 0; kk < 32; ++kk) {
            const float4 w = *(const float4*)(sW + kk * 64 + tx * 4);
            float a[4];
#pragma unroll
            for (int i = 0; i < 4; ++i) a[i] = sA[(ty * 4 + i) * 33 + kk];
#pragma unroll
            for (int i = 0; i < 4; ++i) { acc[i][0] += a[i] * w.x; acc[i][1] += a[i] * w.y; acc[i][2] += a[i] * w.z; acc[i][3] += a[i] * w.w; }
        }
    }
}
#define ZERO_ACC(a) do { _Pragma("unroll") for (int _i = 0; _i < 4; ++_i) _Pragma("unroll") for (int _j = 0; _j < 4; ++_j) a[_i][_j] = 0.f; } while (0)

namespace g8 {
typedef short bf16x8 __attribute__((ext_vector_type(8)));
typedef float f32x4 __attribute__((ext_vector_type(4)));
typedef unsigned u32x4 __attribute__((ext_vector_type(4)));
typedef float f32x2 __attribute__((ext_vector_type(2)));
typedef __bf16 bf16x2_t __attribute__((ext_vector_type(2)));
constexpr int HTB = 16384, STAGE_BYTES = 8 * HTB;
__device__ __forceinline__ int lds_byte(int r, int c) { const int st = (r >> 4) * 2 + (c >> 5), rr = r & 15, cc = c & 31, ob = rr * 64 + cc * 2; return st * 1024 + (ob ^ (((ob >> 9) & 1) << 5)); }
__device__ __forceinline__ void stage_rc(int b, int& R, int& C) { const int st = b / 1024, sb = b % 1024, swz = sb ^ (((sb >> 9) & 1) << 5); R = (st >> 1) * 16 + swz / 64; C = (st & 1) * 32 + (swz % 64) / 2; }
__device__ __forceinline__ int perm32(int rho) { const int n = rho >> 4, i = rho & 15; return 8 * (i >> 2) + 4 * n + (i & 3); }
__device__ __forceinline__ unsigned cvtpk(float lo, float hi) { f32x2 v = {lo, hi}; bf16x2_t b = __builtin_convertvector(v, bf16x2_t); return __builtin_bit_cast(unsigned, b); }
__device__ __forceinline__ float fsigmoid(float x) { return __builtin_amdgcn_rcpf(1.0f + __builtin_amdgcn_exp2f(-1.4426950408889634f * x)); }
__device__ __forceinline__ u32x4 pack8(const f32x4& a, const f32x4& b) { u32x4 w; w.x = cvtpk(a[0], a[1]); w.y = cvtpk(a[2], a[3]); w.z = cvtpk(b[0], b[1]); w.w = cvtpk(b[2], b[3]); return w; }
__device__ __forceinline__ void unpack8(const u32x4& w, f32x4& a, f32x4& b) {
    a[0] = __builtin_bit_cast(float, w.x << 16); a[1] = __builtin_bit_cast(float, w.x & 0xffff0000u); a[2] = __builtin_bit_cast(float, w.y << 16); a[3] = __builtin_bit_cast(float, w.y & 0xffff0000u);
    b[0] = __builtin_bit_cast(float, w.z << 16); b[1] = __builtin_bit_cast(float, w.z & 0xffff0000u); b[2] = __builtin_bit_cast(float, w.w << 16); b[3] = __builtin_bit_cast(float, w.w & 0xffff0000u); }

struct GUnit { const char* A; const char* B; const int* rows; int arow0; unsigned lda2, ldb2; int nt; int pm, pn, tag; };

#define G8_ROWS(u, ra) do { _Pragma("unroll") for (int _h = 0; _h < 2; ++_h) { \
        const int _x0 = (u).arow0 + _h * 128 + R0, _x1 = (u).arow0 + _h * 128 + R1; \
        ra[_h][0] = (u).rows ? (u).rows[_x0] : _x0; ra[_h][1] = (u).rows ? (u).rows[_x1] : _x1; } } while (0)

template <bool GATHER, class Sched, class Epi>
__device__ __forceinline__ void gemm_phase(LAS unsigned char* lds, const Sched& S, const Epi& E, int tid_in) {
    int tid = tid_in; asm volatile("" : "+v"(tid));
    const int wid = __builtin_amdgcn_readfirstlane(tid >> 6), lane = tid & 63, wr = wid >> 2, wc = wid & 3, fr = lane & 15, fq = lane >> 4;
    int R0, C0, R1, C1; stage_rc(tid * 16, R0, C0); stage_rc(tid * 16 + 8192, R1, C1);
    const int Rb0 = (R0 & ~31) + perm32(R0 & 31), Rb1 = (R1 & ~31) + perm32(R1 & 31);
    const unsigned ldsw = (unsigned)wid * 1024u, cb0 = (unsigned)C0 * 2u, cb1 = (unsigned)C1 * 2u;
    const int aoff = lds_byte(wr * 64 + fr, fq * 8), boff = lds_byte(wc * 32 + fr, fq * 8);
#define G8_SA(b, h) (((b) * 2 + (h)) * HTB)
#define G8_SB(b, h) ((4 + (b) * 2 + (h)) * HTB)
#define G8_GLDS(gptr, bufoff, i) __builtin_amdgcn_global_load_lds((const unsigned*)(gptr), (LAS unsigned*)(lds + (bufoff) + ldsw + (i) * 8192), 16, 0, 0)
#define G8_STAGE_A(bufoff, gbase, ld2, ra2, arow, h, kb) do { if constexpr (GATHER) { \
        G8_GLDS((gbase) + (size_t)((unsigned)(ra2)[0] * (ld2) + cb0 + (kb)), bufoff, 0); G8_GLDS((gbase) + (size_t)((unsigned)(ra2)[1] * (ld2) + cb1 + (kb)), bufoff, 1); } else { \
        G8_GLDS((gbase) + (size_t)((unsigned)((arow) + (h) * 128 + R0) * (ld2) + cb0 + (kb)), bufoff, 0); G8_GLDS((gbase) + (size_t)((unsigned)((arow) + (h) * 128 + R1) * (ld2) + cb1 + (kb)), bufoff, 1); } } while (0)
#define G8_STAGE_B(bufoff, gbase, ld2, h, kb) do { G8_GLDS((gbase) + (size_t)((unsigned)((h) * 128 + Rb0) * (ld2) + cb0 + (kb)), bufoff, 0); G8_GLDS((gbase) + (size_t)((unsigned)((h) * 128 + Rb1) * (ld2) + cb1 + (kb)), bufoff, 1); } while (0)
#define G8_LDA(dst, b, h) do { _Pragma("unroll") for (int m = 0; m < 4; ++m) _Pragma("unroll") for (int k = 0; k < 2; ++k) dst[m][k] = *(const LAS bf16x8*)(lds + G8_SA(b, h) + aoff + m * 2048 + k * 1024); } while (0)
#define G8_LDB(dst, b, h) do { _Pragma("unroll") for (int n = 0; n < 2; ++n) _Pragma("unroll") for (int k = 0; k < 2; ++k) dst[n][k] = *(const LAS bf16x8*)(lds + G8_SB(b, h) + boff + n * 2048 + k * 1024); } while (0)
#define G8_MMA(ai, bj, At, Bt) do { __builtin_amdgcn_s_setprio(1); _Pragma("unroll") for (int m = 0; m < 4; ++m) _Pragma("unroll") for (int n = 0; n < 2; ++n) _Pragma("unroll") for (int k = 0; k < 2; ++k) \
        acc[ai][bj][m][n] = __builtin_amdgcn_mfma_f32_16x16x32_bf16(Bt[n][k], At[m][k], acc[ai][bj][m][n], 0, 0, 0); __builtin_amdgcn_s_setprio(0); } while (0)
#define G8_WAIT_V(n) asm volatile("s_waitcnt vmcnt(" #n ")" ::: "memory")
#define G8_WAIT_L(n) asm volatile("s_waitcnt lgkmcnt(" #n ")" ::: "memory")
#define G8_BAR __builtin_amdgcn_s_barrier()
#define G8_SCHED __builtin_amdgcn_sched_barrier(0)
    GUnit cur, nxt; int ui = 0;
    if (!S.get(0, cur)) return;
#define G8_OPAQUE(u) do { (u).lda2 = (unsigned)__builtin_amdgcn_readfirstlane((int)(u).lda2); (u).ldb2 = (unsigned)__builtin_amdgcn_readfirstlane((int)(u).ldb2); (u).nt = __builtin_amdgcn_readfirstlane((u).nt); (u).arow0 = __builtin_amdgcn_readfirstlane((u).arow0); \
    asm volatile("" : "+s"((u).lda2), "+s"((u).ldb2), "+s"((u).nt), "+s"((u).arow0)); } while (0)
    G8_OPAQUE(cur);
    int ra_c[2][2], ra_n[2][2];
    if constexpr (GATHER) { G8_ROWS(cur, ra_c); }
    f32x4 acc[2][2][4][2];
#pragma unroll
    for (int a = 0; a < 2; ++a)
#pragma unroll
        for (int b = 0; b < 2; ++b)
#pragma unroll
            for (int m = 0; m < 4; ++m)
#pragma unroll
                for (int n = 0; n < 2; ++n) acc[a][b][m][n] = (f32x4){0.f, 0.f, 0.f, 0.f};
    bf16x8 At[4][2], B0[2][2], B1[2][2];
    G8_STAGE_B(G8_SB(0, 0), cur.B, cur.ldb2, 0, 0u); G8_STAGE_B(G8_SB(0, 1), cur.B, cur.ldb2, 1, 0u); G8_STAGE_A(G8_SA(0, 0), cur.A, cur.lda2, ra_c[0], cur.arow0, 0, 0u); G8_STAGE_A(G8_SA(0, 1), cur.A, cur.lda2, ra_c[1], cur.arow0, 1, 0u);
    if (wr == 1) G8_BAR;
    G8_WAIT_V(2); G8_BAR;
    G8_STAGE_B(G8_SB(1, 0), cur.B, cur.ldb2, 0, 128u); G8_STAGE_A(G8_SA(1, 0), cur.A, cur.lda2, ra_c[0], cur.arow0, 0, 128u); G8_STAGE_B(G8_SB(1, 1), cur.B, cur.ldb2, 1, 128u);
    G8_WAIT_V(6); G8_BAR;
    for (;;) {
        const bool has_next = S.get(ui + 1, nxt);
        if (has_next) G8_OPAQUE(nxt);
        if (has_next) { if constexpr (GATHER) { G8_ROWS(nxt, ra_n); } }
        else { nxt = cur;
            if constexpr (GATHER) {
#pragma unroll
            for (int h = 0; h < 2; ++h)
#pragma unroll
                for (int i = 0; i < 2; ++i) ra_n[h][i] = ra_c[h][i]; } }
        const int nt = cur.nt;
        for (int t = 0; t < nt; t += 2) {
            const bool last = (t == nt - 2);
            const char* a2 = last ? nxt.A : cur.A; const char* b2 = last ? nxt.B : cur.B;
            const unsigned la2 = last ? nxt.lda2 : cur.lda2, lb2 = last ? nxt.ldb2 : cur.ldb2;
            const unsigned k1 = (unsigned)(t + 1) * 128u, k2 = last ? 0u : (unsigned)(t + 2) * 128u, k3 = k2 + 128u;
            const int ar2 = last ? nxt.arow0 : cur.arow0; (void)ar2;
            int ra2[2][2];
            if constexpr (GATHER) {
#pragma unroll
            for (int h = 0; h < 2; ++h)
#pragma unroll
                for (int i = 0; i < 2; ++i) ra2[h][i] = last ? ra_n[h][i] : ra_c[h][i]; }
            G8_LDB(B0, 0, 0); G8_LDB(B1, 0, 1); G8_SCHED; G8_LDA(At, 0, 0); G8_STAGE_A(G8_SA(1, 1), cur.A, cur.lda2, ra_c[1], cur.arow0, 1, k1);
            G8_WAIT_V(8); G8_WAIT_L(0); G8_BAR; G8_MMA(0, 0, At, B0); G8_MMA(0, 1, At, B1); G8_BAR; G8_SCHED;
            G8_LDA(At, 0, 1); G8_STAGE_B(G8_SB(0, 0), b2, lb2, 0, k2); G8_STAGE_B(G8_SB(0, 1), b2, lb2, 1, k2); G8_STAGE_A(G8_SA(0, 0), a2, la2, ra2[0], ar2, 0, k2);
            G8_WAIT_V(8); G8_WAIT_L(0); G8_BAR; G8_MMA(1, 0, At, B0); G8_MMA(1, 1, At, B1); G8_BAR; G8_SCHED;
            G8_LDB(B0, 1, 0); G8_LDB(B1, 1, 1); G8_SCHED; G8_LDA(At, 1, 0); G8_STAGE_A(G8_SA(0, 1), a2, la2, ra2[1], ar2, 1, k2);
            G8_WAIT_V(8); G8_WAIT_L(0); G8_BAR; G8_MMA(0, 0, At, B0); G8_MMA(0, 1, At, B1); G8_BAR; G8_SCHED;
            G8_LDA(At, 1, 1); G8_STAGE_B(G8_SB(1, 0), b2, lb2, 0, k3); G8_STAGE_B(G8_SB(1, 1), b2, lb2, 1, k3); G8_STAGE_A(G8_SA(1, 0), a2, la2, ra2[0], ar2, 0, k3);
            G8_WAIT_V(8); G8_WAIT_L(0); G8_BAR; G8_MMA(1, 0, At, B0); G8_MMA(1, 1, At, B1); G8_BAR; G8_SCHED;
        }
        if (wr == 0) G8_BAR;
        { int efr = fr, efq = fq, etid = tid; asm volatile("" : "+v"(efr), "+v"(efq), "+v"(etid));
          E(acc, cur, wr, wc, efr, efq, etid); }
        if (!has_next) break;
#pragma unroll
        for (int a = 0; a < 2; ++a)
#pragma unroll
            for (int b = 0; b < 2; ++b)
#pragma unroll
                for (int m = 0; m < 4; ++m)
#pragma unroll
                    for (int n = 0; n < 2; ++n) acc[a][b][m][n] = (f32x4){0.f, 0.f, 0.f, 0.f};
        cur = nxt; ++ui;
        if constexpr (GATHER) {
#pragma unroll
        for (int h = 0; h < 2; ++h)
#pragma unroll
            for (int i = 0; i < 2; ++i) ra_c[h][i] = ra_n[h][i]; }
        if (wr == 1) G8_BAR;
    }
    G8_WAIT_V(0);
    G8_BAR;
#undef G8_SA
#undef G8_SB
#undef G8_GLDS
#undef G8_OPAQUE
#undef G8_STAGE_A
#undef G8_STAGE_B
#undef G8_LDA
#undef G8_LDB
#undef G8_MMA
#undef G8_WAIT_V
#undef G8_WAIT_L
#undef G8_BAR
#undef G8_SCHED
}
__device__ __forceinline__ bool tile_order(int i, int G, int c, int nM, int nN, int& pm, int& pn) {
    const int nwg = nM * nN; const long L = (long)i * G + c; if (L >= nwg) return false;
    int wgid = (int)L; { const int q = nwg / 8, r = nwg % 8, xcd = wgid % 8, off = wgid / 8; wgid = (xcd < r ? xcd * (q + 1) : r * (q + 1) + (xcd - r) * q) + off; }
    const int nig = 8 * nN, gid = wgid / nig, fm = gid * 8, gsz = (nM - fm) < 8 ? (nM - fm) : 8;
    pm = fm + ((wgid % nig) % gsz); pn = (wgid % nig) / gsz; return true;
}
}

__device__ __forceinline__ float sumsq8(const g8::f32x4& a, const g8::f32x4& b) { return (a[0] * a[0] + a[1] * a[1]) + (a[2] * a[2] + a[3] * a[3]) + (b[0] * b[0] + b[1] * b[1]) + (b[2] * b[2] + b[3] * b[3]); }
__device__ __forceinline__ void p_prologue(Frame& F) {
    float* sred = (float*)F.lds;
    const float* cvp = FIN(I_C); const float* ccp = FIN(I_CCTX); const float* adab = FIN(I_ADAB); const float* adaw = FIN(I_ADAW);
    float* ssil = sred + 8 * 64 * 5;
    if (F.bid < 2 * 96) { for (int i = F.tid; i < 5 * D; i += NTHR) { const float v = i < 4 * D ? cvp[i] : ccp[i - 4 * D]; ssil[i] = siluf_(v); } }
    __syncthreads();
    for (int u = F.bid; u < 2 * 96; u += F.G) {
        const int l = u / 96, n0 = (u % 96) * 64, n = n0 + (F.tid & 63), ks = F.tid >> 6;
        float a[5] = {0.f, 0.f, 0.f, 0.f, 0.f};
        const float* W = adaw + (size_t)l * D * 6144;
#pragma unroll 8
        for (int k = ks * 128; k < ks * 128 + 128; ++k) {
            const float w = W[(size_t)k * 6144 + n];
#pragma unroll
            for (int b = 0; b < 5; ++b) a[b] += ssil[b * D + k] * w;
        }
        __syncthreads();
#pragma unroll
        for (int b = 0; b < 5; ++b) sred[(ks * 64 + (F.tid & 63)) * 5 + b] = a[b];
        __syncthreads();
        if (F.tid < 64 * 5) { const int c = F.tid / 5, b = F.tid % 5; float s = 0.f;
            for (int q = 0; q < 8; ++q) s += sred[(q * 64 + c) * 5 + b];
            F_MOD[((size_t)l * 5 + b) * 6144 + n0 + c] = s + adab[l * 6144 + n0 + c]; }
    }
    const int gt = F.bid * NTHR + F.tid, GT = F.G * NTHR;
    for (int i = gt; i < SEQ * 16; i += GT) {
        const int t = i >> 4, a = (i >> 3) & 1, f = i & 7;
        const float inv = powf(10000.0f, -(float)f / 8.0f);
        const float pos = a == 0 ? (float)(t >> 6) : (float)(t & 63);
        const float ang = pos * inv;
        F_ROPE[t * 32 + a * 16 + f] = cosf(ang); F_ROPE[t * 32 + a * 16 + 8 + f] = sinf(ang);
    }
}

__device__ __forceinline__ void p_norm(Frame& F, int l, int which, int nrows) {
    const int gw = F.bid * NWAVES + F.wave, NGW = F.G * NWAVES;
    const float* g = FIN(which == 0 ? I_N1G : I_N2G) + l * D;
    const float* xlat = FIN(I_X); const float* xctx = FIN(I_CTX);
    g8::f32x4 gg[4];
#pragma unroll
    for (int j = 0; j < 4; ++j) gg[j] = *(const g8::f32x4*)(g + j * 256 + F.lane * 4);
    for (int rb = gw; rb < nrows; rb += 4 * NGW) {
        g8::f32x4 v[4][4]; int rr[4];
#pragma unroll
        for (int q = 0; q < 4; ++q) { const int r = rb + q * NGW; rr[q] = r < nrows ? r : rb;
            const g8::f32x4* xr = (const g8::f32x4*)(rr[q] < ML ? xlat + (size_t)rr[q] * D : xctx + (size_t)(rr[q] - ML) * D) + F.lane;
#pragma unroll
            for (int j = 0; j < 4; ++j) v[q][j] = xr[64 * j]; }
#pragma unroll
        for (int q = 0; q < 4; ++q) { if (rb + q * NGW >= nrows) break; const int r = rr[q];
            float s = 0.f;
#pragma unroll
            for (int j = 0; j < 4; ++j) s += (v[q][j][0] * v[q][j][0] + v[q][j][1] * v[q][j][1]) + (v[q][j][2] * v[q][j][2] + v[q][j][3] * v[q][j][3]);
            const float rstd = 1.0f / sqrtf(wave_sum(s) * (1.0f / D) + EPS);
            const float* mod = F_MOD + ((size_t)l * 5 + row_batch(r)) * 6144 + (which == 0 ? 0 : 3 * D);
#pragma unroll
            for (int j = 0; j < 4; ++j) { const int e = j * 256 + F.lane * 4;
                const g8::f32x4 sh = *(const g8::f32x4*)(mod + e), sc = *(const g8::f32x4*)(mod + D + e);
                const g8::f32x4 o = (v[q][j] * rstd * gg[j]) * (sc + 1.0f) + sh;
                uint2 w; w.x = g8::cvtpk(o[0], o[1]); w.y = g8::cvtpk(o[2], o[3]);
                *(uint2*)(F_H + (size_t)r * D + e) = w; } }
    }
}

__device__ __forceinline__ void p_norm2(Frame& F, int l, int nrows) {
    const int gw = F.bid * NWAVES + F.wave, NGW = F.G * NWAVES, e = F.lane * 16;
    const float* g = FIN(I_N2G) + l * D + e;
    constexpr int NLB = ML / 16;
    const int nseg = NLB + (nrows > ML ? nrows - ML : 0);
    for (int seg = gw; seg < nseg; seg += NGW) {
        const int r0 = seg < NLB ? seg * 16 : ML + (seg - NLB), n = seg < NLB ? 16 : 1;
        const float* mod = F_MOD + ((size_t)l * 5 + row_batch(r0)) * 6144 + 3 * D + e;
        g8::f32x4 gs[4], sh[4];
#pragma unroll
        for (int q = 0; q < 4; ++q) { sh[q] = *(const g8::f32x4*)(mod + 4 * q); gs[q] = *(const g8::f32x4*)(g + 4 * q) * (*(const g8::f32x4*)(mod + D + 4 * q) + 1.0f); }
        for (int j0 = 0; j0 < n; j0 += 8) {
            g8::u32x4 v[8][2];
#pragma unroll
            for (int q = 0; q < 8; ++q) { const int r = r0 + (j0 + q < n ? j0 + q : j0); const bf16_t* xr = F_X16 + (size_t)r * D + e; v[q][0] = *(const g8::u32x4*)xr; v[q][1] = *(const g8::u32x4*)(xr + 8); }
#pragma unroll
            for (int q = 0; q < 8; ++q) { if (j0 + q >= n) break; const int r = r0 + j0 + q;
                g8::f32x4 a0, a1, a2, a3; g8::unpack8(v[q][0], a0, a1); g8::unpack8(v[q][1], a2, a3);
                const float rstd = 1.0f / sqrtf(wave_sum(sumsq8(a0, a1) + sumsq8(a2, a3)) * (1.0f / D) + EPS);
                *(g8::u32x4*)(F_H + (size_t)r * D + e) = g8::pack8(a0 * rstd * gs[0] + sh[0], a1 * rstd * gs[1] + sh[1]);
                *(g8::u32x4*)(F_H + (size_t)r * D + e + 8) = g8::pack8(a2 * rstd * gs[2] + sh[2], a3 * rstd * gs[3] + sh[3]); }
        }
    }
}

__device__ __forceinline__ void p_inproj_naive(Frame& F, int l) {
    float* sA = (float*)F.lds; float* sW = sA + 128 * 33;
    const float* W = FIN(I_WIN) + (size_t)l * D * N_IN;
    constexpr int NT_N = (OFF_MERGE + 63) / 64, NT_M = M / 128;
    const int ty = F.tid >> 4, tx = F.tid & 15;
    for (int t = F.bid; t < NT_M * NT_N; t += F.G) {
        const int tm = t / NT_N, tn = t % NT_N; float acc[4][4]; ZERO_ACC(acc);
        ngemm_acc(acc, F_H, D, nullptr, tm * 128, M, W, N_IN, tn * 64, OFF_MERGE, D, sA, sW, F.tid);
#pragma unroll
        for (int i = 0; i < 4; ++i)
#pragma unroll
            for (int j = 0; j < 4; ++j) {
                const int r = tm * 128 + ty * 4 + i, c = tn * 64 + tx * 4 + j; if (c >= OFF_MERGE) continue;
                float v = acc[i][j];
                if (c < OFF_CQ) { if (c >= 512 && c < 1024) v *= 0.08838834764831845f; F_RET[(size_t)r * 2048 + c] = (bf16_t)f2bf(v); }
                else if (c < OFF_CKV) F_CQ[(size_t)r * 384 + (c - OFF_CQ)] = (bf16_t)f2bf(v);
                else if (c < OFF_KR) F_CKV[(size_t)r * 256 + (c - OFF_CKV)] = (bf16_t)f2bf(v);
                else if (c < OFF_UV) F_KR[(size_t)r * 32 + (c - OFF_KR)] = (bf16_t)f2bf(v);
                else F_UV[(size_t)r * 1024 + (c - OFF_UV)] = (bf16_t)f2bf(gelu_tanh(v));
            }
    }
}

__device__ __forceinline__ float rope_elem(const float* tab  , int d, float y, float yp) {
    const int a = d >> 4, j = d & 15, f = j & 7; const float c = tab[a * 16 + f], s = tab[a * 16 + 8 + f];
    return (j < 8) ? (y * c - yp * s) : (yp * s + y * c);
}
__device__ __forceinline__ void p_rowpass_a(Frame& F, int l) {
    const int gw = F.bid * NWAVES + F.wave, NGW = F.G * NWAVES, lane = F.lane;
    const float* qag = FIN(I_QAG) + l * 384; const float* kvag = FIN(I_KVAG) + l * 256; const float* krg = FIN(I_KRG) + l * 32;
    const float* lng = FIN(I_LNG) + l * 512; const float* lnb = FIN(I_LNB) + l * 512;
    for (int r = gw; r < M; r += NGW) {
        { bf16_t* p = F_CQ + (size_t)r * 384; float x[6]; float s = 0.f;
#pragma unroll
          for (int j = 0; j < 6; ++j) { x[j] = bf2f(p[lane + 64 * j]); s += x[j] * x[j]; }
          const float rstd = 1.0f / sqrtf(wave_sum(s) * (1.0f / 384.f) + EPS);
#pragma unroll
          for (int j = 0; j < 6; ++j) p[lane + 64 * j] = (bf16_t)f2bf(x[j] * rstd * qag[lane + 64 * j]); }
        { bf16_t* p = F_CKV + (size_t)r * 256; float x[4]; float s = 0.f;
#pragma unroll
          for (int j = 0; j < 4; ++j) { x[j] = bf2f(p[lane + 64 * j]); s += x[j] * x[j]; }
          const float rstd = 1.0f / sqrtf(wave_sum(s) * (1.0f / 256.f) + EPS);
#pragma unroll
          for (int j = 0; j < 4; ++j) p[lane + 64 * j] = (bf16_t)f2bf(x[j] * rstd * kvag[lane + 64 * j]); }
        { bf16_t* p = F_KR + (size_t)r * 32; const int d = lane & 31; const float x = lane < 32 ? bf2f(p[d]) : 0.f;
          const float rstd = 1.0f / sqrtf(wave_sum(x * x) * (1.0f / 32.f) + EPS);
          float y = x * rstd * krg[d]; const float yp = __shfl_xor(y, 8);
          if (r < ML) y = rope_elem(F_ROPE + (size_t)(r & (SEQ - 1)) * 32, d, y, yp);
          if (lane < 32) p[d] = (bf16_t)f2bf(y); }
        { bf16_t* p = F_UV + (size_t)r * 1024 + 512; float x[8]; float s = 0.f;
#pragma unroll
          for (int j = 0; j < 8; ++j) { x[j] = bf2f(p[lane + 64 * j]); s += x[j]; }
          const float mu = wave_sum(s) * (1.0f / 512.f); float q = 0.f;
#pragma unroll
          for (int j = 0; j < 8; ++j) { x[j] -= mu; q += x[j] * x[j]; }
          const float rstd = 1.0f / sqrtf(wave_sum(q) * (1.0f / 512.f) + EPS);
#pragma unroll
          for (int j = 0; j < 8; ++j) p[lane + 64 * j] = (bf16_t)f2bf(x[j] * rstd * lng[lane + 64 * j] + lnb[lane + 64 * j]); }
    }
}

__device__ __forceinline__ void p_mlaup_naive(Frame& F, int l) {
    float* sA = (float*)F.lds; float* sW = sA + 128 * 33;
    const int ty = F.tid >> 4, tx = F.tid & 15;
    constexpr int NT_M = M / 128, NQ = 768 / 64, NKV = 1024 / 64;
    for (int t = F.bid; t < NT_M * (NQ + NKV); t += F.G) {
        const int tm = t / (NQ + NKV), tn = t % (NQ + NKV); float acc[4][4]; ZERO_ACC(acc);
        if (tn < NQ) {
            ngemm_acc(acc, F_CQ, 384, nullptr, tm * 128, M, FIN(I_WUQ) + (size_t)l * 384 * 768, 768, tn * 64, 768, 384, sA, sW, F.tid);
#pragma unroll
            for (int i = 0; i < 4; ++i)
#pragma unroll
                for (int j = 0; j < 4; ++j) F_Q[(size_t)(tm * 128 + ty * 4 + i) * 768 + tn * 64 + tx * 4 + j] = (bf16_t)f2bf(acc[i][j]);
        } else {
            const int tk = tn - NQ;
            ngemm_acc(acc, F_CKV, 256, nullptr, tm * 128, M, FIN(I_WUKV) + (size_t)l * 256 * 1024, 1024, tk * 64, 1024, 256, sA, sW, F.tid);
#pragma unroll
            for (int i = 0; i < 4; ++i)
#pragma unroll
                for (int j = 0; j < 4; ++j) F_KVR[(size_t)(tm * 128 + ty * 4 + i) * 1024 + tk * 64 + tx * 4 + j] = (bf16_t)f2bf(acc[i][j]);
        }
    }
}
__device__ __forceinline__ void p_rowpass_b(Frame& F, int l) {
    const int gw = F.bid * NWAVES + F.wave, NGW = F.G * NWAVES, lane = F.lane;
    const float* qng = FIN(I_QNG) + l * 96; const float* kng = FIN(I_KNG) + l * 64;
    for (int r = gw; r < M; r += NGW) {
        const float* tab = F_ROPE + (size_t)(r & (SEQ - 1)) * 32;
        const float krv = lane < 32 ? bf2f(F_KR[(size_t)r * 32 + lane]) : 0.f;
        for (int h = 0; h < 8; ++h) {
            bf16_t* q = F_Q + (size_t)r * 768 + h * 96;
            const float x0 = bf2f(q[lane]), x1 = lane < 32 ? bf2f(q[64 + lane]) : 0.f;
            const float rstd = 1.0f / sqrtf(wave_sum(x0 * x0 + x1 * x1) * (1.0f / 96.f) + EPS);
            const float y0 = x0 * rstd * qng[lane]; float y1 = x1 * rstd * qng[64 + (lane & 31)];
            const float yp = __shfl_xor(y1, 8);
            if (r < ML) y1 = rope_elem(tab, lane & 31, y1, yp);
            q[lane] = (bf16_t)f2bf(y0 * QSCALE); if (lane < 32) q[64 + lane] = (bf16_t)f2bf(y1 * QSCALE);
            const bf16_t* kv = F_KVR + (size_t)r * 1024 + h * 128;
            const float k0 = bf2f(kv[lane]);
            const float rk = 1.0f / sqrtf(wave_sum(k0 * k0) * (1.0f / 64.f) + EPS);
            bf16_t* ko = F_K + (size_t)r * 768 + h * 96;
            ko[lane] = (bf16_t)f2bf(k0 * rk * kng[lane]); if (lane < 32) ko[64 + lane] = (bf16_t)f2bf(krv);
            F_V[(size_t)r * 512 + h * 64 + lane] = kv[64 + lane];
        }
    }
}

__device__ __forceinline__ void attn_unit_naive(Frame& F, int h, int qrow0, int kr0, int kn0, int kr1, int kn1) {
    float* sQ = (float*)F.lds;
    float* sK = sQ + 32 * 97;
    float* sV = sK + 64 * 97;
    float* sS = sV + 64 * 64;
    float* sM = sS + 32 * 65;
    const int tid = F.tid;
    __syncthreads();
    for (int i = tid; i < 32 * 96; i += NTHR) { const int rr = i / 96, d = i % 96; sQ[rr * 97 + d] = bf2f(F_Q[(size_t)(qrow0 + rr) * 768 + h * 96 + d]); }
    if (tid < 32) { sM[tid] = -INFINITY; sM[32 + tid] = 0.f; sM[64 + tid] = 0.f; }
    float o[4] = {0.f, 0.f, 0.f, 0.f};
    const int srow = tid >> 4, scol = tid & 15;
    const int orow = (tid >> 6) * 4, ocol = tid & 63;
    const int ntile = (kn0 + kn1) / 64;
    for (int kt = 0; kt < ntile; ++kt) {
        const int j0 = kt * 64; const int krow = j0 < kn0 ? kr0 + j0 : kr1 + (j0 - kn0);
        __syncthreads();
        for (int i = tid; i < 64 * 96; i += NTHR) { const int rr = i / 96, d = i % 96; sK[rr * 97 + d] = bf2f(F_K[(size_t)(krow + rr) * 768 + h * 96 + d]); }
        for (int i = tid; i < 64 * 64; i += NTHR) { const int rr = i >> 6, d = i & 63; sV[rr * 64 + d] = bf2f(F_V[(size_t)(krow + rr) * 512 + h * 64 + d]); }
        __syncthreads();
        float s[4] = {0.f, 0.f, 0.f, 0.f};
        for (int d = 0; d < 96; ++d) { const float qv = sQ[srow * 97 + d];
#pragma unroll
            for (int jj = 0; jj < 4; ++jj) s[jj] += qv * sK[(scol + 16 * jj) * 97 + d]; }
#pragma unroll
        for (int jj = 0; jj < 4; ++jj) sS[srow * 65 + scol + 16 * jj] = s[jj];
        __syncthreads();
        if (tid < 32) { float mx = sM[tid];
            for (int j = 0; j < 64; ++j) mx = fmaxf(mx, sS[tid * 65 + j]);
            const float al = exp2f(sM[tid] - mx); float ls = 0.f;
            for (int j = 0; j < 64; ++j) { const float p = exp2f(sS[tid * 65 + j] - mx); sS[tid * 65 + j] = p; ls += p; }
            sM[tid] = mx; sM[32 + tid] = sM[32 + tid] * al + ls; sM[64 + tid] = al; }
        __syncthreads();
#pragma unroll
        for (int i = 0; i < 4; ++i) { float a = o[i] * sM[64 + orow + i];
            for (int j = 0; j < 64; ++j) a += sS[(orow + i) * 65 + j] * sV[j * 64 + ocol];
            o[i] = a; }
    }
#pragma unroll
    for (int i = 0; i < 4; ++i) F_AO[(size_t)(qrow0 + orow + i) * 512 + h * 64 + ocol] = (bf16_t)f2bf(o[i] / sM[32 + orow + i]);
}

__device__ __forceinline__ void ret_unit_naive(Frame& F, int l, int b, int h, int qpos0, bool isctx) {
    float* sQ = (float*)F.lds;
    float* sK = sQ + 32 * 129;
    float* sV = sK + 64 * 129;
    float* sS = sV + 64 * 128;
    float* sT = sS + 32 * 65;
    const int tid = F.tid;
    const float df = FIN(I_DECF)[l * 4 + h], db = FIN(I_DECB)[l * 4 + h];
    const float lf = -log1pf(expf(-df)) * 1.4426950408889634f, lb = -log1pf(expf(-db)) * 1.4426950408889634f;
    const int qrow0 = isctx ? ML + b * CTX + qpos0 : b * SEQ + qpos0;
    __syncthreads();
    for (int i = tid; i < 32 * 128; i += NTHR) { const int rr = i >> 7, d = i & 127; sQ[rr * 129 + d] = bf2f(F_RET[(size_t)(qrow0 + rr) * 2048 + h * 128 + d]); }
    float o[8];
#pragma unroll
    for (int i = 0; i < 8; ++i) o[i] = 0.f;
    const int srow = tid >> 4, scol = tid & 15;
    const int orow = (tid >> 7) * 8, ocol = tid & 127;
    const int ntile = isctx ? CTX / 64 : (CTX + SEQ) / 64;
    for (int kt = 0; kt < ntile; ++kt) {
        const int j0 = kt * 64; const bool kctx = j0 < CTX;
        const int kpos0 = kctx ? j0 : j0 - CTX; const int krow = kctx ? ML + b * CTX + kpos0 : b * SEQ + kpos0;
        __syncthreads();
        for (int i = tid; i < 64 * 128; i += NTHR) { const int rr = i >> 7, d = i & 127;
            sK[rr * 129 + d] = bf2f(F_RET[(size_t)(krow + rr) * 2048 + 512 + h * 128 + d]);
            sV[rr * 128 + d] = bf2f(F_RET[(size_t)(krow + rr) * 2048 + 1024 + h * 128 + d]); }
        __syncthreads();
        float s[4] = {0.f, 0.f, 0.f, 0.f};
        for (int d = 0; d < 128; ++d) { const float qv = sQ[srow * 129 + d];
#pragma unroll
            for (int jj = 0; jj < 4; ++jj) s[jj] += qv * sK[(scol + 16 * jj) * 129 + d]; }
        const int i_ = qpos0 + srow;
#pragma unroll
        for (int jj = 0; jj < 4; ++jj) { const int j_ = kpos0 + scol + 16 * jj; float w;
            if (isctx == kctx) w = (j_ <= i_) ? exp2f(lf * (float)(i_ - j_)) : exp2f(lb * (float)(j_ - i_));
            else w = exp2f(lf * (float)(i_ + CTX - j_)) + exp2f(lb * (float)(SEQ - i_ + j_));
            sS[srow * 65 + scol + 16 * jj] = s[jj] * w; }
        __syncthreads();
#pragma unroll
        for (int i = 0; i < 8; ++i) { float a = o[i];
            for (int j = 0; j < 64; ++j) a += sS[(orow + i) * 65 + j] * sV[j * 128 + ocol];
            o[i] = a; }
    }
    __syncthreads();
    float* sO = sK;
#pragma unroll
    for (int i = 0; i < 8; ++i) sO[(orow + i) * 129 + ocol] = o[i];
    __syncthreads();
    if (tid < 32) { float mu = 0.f; for (int d = 0; d < 128; ++d) mu += sO[tid * 129 + d]; mu *= (1.0f / 128.f);
        float q = 0.f; for (int d = 0; d < 128; ++d) { const float dd = sO[tid * 129 + d] - mu; q += dd * dd; }
        sT[tid] = mu; sT[32 + tid] = 1.0f / sqrtf(q * (1.0f / 128.f) + EPS); }
    __syncthreads();
    const float gg = FIN(I_GNG)[l * 512 + h * 128 + ocol], gb = FIN(I_GNB)[l * 512 + h * 128 + ocol];
#pragma unroll
    for (int i = 0; i < 8; ++i) { const int rr = orow + i; const size_t base = (size_t)(qrow0 + rr) * 2048 + h * 128 + ocol;
        const float gate = bf2f(F_RET[base + 1536]);
        F_RET[base] = (bf16_t)f2bf(siluf_(gate) * ((o[i] - sT[rr]) * sT[32 + rr] * gg + gb)); }
}

__device__ __forceinline__ void gmlp_unit_naive(Frame& F, int l, int cidx, int g) {
    float* sV = (float*)F.lds;
    float* sW = sV + 128 * 128;
    const int tid = F.tid, r0 = cidx * 128;
    const float* ws = FIN(I_GWS) + ((size_t)l * 4 + g) * 128 * 128; const float* bs = FIN(I_GBS) + (l * 4 + g) * 128;
    __syncthreads();
    for (int i = tid; i < 128 * 128; i += NTHR) { const int rr = i >> 7, c = i & 127;
        sV[rr * 128 + c] = bf2f(F_UV[(size_t)(r0 + rr) * 1024 + 512 + g * 128 + c]); sW[rr * 129 + c] = ws[i]; }
    __syncthreads();
    const int ig = (tid >> 7) * 32, c = tid & 127;
    for (int i = ig; i < ig + 32; ++i) { float a = bs[i];
        for (int j = 0; j < 128; ++j) a += sW[i * 129 + j] * sV[j * 128 + c];
        bf16_t* up = F_UV + (size_t)(r0 + i) * 1024 + g * 128 + c; *up = (bf16_t)f2bf(bf2f(*up) * a); }
}

__device__ __forceinline__ void p_merge_naive(Frame& F, int l, int nrows) {
    float* sA = (float*)F.lds; float* sW = sA + 128 * 33;
    const int ty = F.tid >> 4, tx = F.tid & 15;
    const float* Win = FIN(I_WIN) + (size_t)l * D * N_IN;
    const int ntm = nrows / 128;
    for (int t = F.bid; t < ntm * 16; t += F.G) {
        const int tm = t >> 4, tn = t & 15; float y[4][4]; ZERO_ACC(y);
#pragma unroll 1
        for (int br = 0; br < 3; ++br) {
            float g[4][4]; ZERO_ACC(g); float a[4][4]; ZERO_ACC(a);
            ngemm_acc(g, F_H, D, nullptr, tm * 128, nrows, Win + OFF_MERGE + br * 1024, N_IN, tn * 64, 1024, D, sA, sW, F.tid);
            const bf16_t* A = br == 0 ? F_RET : (br == 1 ? F_AO : F_UV); const int lda = br == 0 ? 2048 : (br == 1 ? 512 : 1024);
            const float* Wb = FIN(br == 0 ? I_WBRRET : (br == 1 ? I_WBRMLA : I_WBRG)) + (size_t)l * 512 * D;
            ngemm_acc(a, A, lda, nullptr, tm * 128, nrows, Wb, D, tn * 64, 1024, 512, sA, sW, F.tid);
#pragma unroll
            for (int i = 0; i < 4; ++i)
#pragma unroll
                for (int j = 0; j < 4; ++j) y[i][j] += sigmoidf_(g[i][j]) * a[i][j];
        }
#pragma unroll
        for (int i = 0; i < 4; ++i)
#pragma unroll
            for (int j = 0; j < 4; ++j) F_Y[(size_t)(tm * 128 + ty * 4 + i) * D + tn * 64 + tx * 4 + j] = (bf16_t)f2bf(y[i][j]);
    }
}
__device__ __forceinline__ void p_out_naive(Frame& F, int l, int nrows) {
    float* sA = (float*)F.lds; float* sW = sA + 128 * 33;
    const int ty = F.tid >> 4, tx = F.tid & 15;
    const int ntm = nrows / 128;
    for (int t = F.bid; t < ntm * 16; t += F.G) {
        const int tm = t >> 4, tn = t & 15; float acc[4][4]; ZERO_ACC(acc);
        ngemm_acc(acc, F_Y, D, nullptr, tm * 128, nrows, FIN(I_WOUT) + (size_t)l * D * D, D, tn * 64, D, D, sA, sW, F.tid);
#pragma unroll
        for (int i = 0; i < 4; ++i) { const int r = tm * 128 + ty * 4 + i; const float* xs = x_row_src(F, l, r); float* xd = x_row_dst(F, r);
            const float* ga = F_MOD + ((size_t)l * 5 + row_batch(r)) * 6144 + 2 * D;
#pragma unroll
            for (int j = 0; j < 4; ++j) { const int c = tn * 64 + tx * 4 + j; xd[c] = xs[c] + ga[c] * acc[i][j]; } }
    }
}

__device__ __forceinline__ void p_router(Frame& F, int l, int ntok) {
    int* hist = (int*)F.lds;
    const int gw = F.bid * NWAVES + F.wave, NGW = F.G * NWAVES, lane = F.lane;
    __syncthreads();
    if (F.tid < 64) hist[F.tid] = 0;
    __syncthreads();
    const float* R = FIN(I_ROUTER) + (size_t)l * D * NEXP; const float bias = FIN(I_MBIAS)[l * NEXP + lane];
    for (int r = gw; r < ntok; r += NGW) {
        const bf16_t* hrow = F_H + (size_t)r * D; float a = 0.f;
        for (int k = 0; k < D; k += 8) { const uint4 hv = *(const uint4*)(hrow + k);
            a += __builtin_bit_cast(float, hv.x << 16) * R[(k + 0) * NEXP + lane]; a += __builtin_bit_cast(float, hv.x & 0xffff0000u) * R[(k + 1) * NEXP + lane];
            a += __builtin_bit_cast(float, hv.y << 16) * R[(k + 2) * NEXP + lane]; a += __builtin_bit_cast(float, hv.y & 0xffff0000u) * R[(k + 3) * NEXP + lane];
            a += __builtin_bit_cast(float, hv.z << 16) * R[(k + 4) * NEXP + lane]; a += __builtin_bit_cast(float, hv.z & 0xffff0000u) * R[(k + 5) * NEXP + lane];
            a += __builtin_bit_cast(float, hv.w << 16) * R[(k + 6) * NEXP + lane]; a += __builtin_bit_cast(float, hv.w & 0xffff0000u) * R[(k + 7) * NEXP + lane]; }
        const float score = sigmoidf_(a); float sel = score + bias;
        float wk[TOPK]; int ek[TOPK]; float wsum = 0.f;
#pragma unroll
        for (int k = 0; k < TOPK; ++k) {
            float bv = sel; int bi = lane;
#pragma unroll
            for (int o = 1; o < 64; o <<= 1) { const float ov = __shfl_xor(bv, o); const int oi = __shfl_xor(bi, o); if (ov > bv || (ov == bv && oi < bi)) { bv = ov; bi = oi; } }
            ek[k] = bi; wk[k] = __shfl(score, bi); wsum += wk[k]; if (lane == bi) sel = -INFINITY;
        }
        if (lane == 0) {
#pragma unroll
            for (int k = 0; k < TOPK; ++k) { F_IDX[r * TOPK + k] = ek[k]; F_WTS[r * TOPK + k] = wk[k] / wsum * 2.5f; F_SLOT[r * TOPK + k] = atomicAdd(&hist[ek[k]], 1) | (F.bid << 20); }
        }
    }
    __syncthreads();
    if (F.tid < 64) F_BLKBASE[(l * 256 + F.bid) * 64 + F.tid] = (int)atomicAdd(F_ctl + CW_CNT + l * 64 + F.tid, (unsigned)hist[F.tid]);
    for (int i = F.bid * NTHR + F.tid; i < APAD; i += F.G * NTHR) F_ROWTOK[i] = 0;
}
__device__ __forceinline__ void moe_offsets(Frame& F, int l, int* ps) {
    __syncthreads();
    if (F.tid < 64) { const int e = F.tid; const int c = (int)F_ctl[CW_CNT + l * 64 + e]; const int n = ((c + 255) >> 8) << 8; int incl = n;
#pragma unroll
        for (int o = 1; o < 64; o <<= 1) { const int v = __builtin_amdgcn_ds_bpermute(((e - o) & 63) << 2, incl); if (e >= o) incl += v; }
        ps[e] = incl - n; ps[65 + e] = c; if (e == 63) ps[64] = incl; }
    __syncthreads();
}
__device__ __forceinline__ void p_scatter(Frame& F, int l, int ntok) {
    int* ps = (int*)F.lds; moe_offsets(F, l, ps);
    for (int i = F.bid * NTHR + F.tid; i < ntok * TOPK; i += F.G * NTHR) {
        const int r = i / TOPK; const int e = F_IDX[i]; const int sl = F_SLOT[i]; const int blk = sl >> 20;
        const int row = ps[e] + F_BLKBASE[(l * 256 + blk) * 64 + e] + (sl & 0xFFFFF);
        F_ROWTOK[row] = r; F_INV[i] = row;
    }
}
__device__ __forceinline__ void p_moe_gateup_naive(Frame& F, int l, int ntok) {
    int* ps = (int*)F.lds; moe_offsets(F, l, ps);
    float* sA = (float*)(F.lds + 1024); float* sW = sA + 128 * 33;
    const int ty = F.tid >> 4, tx = F.tid & 15;
    int tbase = 0, t = F.bid;
    for (int e = 0; e < NEXP; ++e) {
        const int cnt = ps[65 + e], nt = ((cnt + 127) >> 7) * 4;
        for (; t < tbase + nt; t += F.G) {
            const int tt = t - tbase, tm = tt >> 2, tn = tt & 3; float g[4][4], u[4][4]; ZERO_ACC(g); ZERO_ACC(u);
            const float* Wg = FIN(I_WG) + ((size_t)l * NEXP + e) * D * DEXP; const float* Wu = FIN(I_WU) + ((size_t)l * NEXP + e) * D * DEXP;
            ngemm_acc(g, F_H, D, F_ROWTOK + ps[e], tm * 128, cnt, Wg, DEXP, tn * 64, DEXP, D, sA, sW, F.tid);
            ngemm_acc(u, F_H, D, F_ROWTOK + ps[e], tm * 128, cnt, Wu, DEXP, tn * 64, DEXP, D, sA, sW, F.tid);
#pragma unroll
            for (int i = 0; i < 4; ++i) { const int rr = tm * 128 + ty * 4 + i; if (rr >= cnt) continue;
#pragma unroll
                for (int j = 0; j < 4; ++j) F_HB[(size_t)(ps[e] + rr) * DEXP + tn * 64 + tx * 4 + j] = (bf16_t)f2bf(siluf_(g[i][j]) * u[i][j]); }
        }
        tbase += nt;
    }
    const int ntm = ntok / 128;
    for (int t = F.bid; t < ntm * 4; t += F.G) {
        const int tm = t >> 2, tn = t & 3; float g[4][4], u[4][4]; ZERO_ACC(g); ZERO_ACC(u);
        ngemm_acc(g, F_H, D, nullptr, tm * 128, ntok, FIN(I_SG) + (size_t)l * D * DEXP, DEXP, tn * 64, DEXP, D, sA, sW, F.tid);
        ngemm_acc(u, F_H, D, nullptr, tm * 128, ntok, FIN(I_SU) + (size_t)l * D * DEXP, DEXP, tn * 64, DEXP, D, sA, sW, F.tid);
#pragma unroll
        for (int i = 0; i < 4; ++i)
#pragma unroll
            for (int j = 0; j < 4; ++j) F_HBS[(size_t)(tm * 128 + ty * 4 + i) * DEXP + tn * 64 + tx * 4 + j] = (bf16_t)f2bf(siluf_(g[i][j]) * u[i][j]);
    }
}
__device__ __forceinline__ void p_moe_down_naive(Frame& F, int l, int ntok, int c0) {
    int* ps = (int*)F.lds; moe_offsets(F, l, ps);
    float* sA = (float*)(F.lds + 1024); float* sW = sA + 128 * 33;
    const int ty = F.tid >> 4, tx = F.tid & 15;
    int tbase = 0, t = F.bid;
    for (int e = 0; e < NEXP; ++e) {
        const int cnt = ps[65 + e], nt = ((cnt + 127) >> 7) * 8;
        for (; t < tbase + nt; t += F.G) {
            const int tt = t - tbase, tm = tt >> 3, tn = tt & 7; float acc[4][4]; ZERO_ACC(acc);
            const float* Wd = FIN(I_WD) + ((size_t)l * NEXP + e) * DEXP * D;
            ngemm_acc(acc, F_HB + (size_t)ps[e] * DEXP, DEXP, nullptr, tm * 128, cnt, Wd, D, c0 + tn * 64, D, DEXP, sA, sW, F.tid);
#pragma unroll
            for (int i = 0; i < 4; ++i) { const int rr = tm * 128 + ty * 4 + i; if (rr >= cnt) continue;
#pragma unroll
                for (int j = 0; j < 4; ++j) F_OUT[(size_t)(ps[e] + rr) * 512 + tn * 64 + tx * 4 + j] = (bf16_t)f2bf(acc[i][j]); }
        }
        tbase += nt;
    }
    if (c0 == 0) {
        const int ntm = ntok / 128;
        for (int t = F.bid; t < ntm * 16; t += F.G) {
            const int tm = t >> 4, tn = t & 15; float acc[4][4]; ZERO_ACC(acc);
            ngemm_acc(acc, F_HBS, DEXP, nullptr, tm * 128, ntok, FIN(I_SD) + (size_t)l * DEXP * D, D, tn * 64, D, DEXP, sA, sW, F.tid);
#pragma unroll
            for (int i = 0; i < 4; ++i) { const int r = tm * 128 + ty * 4 + i; float* xd = x_row_dst(F, r);
                const float* gf = F_MOD + ((size_t)l * 5 + row_batch(r)) * 6144 + 5 * D;
#pragma unroll
                for (int j = 0; j < 4; ++j) { const int c = tn * 64 + tx * 4 + j; xd[c] += gf[c] * acc[i][j]; } }
        }
    }
}
typedef float f32x2_t __attribute__((ext_vector_type(2)));
__device__ __forceinline__ void acc16(f32x2_t (&s)[8], float w, const g8::u32x4& v) {
    const f32x2_t w2 = {w, w};
#pragma unroll
    for (int q = 0; q < 4; ++q) { const f32x2_t lo = __builtin_amdgcn_cvt_pk_f32_fp8(v[q], false), hi = __builtin_amdgcn_cvt_pk_f32_fp8(v[q], true);
        s[2 * q] = __builtin_elementwise_fma(w2, lo, s[2 * q]); s[2 * q + 1] = __builtin_elementwise_fma(w2, hi, s[2 * q + 1]); } }
template <bool NORM_NEXT> __device__ __forceinline__ void p_combine(Frame& F, int l, int ntok) {
    const int gw = F.bid * NWAVES + F.wave, NGW = F.G * NWAVES, lane = F.lane;
    const float* g1 = NORM_NEXT ? FIN(I_N1G) + (l + 1) * D : nullptr;
    const unsigned char* OUT8 = (const unsigned char*)F_OUT;
    LAS int* tabI = (LAS int*)((LAS unsigned char*)F.lds) + F.wave * 512; LAS float* tabW = (LAS float*)(tabI + 256);
    constexpr int NLB = ML / 16;
    const int nseg = NLB + (ntok > ML ? ntok - ML : 0);
    for (int seg = gw; seg < nseg; seg += NGW) {
        const int r0 = seg < NLB ? seg * 16 : ML + (seg - NLB), n = seg < NLB ? 16 : 1;
        int l16 = lane * 16; asm volatile("" : "+v"(l16));
        for (int e = lane; e < n * TOPK; e += 64) { tabI[e] = F_INV[r0 * TOPK + e]; tabW[e] = F_WTS[r0 * TOPK + e]; }
        const int bt = row_batch(r0);
        g8::f32x4 gt[4], gs[4], sh[4];
        { const float* gf = F_MOD + ((size_t)l * 5 + bt) * 6144 + 5 * D + l16;
#pragma unroll
          for (int q = 0; q < 4; ++q) gt[q] = *(const g8::f32x4*)(gf + 4 * q);
          if constexpr (NORM_NEXT) { const float* mod = F_MOD + ((size_t)(l + 1) * 5 + bt) * 6144 + l16;
#pragma unroll
              for (int q = 0; q < 4; ++q) { sh[q] = *(const g8::f32x4*)(mod + 4 * q); gs[q] = *(const g8::f32x4*)(g1 + l16 + 4 * q) * (*(const g8::f32x4*)(mod + D + 4 * q) + 1.0f); } } }
        asm volatile("s_waitcnt vmcnt(0) lgkmcnt(0)" ::: "memory");
        for (int j = 0; j < n; j += 2) {
            const bool hb = j + 1 < n; const int ra = r0 + j, jb = hb ? j + 1 : j, rb_ = r0 + jb;
            bf16_t* xa = F_X16 + (size_t)ra * D + l16; bf16_t* xb = F_X16 + (size_t)rb_ * D + l16;
            int ia[TOPK], ib[TOPK]; float wa[TOPK], wb[TOPK];
#pragma unroll
            for (int k = 0; k < TOPK; ++k) { ia[k] = tabI[j * TOPK + k]; ib[k] = tabI[jb * TOPK + k]; wa[k] = tabW[j * TOPK + k]; wb[k] = tabW[jb * TOPK + k]; }
            g8::u32x4 va[TOPK], vb[TOPK];
#pragma unroll
            for (int k = 0; k < TOPK; ++k) { va[k] = *(const g8::u32x4*)(OUT8 + (size_t)ia[k] * 1024 + l16); vb[k] = *(const g8::u32x4*)(OUT8 + (size_t)ib[k] * 1024 + l16); }
            const bf16_t* shp = FWS(bf16_t, WS_SCR) + l16; const g8::u32x4 sha0 = *(const g8::u32x4*)(shp + (size_t)ra * 1024), sha1 = *(const g8::u32x4*)(shp + (size_t)ra * 1024 + 8), shb0 = *(const g8::u32x4*)(shp + (size_t)rb_ * 1024), shb1 = *(const g8::u32x4*)(shp + (size_t)rb_ * 1024 + 8);
            const g8::u32x4 xa0 = *(const g8::u32x4*)xa, xa1 = *(const g8::u32x4*)(xa + 8), xb0 = *(const g8::u32x4*)xb, xb1 = *(const g8::u32x4*)(xb + 8);
            f32x2_t sa2[8], sb2[8];
#pragma unroll
            for (int i = 0; i < 8; ++i) { sa2[i] = (f32x2_t){0.f, 0.f}; sb2[i] = (f32x2_t){0.f, 0.f}; }
#pragma unroll
            for (int k = 0; k < TOPK; ++k) { acc16(sa2, wa[k], va[k]); acc16(sb2, wb[k], vb[k]); }
            float sa[16], sb[16];
#pragma unroll
            for (int i = 0; i < 8; ++i) { sa[2 * i] = sa2[i][0]; sa[2 * i + 1] = sa2[i][1]; sb[2 * i] = sb2[i][0]; sb[2 * i + 1] = sb2[i][1]; }
            { g8::f32x4 a0, a1; g8::unpack8(sha0, a0, a1); _Pragma("unroll") for (int i = 0; i < 4; ++i) { sa[i] += a0[i]; sa[4 + i] += a1[i]; } g8::unpack8(sha1, a0, a1); _Pragma("unroll") for (int i = 0; i < 4; ++i) { sa[8 + i] += a0[i]; sa[12 + i] += a1[i]; }
              g8::unpack8(shb0, a0, a1); _Pragma("unroll") for (int i = 0; i < 4; ++i) { sb[i] += a0[i]; sb[4 + i] += a1[i]; } g8::unpack8(shb1, a0, a1); _Pragma("unroll") for (int i = 0; i < 4; ++i) { sb[8 + i] += a0[i]; sb[12 + i] += a1[i]; } }
            g8::f32x4 xav[4], xbv[4];
            g8::unpack8(xa0, xav[0], xav[1]); g8::unpack8(xa1, xav[2], xav[3]); g8::unpack8(xb0, xbv[0], xbv[1]); g8::unpack8(xb1, xbv[2], xbv[3]);
#pragma unroll
            for (int q = 0; q < 4; ++q)
#pragma unroll
                for (int i = 0; i < 4; ++i) { xav[q][i] += gt[q][i] * sa[4 * q + i]; xbv[q][i] += gt[q][i] * sb[4 * q + i]; }
            if constexpr (!NORM_NEXT) {
#pragma unroll
                for (int q = 0; q < 4; ++q) { *(g8::f32x4*)(F_out + (size_t)ra * D + l16 + 4 * q) = xav[q]; if (hb) *(g8::f32x4*)(F_out + (size_t)rb_ * D + l16 + 4 * q) = xbv[q]; }
            } else {
                *(g8::u32x4*)xa = g8::pack8(xav[0], xav[1]); *(g8::u32x4*)(xa + 8) = g8::pack8(xav[2], xav[3]);
                if (hb) { *(g8::u32x4*)xb = g8::pack8(xbv[0], xbv[1]); *(g8::u32x4*)(xb + 8) = g8::pack8(xbv[2], xbv[3]); }
#pragma unroll
                for (int t = 0; t < 2; ++t) { if (t == 1 && !hb) break; const int r = t ? rb_ : ra;
                    const g8::f32x4 v0 = t ? xbv[0] : xav[0], v1 = t ? xbv[1] : xav[1], v2 = t ? xbv[2] : xav[2], v3 = t ? xbv[3] : xav[3];
                    const float rstd = 1.0f / sqrtf(wave_sum(sumsq8(v0, v1) + sumsq8(v2, v3)) * (1.0f / D) + EPS);
                    *(g8::u32x4*)(F_H + (size_t)r * D + l16) = g8::pack8(v0 * rstd * gs[0] + sh[0], v1 * rstd * gs[1] + sh[1]);
                    *(g8::u32x4*)(F_H + (size_t)r * D + l16 + 8) = g8::pack8(v2 * rstd * gs[2] + sh[2], v3 * rstd * gs[3] + sh[3]); }
            }
        }
    }
}
__device__ __forceinline__ void cvt_item(const float* W, int ldw, int k0, int n0, bf16_t* dst  , int ldt, LAS float* scr, int lane, const float* gk = nullptr  ) {
#pragma unroll 8
    for (int i = 0; i < 32; ++i) { const int kk = 2 * i + (lane >> 5); scr[kk * 33 + (lane & 31)] = W[(size_t)(k0 + kk) * ldw + n0 + (lane & 31)] * (gk ? gk[k0 + kk] : 1.0f); }
    asm volatile("s_waitcnt lgkmcnt(0)" ::: "memory");
    const int c = lane & 7;
#pragma unroll
    for (int j = 0; j < 4; ++j) { const int n = (lane >> 3) + 8 * j; const LAS float* s = scr + (8 * c) * 33 + n;
        uint4 o; o.x = g8::cvtpk(s[0 * 33], s[1 * 33]); o.y = g8::cvtpk(s[2 * 33], s[3 * 33]); o.z = g8::cvtpk(s[4 * 33], s[5 * 33]); o.w = g8::cvtpk(s[6 * 33], s[7 * 33]);
        *(uint4*)(dst + (size_t)n * ldt + k0 + 8 * c) = o; }
    asm volatile("s_waitcnt lgkmcnt(0)" ::: "memory");
}
#define CVT_JOBG(Wp, Kk, ldw_, c0_, ncols_, dstp, gk_) do { const int _nb = (ncols_) / 32, _ni = ((Kk) / 64) * _nb; \
    if (it < _ni) { const int _kb = it / _nb, _nbi = it % _nb; cvt_item((Wp), (ldw_), 64 * _kb, (c0_) + 32 * _nbi, (dstp) + (size_t)(32 * _nbi) * (Kk), (Kk), scr, lane, (gk_)); return; } it -= _ni; } while (0)
#define CVT_JOB(Wp, Kk, ldw_, c0_, ncols_, dstp) do { const int _nb = (ncols_) / 32, _ni = ((Kk) / 64) * _nb; \
    if (it < _ni) { const int _kb = it / _nb, _nbi = it % _nb; cvt_item((Wp), (ldw_), 64 * _kb, (c0_) + 32 * _nbi, (dstp) + (size_t)(32 * _nbi) * (Kk), (Kk), scr, lane); return; } it -= _ni; } while (0)
constexpr int CVT_SMALL_ITEMS = 16 * 85 + 16 * 32 + 16 * 96 + 6 * 24 + 4 * 32 + 3 * 8 * 32 + 16 * 32 + 2 * 16 * 8 + 4 * 32;
__device__ __forceinline__ void cvt_small_item(Frame& F, int l, int it, LAS float* scr, int lane) {
    unsigned char* base = ws_(F.A) + WS_WSM + (size_t)l * SMW_L;
    const float* win = FIN(I_WIN) + (size_t)l * D * N_IN;
    CVT_JOB(win, 1024, N_IN, 0, 2720, (bf16_t*)(base + SMW_WIN));
    CVT_JOB(win, 1024, N_IN, 2720, 1024, (bf16_t*)(base + SMW_WIN) + (size_t)2816 * 1024);
    CVT_JOB(win, 1024, N_IN, 3744, 3072, (bf16_t*)(base + SMW_WG));
#pragma unroll
    for (int hh = 0; hh < 8; ++hh) CVT_JOBG(FIN(I_WUQ) + (size_t)l * 384 * 768, 384, 768, hh * 96, 96, (bf16_t*)(base + SMW_WUQ) + (size_t)hh * 128 * 384, FIN(I_QAG) + l * 384);
    CVT_JOBG(FIN(I_WUKV) + (size_t)l * 256 * 1024, 256, 1024, 0, 1024, (bf16_t*)(base + SMW_WUKV), FIN(I_KVAG) + l * 256);
    CVT_JOB(FIN(I_WBRRET) + (size_t)l * 512 * D, 512, D, 0, D, (bf16_t*)(base + SMW_WBR));
    CVT_JOB(FIN(I_WBRMLA) + (size_t)l * 512 * D, 512, D, 0, D, (bf16_t*)(base + SMW_WBR) + (size_t)1024 * 512);
    CVT_JOB(FIN(I_WBRG) + (size_t)l * 512 * D, 512, D, 0, D, (bf16_t*)(base + SMW_WBR) + (size_t)2 * 1024 * 512);
    CVT_JOB(FIN(I_WOUT) + (size_t)l * D * D, 1024, D, 0, D, (bf16_t*)(base + SMW_WOUT));
    CVT_JOB(FIN(I_SG) + (size_t)l * D * DEXP, 1024, DEXP, 0, 128, (bf16_t*)(base + SMW_SHGU));
    CVT_JOB(FIN(I_SG) + (size_t)l * D * DEXP, 1024, DEXP, 128, 128, (bf16_t*)(base + SMW_SHGU) + (size_t)256 * 1024);
    CVT_JOB(FIN(I_SU) + (size_t)l * D * DEXP, 1024, DEXP, 0, 128, (bf16_t*)(base + SMW_SHGU) + (size_t)128 * 1024);
    CVT_JOB(FIN(I_SU) + (size_t)l * D * DEXP, 1024, DEXP, 128, 128, (bf16_t*)(base + SMW_SHGU) + (size_t)384 * 1024);
    CVT_JOB(FIN(I_SD) + (size_t)l * DEXP * D, 256, D, 0, D, (bf16_t*)(base + SMW_SHD));
}
constexpr int CVT_MOE_ITEMS_PER_E = 4 * 16 * 4 + 4 * 32;
__device__ __forceinline__ void cvt_moe_item(Frame& F, int l, int itg, LAS float* scr, int lane) {
    const int e = itg / CVT_MOE_ITEMS_PER_E; int it = itg % CVT_MOE_ITEMS_PER_E;
    unsigned char* base = ws_(F.A) + WS_MOEW + (size_t)e * (1536 * 1024);
    const float* wg = FIN(I_WG) + ((size_t)l * NEXP + e) * D * DEXP; const float* wu = FIN(I_WU) + ((size_t)l * NEXP + e) * D * DEXP;
    CVT_JOB(wg, 1024, DEXP, 0, 128, (bf16_t*)base);
    CVT_JOB(wg, 1024, DEXP, 128, 128, (bf16_t*)base + (size_t)256 * 1024);
    CVT_JOB(wu, 1024, DEXP, 0, 128, (bf16_t*)base + (size_t)128 * 1024);
    CVT_JOB(wu, 1024, DEXP, 128, 128, (bf16_t*)base + (size_t)384 * 1024);
    CVT_JOB(FIN(I_WD) + ((size_t)l * NEXP + e) * DEXP * D, 256, D, 0, D, (bf16_t*)(base + 1024 * 1024));
}
__device__ __forceinline__ void p_cvt_small(Frame& F) {
    LAS float* scr = (LAS float*)((LAS unsigned char*)F.lds + F.wave * 16384);
    const int gw = F.bid * NWAVES + F.wave, NGW = F.G * NWAVES;
    for (int it = gw; it < 2 * CVT_SMALL_ITEMS; it += NGW) cvt_small_item(F, it / CVT_SMALL_ITEMS, it % CVT_SMALL_ITEMS, scr, F.lane);
    for (int i = F.bid * NTHR + F.tid; i < 2 * 64 * 1024; i += F.G * NTHR) { const int l = i >> 16, e = (i >> 10) & 63, k = i & 1023;
        const float v = FIN(I_ROUTER)[(size_t)l * D * NEXP + k * NEXP + e]; const unsigned h = f2bf(v); const float vh = __builtin_bit_cast(float, h << 16);
        bf16_t* rt = (bf16_t*)(ws_(F.A) + WS_WSM + (size_t)l * SMW_L + SMW_RT); rt[e * 1024 + k] = (bf16_t)h; rt[64 * 1024 + e * 1024 + k] = (bf16_t)f2bf(v - vh); }
    for (int i = F.bid * NTHR + F.tid; i < 2 * 8 * 32 * 768 / 16; i += F.G * NTHR) { const int l = i / (8 * 32 * 48), rem = i % (8 * 32 * 48), hh = rem / (32 * 48), w = rem % (32 * 48);
        ((uint4*)(ws_(F.A) + WS_WSM + (size_t)l * SMW_L + SMW_WUQ + (size_t)(hh * 128 + 96) * 768))[w] = make_uint4(0u, 0u, 0u, 0u); }
    for (int l = 0; l < 2; ++l) { uint4* z = (uint4*)(ws_(F.A) + WS_WSM + (size_t)l * SMW_L + SMW_WIN + (size_t)2720 * 2048);
        for (int i = F.bid * NTHR + F.tid; i < 96 * 2048 / 16; i += F.G * NTHR) z[i] = make_uint4(0u, 0u, 0u, 0u); }
}
struct CvtPanel { const float* W; int ldw; bf16_t* dst0; int ldt; int gu_map, up; };
__device__ __forceinline__ CvtPanel cvt_moe_panel(Frame& F, int l, int it) {
    const int e = it / 48, p = it % 48; unsigned char* base = ws_(F.A) + WS_MOEW + (size_t)e * (1536 * 1024); CvtPanel c;
    if (p < 32) { const int up = p >> 4, kb = p & 15; c.W = FIN(up ? I_WU : I_WG) + ((size_t)l * NEXP + e) * D * DEXP + (size_t)kb * 64 * DEXP; c.ldw = DEXP; c.dst0 = (bf16_t*)base + kb * 64; c.ldt = 1024; c.gu_map = 1; c.up = up; }
    else { const int q = p - 32, kb = q >> 2, nb = q & 3; c.W = FIN(I_WD) + ((size_t)l * NEXP + e) * DEXP * D + (size_t)kb * 64 * D + nb * 256; c.ldw = D; c.dst0 = (bf16_t*)(base + 1024 * 1024) + (size_t)nb * 256 * 256 + kb * 64; c.ldt = 256; c.gu_map = 0; c.up = 0; }
    return c;
}
__device__ __forceinline__ void p_cvt_moe(Frame& F, int l) {
    LAS float* scr = (LAS float*)((LAS unsigned char*)F.lds); const int tid = F.tid;
    const int nit = NEXP * 48; int it = F.bid; if (it >= nit) return;
    CvtPanel cur = cvt_moe_panel(F, l, it); g8::f32x4 rv[8];
#pragma unroll
    for (int i = 0; i < 8; ++i) { const int idx = tid + i * 512, kk = idx >> 6, c4 = (idx & 63) * 4; rv[i] = *(const g8::f32x4*)(cur.W + (size_t)kk * cur.ldw + c4); }
    for (;;) {
        __syncthreads();
#pragma unroll
        for (int i = 0; i < 8; ++i) { const int idx = tid + i * 512, kk = idx >> 6, c4 = (idx & 63) * 4; LAS float* p = scr + kk * 257 + c4; p[0] = rv[i][0]; p[1] = rv[i][1]; p[2] = rv[i][2]; p[3] = rv[i][3]; }
        __syncthreads();
        const int nx = it + F.G; const bool more = nx < nit; CvtPanel nxt = cur;
        if (more) { nxt = cvt_moe_panel(F, l, nx);
#pragma unroll
            for (int i = 0; i < 8; ++i) { const int idx = tid + i * 512, kk = idx >> 6, c4 = (idx & 63) * 4; rv[i] = *(const g8::f32x4*)(nxt.W + (size_t)kk * nxt.ldw + c4); } }
        { const int n = tid >> 1, k0 = (tid & 1) * 32; const int row = cur.gu_map ? ((n >> 7) * 256 + cur.up * 128 + (n & 127)) : n;
          bf16_t* d = cur.dst0 + (size_t)row * cur.ldt + k0;
#pragma unroll
          for (int j = 0; j < 4; ++j) { g8::f32x4 a, b;
#pragma unroll
              for (int e = 0; e < 4; ++e) { a[e] = scr[(k0 + j * 8 + e) * 257 + n]; b[e] = scr[(k0 + j * 8 + 4 + e) * 257 + n]; }
              *(g8::u32x4*)(d + j * 8) = g8::pack8(a, b); } }
        if (!more) break;
        cur = nxt; it = nx;
    }
    __syncthreads();
}

__device__ __forceinline__ void rope8_fly(g8::f32x4& a, g8::f32x4& b, const g8::f32x4& pa, const g8::f32x4& pb, float pos, bool first) {
    const float ir[8] = {0.15915494309f, 0.05032921210f, 0.01591549431f, 0.00503292121f, 0.00159154943f, 0.00050329212f, 0.00015915494f, 0.00005032921f};
#pragma unroll
    for (int e = 0; e < 4; ++e) { const float x0 = __builtin_amdgcn_fractf(pos * ir[e]), x1 = __builtin_amdgcn_fractf(pos * ir[4 + e]);
        const float c0 = __builtin_amdgcn_cosf(x0), s0 = __builtin_amdgcn_sinf(x0), c1 = __builtin_amdgcn_cosf(x1), s1 = __builtin_amdgcn_sinf(x1);
        if (first) { a[e] = a[e] * c0 - pa[e] * s0; b[e] = b[e] * c1 - pb[e] * s1; } else { a[e] = pa[e] * s0 + a[e] * c0; b[e] = pb[e] * s1 + b[e] * c1; } }
}
__device__ __forceinline__ void rope8(g8::f32x4& a, g8::f32x4& b, const g8::f32x4& pa, const g8::f32x4& pb, const float* tab, int vi) {
    const int ax = vi >> 1; const bool first = (vi & 1) == 0;
    const g8::f32x4 c0 = *(const g8::f32x4*)(tab + ax * 16), c1 = *(const g8::f32x4*)(tab + ax * 16 + 4), s0 = *(const g8::f32x4*)(tab + ax * 16 + 8), s1 = *(const g8::f32x4*)(tab + ax * 16 + 12);
    if (first) { a = a * c0 - pa * s0; b = b * c1 - pb * s1; } else { a = pa * s0 + a * c0; b = pb * s1 + b * c1; }
}

using g8::f32x4; using g8::u32x4; using g8::GUnit;
#define EPI_ARGS const f32x4 (&acc)[2][2][4][2], const GUnit& u, int wr, int wc, int fr, int fq, int tid
#define EPI_FOR(...) do { _Pragma("unroll") for (int ai = 0; ai < 2; ++ai) _Pragma("unroll") for (int m = 0; m < 4; ++m) { const int lr = ai * 128 + wr * 64 + m * 16 + fr; \
    _Pragma("unroll") for (int bj = 0; bj < 2; ++bj) { const int lc = bj * 128 + wc * 32 + 8 * fq; f32x4 v0 = acc[ai][bj][m][0], v1 = acc[ai][bj][m][1]; const int gi = (ai * 4 + m) * 2 + bj; (void)gi; __VA_ARGS__ } asm volatile("" ::: "memory"); } } while (0)
__device__ __forceinline__ f32x4 gelu4(f32x4 x) { f32x4 o;
#pragma unroll
    for (int i = 0; i < 4; ++i) { const float t = x[i]; o[i] = t * g8::fsigmoid(1.5957691216057308f * (t + 0.044715f * t * t * t)); } return o; }

struct SchedInproj { const char* A; const char* B; int G, c;
    __device__ __forceinline__ bool get(int i, GUnit& u) const { int pm, pn; if (!g8::tile_order(i, G, c, M / 256, 15, pm, pn)) return false;
        u.A = A; u.B = B + (size_t)pn * 256 * 2048; u.rows = nullptr; u.arow0 = pm * 256; u.lda2 = 2048u; u.ldb2 = 2048u; u.nt = 16; u.pm = pm; u.pn = pn; u.tag = 0; return true; } };
__device__ __forceinline__ float fq_sum(float v, int lane) {
    v += __builtin_bit_cast(float, __builtin_amdgcn_ds_bpermute((lane ^ 16) << 2, __builtin_bit_cast(int, v)));
    v += __builtin_bit_cast(float, __builtin_amdgcn_ds_bpermute((lane ^ 32) << 2, __builtin_bit_cast(int, v))); return v; }
struct EpiInproj { bf16_t *RET, *CQ, *CKV, *KR, *UV; float *PART, *PARTV; const float *krg, *rope;
    __device__ __forceinline__ void operator()(EPI_ARGS) const {
        const int r0 = u.pm * 256, lane = tid & 63;
        if (u.pn < 8) { const float sc = (u.pn == 2 || u.pn == 3) ? 0.08838834764831845f : 1.0f;
            EPI_FOR({ *(u32x4*)(RET + (size_t)(r0 + lr) * 2048 + u.pn * 256 + lc) = g8::pack8(v0 * sc, v1 * sc); });
        } else if (u.pn < 11) {
            const bool lat = r0 < ML;
            EPI_FOR({ const int c = (u.pn - 8) * 256 + lc; const int r = r0 + lr;
                const float ss = fq_sum(sumsq8(v0, v1), lane); if (fq == 0 && c < 672) PART[(size_t)r * 24 + (c >> 5)] = ss;
                if (c < 384) *(u32x4*)(CQ + (size_t)r * 384 + c) = g8::pack8(v0, v1);
                else if (c < 640) *(u32x4*)(CKV + (size_t)r * 256 + (c - 384)) = g8::pack8(v0, v1);
                else if (c < 672) {
                    const float rstd = 1.0f / sqrtf(ss * (1.0f / 32.f) + EPS); const g8::f32x4 g0 = *(const g8::f32x4*)(krg + 8 * fq), g1 = *(const g8::f32x4*)(krg + 8 * fq + 4);
                    g8::f32x4 y0 = v0 * rstd * g0, y1 = v1 * rstd * g1, p0, p1;
                    _Pragma("unroll") for (int i = 0; i < 4; ++i) { p0[i] = __builtin_bit_cast(float, __builtin_amdgcn_ds_bpermute((lane ^ 16) << 2, __builtin_bit_cast(int, y0[i]))); p1[i] = __builtin_bit_cast(float, __builtin_amdgcn_ds_bpermute((lane ^ 16) << 2, __builtin_bit_cast(int, y1[i]))); }
                    if (lat) { const int t = r & (SEQ - 1); rope8_fly(y0, y1, p0, p1, (float)((fq >> 1) ? (t & 63) : (t >> 6)), (fq & 1) == 0); }
                    *(u32x4*)(KR + (size_t)r * 32 + 8 * fq) = g8::pack8(y0, y1); } });
        } else {
            EPI_FOR({ const g8::f32x4 z0 = gelu4(v0), z1 = gelu4(v1); const int c = (u.pn - 11) * 256 + lc; const int r = r0 + lr;
                *(u32x4*)(UV + (size_t)r * 1024 + c) = g8::pack8(z0, z1);
                if (u.pn >= 13) { const float s1 = fq_sum((z0[0] + z0[1]) + (z0[2] + z0[3]) + (z1[0] + z1[1]) + (z1[2] + z1[3]), lane), s2 = fq_sum(sumsq8(z0, z1), lane);
                    if (fq == 0) { float* pp = PARTV + ((size_t)r * 16 + ((c - 512) >> 5)) * 2; pp[0] = s1; pp[1] = s2; } } });
        }
    } };
struct SchedMlaUp { const char *CQ, *CKV, *WQ, *WKV; int G, c;
    __device__ __forceinline__ bool get(int i, GUnit& u) const { int pm, pn; if (!g8::tile_order(i, G, c, M / 256, 8, pm, pn)) return false;
        u.rows = nullptr; u.arow0 = pm * 256; u.pm = pm;
        if (pn < 4) { u.A = CQ; u.lda2 = 768u; u.B = WQ + (size_t)pn * 256 * 768; u.ldb2 = 768u; u.nt = 6; u.pn = pn; u.tag = 0; }
        else { u.A = CKV; u.lda2 = 512u; u.B = WKV + (size_t)(pn - 4) * 256 * 512; u.ldb2 = 512u; u.nt = 4; u.pn = pn - 4; u.tag = 1; }
        return true; } };
#define EPI_BAR() do { asm volatile("s_waitcnt lgkmcnt(0)" ::: "memory"); __builtin_amdgcn_s_barrier(); asm volatile("" ::: "memory"); } while (0)
struct EpiMlaFused { bf16_t *Q, *K, *V; const bf16_t* KRN; const float *qng, *kng, *rope, *PART; LAS float* SS;
    __device__ __forceinline__ void operator()(EPI_ARGS) const {
        const int r0 = u.pm * 256, lane = tid & 63;
        const bool act = (u.tag == 0) ? (wc < 3) : (wc < 2);
        float rs[8];
#pragma unroll
        for (int ai = 0; ai < 2; ++ai)
#pragma unroll
            for (int m = 0; m < 4; ++m) { const float* pp = PART + (size_t)(r0 + ai * 128 + wr * 64 + m * 16 + fr) * 24;
                if (u.tag == 0) { const g8::f32x4 a = *(const g8::f32x4*)pp, b = *(const g8::f32x4*)(pp + 4), c = *(const g8::f32x4*)(pp + 8);
                    rs[ai * 4 + m] = 1.0f / sqrtf((((a[0] + a[1]) + (a[2] + a[3])) + ((b[0] + b[1]) + (b[2] + b[3])) + ((c[0] + c[1]) + (c[2] + c[3]))) * (1.0f / 384.f) + EPS); }
                else { const g8::f32x4 a = *(const g8::f32x4*)(pp + 12), b = *(const g8::f32x4*)(pp + 16);
                    rs[ai * 4 + m] = 1.0f / sqrtf((((a[0] + a[1]) + (a[2] + a[3])) + ((b[0] + b[1]) + (b[2] + b[3]))) * (1.0f / 256.f) + EPS); } }
        EPI_FOR({ const float rsr = rs[ai * 4 + m]; v0 = v0 * rsr; v1 = v1 * rsr; float ss = sumsq8(v0, v1);
            ss += __builtin_bit_cast(float, __builtin_amdgcn_ds_bpermute((lane ^ 16) << 2, __builtin_bit_cast(int, ss)));
            ss += __builtin_bit_cast(float, __builtin_amdgcn_ds_bpermute((lane ^ 32) << 2, __builtin_bit_cast(int, ss)));
            if (fq == 0) SS[(lr * 2 + bj) * 4 + wc] = act ? ss : 0.f; });
        u32x4 krn[8];
        if (u.tag == 1 && wc == 2) {
#pragma unroll
            for (int i = 0; i < 8; ++i) krn[i] = *(const u32x4*)(KRN + (size_t)(r0 + (i >> 2) * 128 + wr * 64 + (i & 3) * 16 + fr) * 32 + 8 * fq); }
        EPI_BAR();
        const int hcg = (u.tag == 0 ? (wc < 3 ? wc : 0) : (wc & 1)) * 32 + 8 * fq; const float* gp_ = (u.tag == 0 ? qng : kng) + hcg;
        const g8::f32x4 gq0 = *(const g8::f32x4*)gp_, gq1 = *(const g8::f32x4*)(gp_ + 4);
        if (u.tag == 0) {
            const bool lat = r0 < ML;
            EPI_FOR({ const float rsr = rs[ai * 4 + m]; v0 = v0 * rsr; v1 = v1 * rsr; const g8::f32x4 t = *(const LAS g8::f32x4*)(SS + (lr * 2 + bj) * 4); const float rstd = 1.0f / sqrtf(((t[0] + t[1]) + t[2]) * (1.0f / 96.f) + EPS);
                if (wc < 3) { const int hc = wc * 32 + 8 * fq;
                    g8::f32x4 y0 = v0 * rstd * gq0, y1 = v1 * rstd * gq1;
                    if (wc == 2 && lat) { g8::f32x4 p0, p1;
                        _Pragma("unroll") for (int i = 0; i < 4; ++i) { p0[i] = __builtin_bit_cast(float, __builtin_amdgcn_ds_bpermute((lane ^ 16) << 2, __builtin_bit_cast(int, y0[i]))); p1[i] = __builtin_bit_cast(float, __builtin_amdgcn_ds_bpermute((lane ^ 16) << 2, __builtin_bit_cast(int, y1[i]))); }
                        const int t = (r0 + lr) & (SEQ - 1); rope8_fly(y0, y1, p0, p1, (float)((fq >> 1) ? (t & 63) : (t >> 6)), (fq & 1) == 0); }
                    *(u32x4*)(Q + (size_t)(r0 + lr) * 768 + (2 * u.pn + bj) * 96 + hc) = g8::pack8(y0 * QSCALE, y1 * QSCALE); } });
        } else {
            EPI_FOR({ const int h = 2 * u.pn + bj; const float rsr = rs[ai * 4 + m]; v0 = v0 * rsr; v1 = v1 * rsr;
                if (wc < 2) { const LAS float* t = SS + (lr * 2 + bj) * 4; const float rk = 1.0f / sqrtf((t[0] + t[1]) * (1.0f / 64.f) + EPS); const int hc = wc * 32 + 8 * fq;
                    *(u32x4*)(K + (size_t)(r0 + lr) * 768 + h * 96 + hc) = g8::pack8(v0 * rk * gq0, v1 * rk * gq1); }
                else { *(u32x4*)(V + (size_t)(r0 + lr) * 512 + h * 64 + (wc - 2) * 32 + 8 * fq) = g8::pack8(v0, v1);
                    if (wc == 2) *(u32x4*)(K + (size_t)(r0 + lr) * 768 + h * 96 + 64 + 8 * fq) = krn[ai * 4 + m]; } });
        }
        EPI_BAR();
    } };
struct SchedMerge { const char *H, *WG, *ABR, *WBR; unsigned lda2; int G, c, nM;
    __device__ __forceinline__ bool get(int i, GUnit& u) const { int pm, pn; if (!g8::tile_order(i >> 1, G, c, nM, 4, pm, pn)) return false;
        u.rows = nullptr; u.arow0 = pm * 256; u.pm = pm; u.pn = pn; u.tag = i & 1;
        if ((i & 1) == 0) { u.A = H; u.lda2 = 2048u; u.B = WG + (size_t)(pn * 256) * 2048; u.ldb2 = 2048u; u.nt = 16; }
        else { u.A = ABR; u.lda2 = lda2; u.B = WBR + (size_t)pn * 256 * 1024; u.ldb2 = 1024u; u.nt = 8; }
        return true; } };
template <int BR> struct EpiMerge { bf16_t* Y; u32x4* scrT;
    __device__ __forceinline__ void operator()(EPI_ARGS) const {
        const int r0 = u.pm * 256;
        if (u.tag == 0) { EPI_FOR({ f32x4 s0, s1;
                _Pragma("unroll") for (int i = 0; i < 4; ++i) { s0[i] = g8::fsigmoid(v0[i]); s1[i] = g8::fsigmoid(v1[i]); }
                scrT[gi * 512 + tid] = g8::pack8(s0, s1); });
        } else {
#pragma unroll
            for (int ai = 0; ai < 2; ++ai) { u32x4 tv[4][2], yv[4][2];
#pragma unroll
                for (int m = 0; m < 4; ++m)
#pragma unroll
                    for (int bj = 0; bj < 2; ++bj) { const int lr = ai * 128 + wr * 64 + m * 16 + fr, lc = bj * 128 + wc * 32 + 8 * fq, gi = (ai * 4 + m) * 2 + bj;
                        tv[m][bj] = scrT[gi * 512 + tid]; if (BR > 0) yv[m][bj] = *(const u32x4*)(Y + (size_t)(r0 + lr) * 1024 + u.pn * 256 + lc); }
#pragma unroll
                for (int m = 0; m < 4; ++m)
#pragma unroll
                    for (int bj = 0; bj < 2; ++bj) { const int lr = ai * 128 + wr * 64 + m * 16 + fr, lc = bj * 128 + wc * 32 + 8 * fq;
                        f32x4 t0, t1; g8::unpack8(tv[m][bj], t0, t1); f32x4 y0 = t0 * acc[ai][bj][m][0], y1 = t1 * acc[ai][bj][m][1];
                        if (BR > 0) { f32x4 p0, p1; g8::unpack8(yv[m][bj], p0, p1); y0 += p0; y1 += p1; }
                        *(u32x4*)(Y + (size_t)(r0 + lr) * 1024 + u.pn * 256 + lc) = g8::pack8(y0, y1); }
                asm volatile("" ::: "memory"); }
        }
    } };
struct SchedOut { const char *Y, *W; int G, c, nM;
    __device__ __forceinline__ bool get(int i, GUnit& u) const { int pm, pn; if (!g8::tile_order(i, G, c, nM, 4, pm, pn)) return false;
        u.A = Y; u.B = W + (size_t)pn * 256 * 2048; u.rows = nullptr; u.arow0 = pm * 256; u.lda2 = 2048u; u.ldb2 = 2048u; u.nt = 16; u.pm = pm; u.pn = pn; u.tag = 0; return true; } };
struct EpiResid { const float* xlat32; const float* xctx32; bf16_t* X16; const float* modg; int l;
    __device__ __forceinline__ void operator()(EPI_ARGS) const {
        const int r0 = u.pm * 256; const bool lat = r0 < ML;
        const float* g = modg + (size_t)(lat ? (r0 >> 13) : 4) * 6144 + u.pn * 256 + wc * 32 + 8 * fq;
        f32x4 gv[2][2];
#pragma unroll
        for (int bj = 0; bj < 2; ++bj) { gv[bj][0] = *(const f32x4*)(g + bj * 128); gv[bj][1] = *(const f32x4*)(g + bj * 128 + 4); }
        const size_t c0 = (size_t)u.pn * 256 + wc * 32 + 8 * fq;
        bf16_t* xd0 = X16 + (size_t)r0 * D + c0;
        if (l == 0) {
            const float* xs0 = (lat ? xlat32 + (size_t)r0 * D : xctx32 + (size_t)(r0 - ML) * D) + c0;
#pragma unroll
            for (int ai = 0; ai < 2; ++ai) { f32x4 xv[4][2][2];
#pragma unroll
                for (int m = 0; m < 4; ++m)
#pragma unroll
                    for (int bj = 0; bj < 2; ++bj) { const float* xp = xs0 + (size_t)(ai * 128 + wr * 64 + m * 16 + fr) * D + bj * 128;
                        xv[m][bj][0] = *(const f32x4*)xp; xv[m][bj][1] = *(const f32x4*)(xp + 4); }
#pragma unroll
                for (int m = 0; m < 4; ++m)
#pragma unroll
                    for (int bj = 0; bj < 2; ++bj)
                        *(u32x4*)(xd0 + (size_t)(ai * 128 + wr * 64 + m * 16 + fr) * D + bj * 128) = g8::pack8(xv[m][bj][0] + gv[bj][0] * acc[ai][bj][m][0], xv[m][bj][1] + gv[bj][1] * acc[ai][bj][m][1]);
                asm volatile("" ::: "memory"); }
        } else {
#pragma unroll
            for (int ai = 0; ai < 2; ++ai) { u32x4 xw[4][2];
#pragma unroll
                for (int m = 0; m < 4; ++m)
#pragma unroll
                    for (int bj = 0; bj < 2; ++bj) xw[m][bj] = *(const u32x4*)(xd0 + (size_t)(ai * 128 + wr * 64 + m * 16 + fr) * D + bj * 128);
#pragma unroll
                for (int m = 0; m < 4; ++m)
#pragma unroll
                    for (int bj = 0; bj < 2; ++bj) { f32x4 x0, x1; g8::unpack8(xw[m][bj], x0, x1);
                        *(u32x4*)(xd0 + (size_t)(ai * 128 + wr * 64 + m * 16 + fr) * D + bj * 128) = g8::pack8(x0 + gv[bj][0] * acc[ai][bj][m][0], x1 + gv[bj][1] * acc[ai][bj][m][1]); }
                asm volatile("" ::: "memory"); }
        }
    } };
__device__ __forceinline__ void moe_tiles(Frame& F, int l, LAS int* tt) {
    __syncthreads();
    if (F.tid < 64) { const int e = F.tid; const int c = (int)F_ctl[CW_CNT + l * 64 + e]; const int n = (c + 255) >> 8; int incl = n;
#pragma unroll
        for (int o = 1; o < 64; o <<= 1) { const int v = __builtin_amdgcn_ds_bpermute(((e - o) & 63) << 2, incl); if (e >= o) incl += v; }
        const int start = incl - n; for (int j = 0; j < n; ++j) tt[1 + start + j] = e; if (e == 63) tt[0] = incl; }
    __syncthreads();
}
struct SchedGateUp { const char *H, *MOEW, *SHGU; const int* rowtok; const LAS int* tt; int G, c, nsh  ;
    __device__ __forceinline__ bool get(int i, GUnit& u) const { const int ntr = __builtin_amdgcn_readfirstlane(tt[0]);
        const int xcd = c & 7, q = i * (G >> 3) + (c >> 3), g = (q >> 1) * 8 + xcd, pn = q & 1;
        u.A = H; u.lda2 = 2048u; u.ldb2 = 2048u; u.nt = 16;
        if (g < ntr) { const int e = __builtin_amdgcn_readfirstlane(tt[1 + g]); u.rows = rowtok; u.arow0 = g * 256; u.B = MOEW + (size_t)e * (1536 * 1024) + (size_t)pn * 256 * 2048; u.pm = g; u.pn = pn; u.tag = 0; return true; }
        const int g2 = g - ntr; if (g2 >= nsh) return false;
        u.rows = nullptr; u.arow0 = g2 * 256; u.B = SHGU + (size_t)pn * 256 * 2048; u.pm = g2; u.pn = pn; u.tag = 1; return true; }
};
struct EpiGateUp { bf16_t *HB, *HBS;
    __device__ __forceinline__ void operator()(EPI_ARGS) const {
        bf16_t* dst = (u.tag == 0 ? HB : HBS) + (size_t)(u.pm * 256) * DEXP + u.pn * 128;
#pragma unroll
        for (int ai = 0; ai < 2; ++ai)
#pragma unroll
            for (int m = 0; m < 4; ++m) { const int lr = ai * 128 + wr * 64 + m * 16 + fr; f32x4 h0, h1;
#pragma unroll
                for (int i = 0; i < 4; ++i) { const float g0 = acc[ai][0][m][0][i], g1 = acc[ai][0][m][1][i];
                    h0[i] = g0 * g8::fsigmoid(g0) * acc[ai][1][m][0][i]; h1[i] = g1 * g8::fsigmoid(g1) * acc[ai][1][m][1][i]; }
                *(u32x4*)(dst + (size_t)lr * DEXP + wc * 32 + 8 * fq) = g8::pack8(h0, h1); }
    } };
struct SchedDown { const char *HB, *HBS, *MOEW, *SHD; const LAS int* tt; int G, c, nsh;
    __device__ __forceinline__ bool get(int i, GUnit& u) const { const int ntr = __builtin_amdgcn_readfirstlane(tt[0]);
        const int xcd = c & 7, q = i * (G >> 3) + (c >> 3), g = (q >> 2) * 8 + xcd, pn = q & 3;
        u.rows = nullptr; u.lda2 = 512u; u.ldb2 = 512u; u.nt = 4;
        if (g < ntr) { const int e = __builtin_amdgcn_readfirstlane(tt[1 + g]); u.A = HB; u.arow0 = g * 256; u.B = MOEW + (size_t)e * (1536 * 1024) + 1024 * 1024 + (size_t)(pn * 256) * 512; u.pm = g; u.pn = pn; u.tag = 0; return true; }
        const int g2 = g - ntr; if (g2 >= nsh) return false;
        u.A = HBS; u.arow0 = g2 * 256; u.B = SHD + (size_t)pn * 256 * 512; u.pm = g2; u.pn = pn; u.tag = 1; return true; } };
__device__ __forceinline__ unsigned pack_fp8x4(const f32x4& v) { unsigned w = 0;
    w = __builtin_amdgcn_cvt_pk_fp8_f32(__builtin_amdgcn_fmed3f(v[0], -448.f, 448.f), __builtin_amdgcn_fmed3f(v[1], -448.f, 448.f), w, false);
    w = __builtin_amdgcn_cvt_pk_fp8_f32(__builtin_amdgcn_fmed3f(v[2], -448.f, 448.f), __builtin_amdgcn_fmed3f(v[3], -448.f, 448.f), w, true); return w; }
struct EpiDown { unsigned char* OUT8; bf16_t* SHOUT;
    __device__ __forceinline__ void operator()(EPI_ARGS) const {
        if (u.tag == 0) { EPI_FOR({ uint2 w; w.x = pack_fp8x4(v0); w.y = pack_fp8x4(v1); *(uint2*)(OUT8 + (size_t)(u.pm * 256 + lr) * 1024 + u.pn * 256 + lc) = w; }); }
        else { EPI_FOR({ *(u32x4*)(SHOUT + (size_t)(u.pm * 256 + lr) * 1024 + u.pn * 256 + lc) = g8::pack8(v0, v1); }); }
    } };
namespace at {
typedef short bf16x8 __attribute__((ext_vector_type(8)));
typedef short s16x4 __attribute__((ext_vector_type(4)));
typedef float f32x16 __attribute__((ext_vector_type(16)));
constexpr int KSTR = 208, VSTR = 192, KT = 128  , KBUF = KT * KSTR, VBUF = KT * VSTR, STAGE = KBUF + VBUF, LDS_WSF = 2 * STAGE;
__device__ __forceinline__ int crow(int r, int hi) { return (r & 3) + 8 * (r >> 2) + 4 * hi; }
__device__ __forceinline__ s16x4 vtr(const LAS unsigned char* p) { return __builtin_bit_cast(s16x4, __builtin_amdgcn_ds_read_tr16_b64_v4i16((LAS s16x4*)p)); }
#define AT_BAR() do { asm volatile("s_waitcnt lgkmcnt(0)" ::: "memory"); __builtin_amdgcn_s_barrier(); asm volatile("" ::: "memory"); } while (0)
__device__ __forceinline__ void attn_unit(LAS unsigned char* lds, const bf16_t* __restrict__ Q, const bf16_t* __restrict__ K, const bf16_t* __restrict__ V, bf16_t* __restrict__ O,
                                          int h, int qrow0, int kr0, int kn0, int kr1, int kn1, int tid) {
    const int lane = tid & 63, wave = __builtin_amdgcn_readfirstlane(tid >> 6), r32 = lane & 31, hi = lane >> 5;
    unsigned ko_[3], kw_[3];
#pragma unroll
    for (int i = 0; i < 3; ++i) { const int ch = tid + 512 * i, kr = ch / 12, kc = ch % 12; ko_[i] = kr * 768 + kc * 8; kw_[i] = kr * KSTR + kc * 16; }
    const int vr = tid >> 3, vc = tid & 7; const unsigned vo = vr * 512 + vc * 8, vw = KBUF + vr * VSTR + vc * 16;
    const int nt = kn0 + kn1;
    g8::u32x4 rk[3], rv[2];
#define AT_LOAD(t) do { const int _t = (t); const int _row = _t < kn0 ? kr0 + KT * _t : kr1 + KT * (_t - kn0); const bf16_t* _kb = K + (size_t)_row * 768 + h * 96; const bf16_t* _vb = V + (size_t)_row * 512 + h * 64; \
        _Pragma("unroll") for (int _i = 0; _i < 3; ++_i) rk[_i] = *(const g8::u32x4*)(_kb + ko_[_i]); \
        rv[0] = *(const g8::u32x4*)(_vb + vo); rv[1] = *(const g8::u32x4*)(_vb + vo + 64 * 512); } while (0)
#define AT_WRITE(buf) do { LAS unsigned char* _b = lds + (buf) * STAGE; _Pragma("unroll") for (int _i = 0; _i < 3; ++_i) *(LAS g8::u32x4*)(_b + kw_[_i]) = rk[_i]; \
        *(LAS g8::u32x4*)(_b + vw) = rv[0]; *(LAS g8::u32x4*)(_b + vw + 64 * VSTR) = rv[1]; } while (0)
    AT_LOAD(0);
    bf16x8 qf[6];
    { const bf16_t* qp = Q + (size_t)(qrow0 + wave * 32 + r32) * 768 + h * 96 + hi * 8;
#pragma unroll
      for (int d0 = 0; d0 < 6; ++d0) qf[d0] = *(const bf16x8*)(qp + d0 * 16); }
    AT_WRITE(0);
    if (nt > 1) AT_LOAD(1);
    AT_BAR();
    f32x16 o0 = {}, o1 = {}; float lsum = 0.f;
    const unsigned kroff = r32 * KSTR + hi * 16;
    const unsigned vroff = KBUF + (4 * hi + ((lane & 15) >> 2)) * VSTR + ((lane >> 4) & 1) * 32 + (lane & 3) * 8;
    for (int t = 0; t < nt; ++t) {
        const LAS unsigned char* sb = lds + (t & 1) * STAGE;
        f32x16 p[4] = {};
#define AT_KLD(dst, d0) do { _Pragma("unroll") for (int x = 0; x < 4; ++x) dst[x] = *(const LAS bf16x8*)(sb + kroff + 32 * x * KSTR + (d0) * 32); } while (0)
#define AT_KMM(src, d0) do { __builtin_amdgcn_s_setprio(1); _Pragma("unroll") for (int x = 0; x < 4; ++x) p[x] = __builtin_amdgcn_mfma_f32_32x32x16_bf16(src[x], qf[d0], p[x], 0, 0, 0); __builtin_amdgcn_s_setprio(0); } while (0)
        { bf16x8 ka[4], kb[4];
          AT_KLD(ka, 0); __builtin_amdgcn_sched_barrier(0);
          AT_KLD(kb, 1); __builtin_amdgcn_sched_barrier(0); AT_KMM(ka, 0); __builtin_amdgcn_sched_barrier(0);
          AT_KLD(ka, 2); __builtin_amdgcn_sched_barrier(0); AT_KMM(kb, 1); __builtin_amdgcn_sched_barrier(0);
          AT_KLD(kb, 3); __builtin_amdgcn_sched_barrier(0); AT_KMM(ka, 2); __builtin_amdgcn_sched_barrier(0);
          AT_KLD(ka, 4); __builtin_amdgcn_sched_barrier(0); AT_KMM(kb, 3); __builtin_amdgcn_sched_barrier(0);
          AT_KLD(kb, 5); __builtin_amdgcn_sched_barrier(0); AT_KMM(ka, 4); __builtin_amdgcn_sched_barrier(0);
          AT_KMM(kb, 5); __builtin_amdgcn_sched_barrier(0); }
#undef AT_KLD
#undef AT_KMM
        float s = 0.f;
#pragma unroll
        for (int x = 0; x < 4; ++x)
#pragma unroll
            for (int r = 0; r < 16; ++r) { p[x][r] = __builtin_amdgcn_exp2f(p[x][r]); s += p[x][r]; }
        lsum += s;
#define AT_VLD(dst, ks) do { _Pragma("unroll") for (int d0 = 0; d0 < 2; ++d0) { const s16x4 lo = vtr(sb + vroff + (16 * (ks)) * VSTR + d0 * 64), hh = vtr(sb + vroff + (16 * (ks) + 8) * VSTR + d0 * 64); \
            dst[d0] = (bf16x8){lo[0], lo[1], lo[2], lo[3], hh[0], hh[1], hh[2], hh[3]}; } } while (0)
#define AT_PMM(src, ks) do { unsigned w[4]; _Pragma("unroll") for (int j = 0; j < 4; ++j) { const int r = 8 * ((ks) & 1) + 2 * j; w[j] = g8::cvtpk(p[(ks) >> 1][r], p[(ks) >> 1][r + 1]); } \
            const bf16x8 pa = __builtin_bit_cast(bf16x8, (g8::u32x4){w[0], w[1], w[2], w[3]}); __builtin_amdgcn_s_setprio(1); \
            o0 = __builtin_amdgcn_mfma_f32_32x32x16_bf16(pa, src[0], o0, 0, 0, 0); o1 = __builtin_amdgcn_mfma_f32_32x32x16_bf16(pa, src[1], o1, 0, 0, 0); __builtin_amdgcn_s_setprio(0); } while (0)
        { bf16x8 va[2], vb[2];
          AT_VLD(va, 0); __builtin_amdgcn_sched_barrier(0);
          AT_VLD(vb, 1); __builtin_amdgcn_sched_barrier(0); AT_PMM(va, 0); __builtin_amdgcn_sched_barrier(0);
          AT_VLD(va, 2); __builtin_amdgcn_sched_barrier(0); AT_PMM(vb, 1); __builtin_amdgcn_sched_barrier(0);
          AT_VLD(vb, 3); __builtin_amdgcn_sched_barrier(0); AT_PMM(va, 2); __builtin_amdgcn_sched_barrier(0);
          AT_VLD(va, 4); __builtin_amdgcn_sched_barrier(0); AT_PMM(vb, 3); __builtin_amdgcn_sched_barrier(0);
          AT_VLD(vb, 5); __builtin_amdgcn_sched_barrier(0); AT_PMM(va, 4); __builtin_amdgcn_sched_barrier(0);
          AT_VLD(va, 6); __builtin_amdgcn_sched_barrier(0); AT_PMM(vb, 5); __builtin_amdgcn_sched_barrier(0);
          AT_VLD(vb, 7); __builtin_amdgcn_sched_barrier(0); AT_PMM(va, 6); __builtin_amdgcn_sched_barrier(0);
          AT_PMM(vb, 7); __builtin_amdgcn_sched_barrier(0); }
#undef AT_VLD
#undef AT_PMM
        if (t + 1 < nt) { AT_WRITE((t + 1) & 1); if (t + 2 < nt) AT_LOAD(t + 2); }
        AT_BAR();
    }
    lsum += xlane32(lsum, lane);
    LAS float* wsf = (LAS float*)(lds + LDS_WSF) + wave * 32;
    if (hi == 0) wsf[r32] = lsum;
    asm volatile("s_waitcnt lgkmcnt(0)" ::: "memory");
    bf16_t* op = O + (size_t)(qrow0 + wave * 32) * 512 + h * 64 + r32;
#pragma unroll
    for (int r = 0; r < 16; ++r) { const int q = crow(r, hi); const float rl = 1.0f / wsf[q];
        op[(size_t)q * 512] = (bf16_t)f2bf(o0[r] * rl); op[(size_t)q * 512 + 32] = (bf16_t)f2bf(o1[r] * rl); }
    AT_BAR();
#undef AT_LOAD
#undef AT_WRITE
}
#undef AT_BAR
}

namespace at16 {
using at::bf16x8; using at::s16x4; using at::vtr;
typedef float f32x4_t __attribute__((ext_vector_type(4)));
constexpr int KSTR = 256, VSTR = 160, KT = 128, KBUF = KT * KSTR, VBUF = KT * VSTR, STAGE = KBUF + VBUF, LDS_WSF = 2 * STAGE;
#define A16_BAR() do { asm volatile("s_waitcnt lgkmcnt(0)" ::: "memory"); __builtin_amdgcn_s_barrier(); asm volatile("" ::: "memory"); } while (0)
__device__ __forceinline__ void attn_unit(LAS unsigned char* lds, const bf16_t* __restrict__ Q, const bf16_t* __restrict__ K, const bf16_t* __restrict__ V, bf16_t* __restrict__ O,
                                          int h, int qrow0, int kr0, int kn0, int kr1, int kn1, int tid) {
    const int lane = tid & 63, wave = __builtin_amdgcn_readfirstlane(tid >> 6), i16 = lane & 15, g = lane >> 4;
    unsigned ko_[3], kw_[3];
#pragma unroll
    for (int i = 0; i < 3; ++i) { const int ch = tid + 512 * i, kr = ch / 12, kc = ch % 12; ko_[i] = kr * 768 + kc * 8; kw_[i] = kr * KSTR + ((kc ^ (kr & 15)) << 4); }
    const int vr = tid >> 3, vc = tid & 7; const unsigned vo = vr * 512 + vc * 8, vw = KBUF + vr * VSTR + vc * 16;
    const int nt = kn0 + kn1;
    g8::u32x4 rk[3], rv[2];
#define A16_LOAD(t) do { const int _t = (t); const int _row = _t < kn0 ? kr0 + KT * _t : kr1 + KT * (_t - kn0); const bf16_t* _kb = K + (size_t)_row * 768 + h * 96; const bf16_t* _vb = V + (size_t)_row * 512 + h * 64; \
        _Pragma("unroll") for (int _i = 0; _i < 3; ++_i) rk[_i] = *(const g8::u32x4*)(_kb + ko_[_i]); \
        rv[0] = *(const g8::u32x4*)(_vb + vo); rv[1] = *(const g8::u32x4*)(_vb + vo + 64 * 512); } while (0)
#define A16_WRITE(buf) do { LAS unsigned char* _b = lds + (buf) * STAGE; _Pragma("unroll") for (int _i = 0; _i < 3; ++_i) *(LAS g8::u32x4*)(_b + kw_[_i]) = rk[_i]; \
        *(LAS g8::u32x4*)(_b + vw) = rv[0]; *(LAS g8::u32x4*)(_b + vw + 64 * VSTR) = rv[1]; } while (0)
    A16_LOAD(0);
    bf16x8 qf[2][3];
#pragma unroll
    for (int qb = 0; qb < 2; ++qb) { const bf16_t* qp = Q + (size_t)(qrow0 + wave * 32 + qb * 16 + i16) * 768 + h * 96 + g * 8;
#pragma unroll
        for (int s = 0; s < 3; ++s) qf[qb][s] = *(const bf16x8*)(qp + s * 32); }
    A16_WRITE(0);
    if (nt > 1) A16_LOAD(1);
    A16_BAR();
    f32x4_t o[2][4] = {}, ol[2] = {};
    const bf16x8 ones = {(short)0x3F80, (short)0x3F80, (short)0x3F80, (short)0x3F80, (short)0x3F80, (short)0x3F80, (short)0x3F80, (short)0x3F80};
    unsigned kroff[3];
#pragma unroll
    for (int s2 = 0; s2 < 3; ++s2) kroff[s2] = i16 * KSTR + (((4 * s2 + g) ^ i16) << 4);
    const unsigned vroff = KBUF + (4 * g + (i16 >> 2)) * VSTR + (i16 & 3) * 8;
#define A16_KF(kbg, s) (*(const LAS bf16x8*)(sb + kroff[s] + (16 * (kbg)) * KSTR))
#define A16_VLD(vfx, hf, ks2) do { _Pragma("unroll") for (int dvb = 0; dvb < 4; ++dvb) { const LAS unsigned char* vp = sb + vroff + (64 * (hf) + 32 * (ks2)) * VSTR + dvb * 32; \
        const s16x4 lo = vtr(vp), hh = vtr(vp + 16 * VSTR); vfx[dvb] = (bf16x8){lo[0], lo[1], lo[2], lo[3], hh[0], hh[1], hh[2], hh[3]}; } } while (0)
#define A16_EXPQ(kb, qb) do { _Pragma("unroll") for (int r = 0; r < 4; ++r) st[kb][qb][r] = __builtin_amdgcn_exp2f(st[kb][qb][r]); } while (0)
#define A16_CVT(pax, ks2) do { _Pragma("unroll") for (int qb = 0; qb < 2; ++qb) { const f32x4_t a = st[2 * (ks2)][qb], b = st[2 * (ks2) + 1][qb]; \
        pax[qb] = __builtin_bit_cast(bf16x8, (g8::u32x4){g8::cvtpk(a[0], a[1]), g8::cvtpk(a[2], a[3]), g8::cvtpk(b[0], b[1]), g8::cvtpk(b[2], b[3])}); } } while (0)
#define A16_PV(pax, vfx, dvb) do { __builtin_amdgcn_s_setprio(1); _Pragma("unroll") for (int qb = 0; qb < 2; ++qb) o[qb][dvb] = __builtin_amdgcn_mfma_f32_16x16x32_bf16(pax[qb], vfx[dvb], o[qb][dvb], 0, 0, 0); __builtin_amdgcn_s_setprio(0); } while (0)
#define A16_PL(pax) do { __builtin_amdgcn_s_setprio(1); _Pragma("unroll") for (int qb = 0; qb < 2; ++qb) ol[qb] = __builtin_amdgcn_mfma_f32_16x16x32_bf16(pax[qb], ones, ol[qb], 0, 0, 0); __builtin_amdgcn_s_setprio(0); } while (0)
#define A16_SB() __builtin_amdgcn_sched_barrier(0)
    for (int t = 0; t < nt; ++t) {
        const LAS unsigned char* sb = lds + (t & 1) * STAGE;
        bf16x8 kf[2][3];
#pragma unroll
        for (int s = 0; s < 3; ++s) kf[0][s] = A16_KF(0, s);
#pragma unroll
        for (int s = 0; s < 3; ++s) kf[1][s] = A16_KF(1, s);
        A16_SB();
#pragma unroll
        for (int hf = 0; hf < 2; ++hf) {
            f32x4_t st[4][2];
            bf16x8 vf0[4], vf1[4], pa0[2], pa1[2];
#pragma unroll
            for (int kb = 0; kb < 4; ++kb) {
#pragma unroll
                for (int s = 0; s < 3; ++s) {
                    __builtin_amdgcn_s_setprio(1);
#pragma unroll
                    for (int qb = 0; qb < 2; ++qb) st[kb][qb] = __builtin_amdgcn_mfma_f32_16x16x32_bf16(kf[kb & 1][s], qf[qb][s], s == 0 ? (f32x4_t){0.f, 0.f, 0.f, 0.f} : st[kb][qb], 0, 0, 0);
                    __builtin_amdgcn_s_setprio(0);
                    if (4 * hf + kb + 2 < 8) kf[kb & 1][s] = A16_KF(4 * hf + kb + 2, s);
                    if (kb > 0 && s == 0) A16_EXPQ(kb - 1, 0);
                    if (kb > 0 && s == 1) A16_EXPQ(kb - 1, 1);
                    if (kb == 1 && s == 2) A16_VLD(vf0, hf, 0);
                    if (kb == 2 && s == 2) A16_CVT(pa0, 0);
                    if (kb == 3 && s == 2) A16_VLD(vf1, hf, 1);
                    A16_SB();
                }
            }
            A16_PV(pa0, vf0, 0); A16_EXPQ(3, 0); A16_SB();
            A16_PV(pa0, vf0, 1); A16_EXPQ(3, 1); A16_SB();
            A16_PV(pa0, vf0, 2); A16_CVT(pa1, 1); A16_SB();
            A16_PV(pa0, vf0, 3); A16_PL(pa0); A16_SB();
#pragma unroll
            for (int dvb = 0; dvb < 4; ++dvb) A16_PV(pa1, vf1, dvb);
            A16_PL(pa1);
            A16_SB();
        }
        if (t + 1 < nt) { A16_WRITE((t + 1) & 1); if (t + 2 < nt) A16_LOAD(t + 2); }
        A16_BAR();
    }
#undef A16_KF
#undef A16_VLD
#undef A16_EXPQ
#undef A16_CVT
#undef A16_PV
#undef A16_PL
#undef A16_SB
#pragma unroll
    for (int qb = 0; qb < 2; ++qb)
#pragma unroll
        for (int r = 0; r < 4; ++r) { const int q = qb * 16 + 4 * g + r; const float rl = 1.0f / ol[qb][r];
            bf16_t* op = O + (size_t)(qrow0 + wave * 32 + q) * 512 + h * 64 + i16;
#pragma unroll
            for (int dvb = 0; dvb < 4; ++dvb) op[dvb * 16] = (bf16_t)f2bf(o[qb][dvb][r] * rl); }
#undef A16_LOAD
#undef A16_WRITE
}
__device__ __forceinline__ void attn_unit64(LAS unsigned char* lds, const bf16_t* __restrict__ Q, const bf16_t* __restrict__ K, const bf16_t* __restrict__ V, bf16_t* __restrict__ O,
                                            int h, int qrow0, int kr0, int kn0, int kr1, int kn1, int tid) {
    const int lane = tid & 63, wave = __builtin_amdgcn_readfirstlane(tid >> 6), i16 = lane & 15, g = lane >> 4;
    unsigned ko_[3], kw_[3];
#pragma unroll
    for (int i = 0; i < 3; ++i) { const int ch = tid + 512 * i, kr = ch / 12, kc = ch % 12; ko_[i] = kr * 768 + kc * 8; kw_[i] = kr * KSTR + ((kc ^ (kr & 15)) << 4); }
    const int vr = tid >> 3, vc = tid & 7; const unsigned vo = vr * 512 + vc * 8, vw = KBUF + vr * VSTR + vc * 16;
    const int nt = kn0 + kn1;
    g8::u32x4 rk[3], rv[2];
#define A64_LOAD(t) do { const int _t = (t); const int _row = _t < kn0 ? kr0 + KT * _t : kr1 + KT * (_t - kn0); const bf16_t* _kb = K + (size_t)_row * 768 + h * 96; const bf16_t* _vb = V + (size_t)_row * 512 + h * 64; \
        _Pragma("unroll") for (int _i = 0; _i < 3; ++_i) rk[_i] = *(const g8::u32x4*)(_kb + ko_[_i]); \
        rv[0] = *(const g8::u32x4*)(_vb + vo); rv[1] = *(const g8::u32x4*)(_vb + vo + 64 * 512); } while (0)
#define A64_WRITE(buf) do { LAS unsigned char* _b = lds + (buf) * STAGE; _Pragma("unroll") for (int _i = 0; _i < 3; ++_i) *(LAS g8::u32x4*)(_b + kw_[_i]) = rk[_i]; \
        *(LAS g8::u32x4*)(_b + vw) = rv[0]; *(LAS g8::u32x4*)(_b + vw + 64 * VSTR) = rv[1]; } while (0)
    A64_LOAD(0);
    bf16x8 qf[4][3];
#pragma unroll
    for (int qb = 0; qb < 4; ++qb) { const bf16_t* qp = Q + (size_t)(qrow0 + wave * 64 + qb * 16 + i16) * 768 + h * 96 + g * 8;
#pragma unroll
        for (int s = 0; s < 3; ++s) qf[qb][s] = *(const bf16x8*)(qp + s * 32); }
    A64_WRITE(0);
    if (nt > 1) A64_LOAD(1);
    A16_BAR();
    f32x4_t o[4][4] = {}, ol[4] = {};
    const bf16x8 ones = {(short)0x3F80, (short)0x3F80, (short)0x3F80, (short)0x3F80, (short)0x3F80, (short)0x3F80, (short)0x3F80, (short)0x3F80};
    unsigned kroff[3];
#pragma unroll
    for (int s2 = 0; s2 < 3; ++s2) kroff[s2] = i16 * KSTR + (((4 * s2 + g) ^ i16) << 4);
    const unsigned vroff = KBUF + (4 * g + (i16 >> 2)) * VSTR + (i16 & 3) * 8;
    for (int t = 0; t < nt; ++t) {
        const LAS unsigned char* sb = lds + (t & 1) * STAGE;
        constexpr int KPD = 2;
#define A64_KF(idx) (*(const LAS bf16x8*)(sb + kroff[(idx) % 3] + (16 * ((idx) / 3)) * KSTR))
        bf16x8 kfr[KPD + 1];
#pragma unroll
        for (int i = 0; i < KPD; ++i) kfr[i] = A64_KF(i);
#pragma unroll
        for (int j = 0; j < 4; ++j) {
            f32x4_t st[2][4];
#pragma unroll
            for (int kb = 0; kb < 2; ++kb)
#pragma unroll
                for (int s = 0; s < 3; ++s) { const int idx = 3 * (2 * j + kb) + s;
                    if (idx + KPD < 24) kfr[(idx + KPD) % (KPD + 1)] = A64_KF(idx + KPD);
                    __builtin_amdgcn_s_setprio(1);
#pragma unroll
                    for (int qb = 0; qb < 4; ++qb) st[kb][qb] = __builtin_amdgcn_mfma_f32_16x16x32_bf16(kfr[idx % (KPD + 1)], qf[qb][s], s == 0 ? (f32x4_t){0.f, 0.f, 0.f, 0.f} : st[kb][qb], 0, 0, 0);
                    __builtin_amdgcn_s_setprio(0); }
            bf16x8 vf[4];
#pragma unroll
            for (int dvb = 0; dvb < 4; ++dvb) { const LAS unsigned char* vp = sb + vroff + (32 * j) * VSTR + dvb * 32;
                const s16x4 lo = vtr(vp), hh = vtr(vp + 16 * VSTR); vf[dvb] = (bf16x8){lo[0], lo[1], lo[2], lo[3], hh[0], hh[1], hh[2], hh[3]}; }
            bf16x8 pa[4];
#pragma unroll
            for (int qb = 0; qb < 4; ++qb) { f32x4_t a = st[0][qb], b = st[1][qb];
#pragma unroll
                for (int r = 0; r < 4; ++r) { a[r] = __builtin_amdgcn_exp2f(a[r]); b[r] = __builtin_amdgcn_exp2f(b[r]); }
                pa[qb] = __builtin_bit_cast(bf16x8, (g8::u32x4){g8::cvtpk(a[0], a[1]), g8::cvtpk(a[2], a[3]), g8::cvtpk(b[0], b[1]), g8::cvtpk(b[2], b[3])}); }
            __builtin_amdgcn_s_setprio(1);
#pragma unroll
            for (int dvb = 0; dvb < 4; ++dvb)
#pragma unroll
                for (int qb = 0; qb < 4; ++qb) o[qb][dvb] = __builtin_amdgcn_mfma_f32_16x16x32_bf16(pa[qb], vf[dvb], o[qb][dvb], 0, 0, 0);
#pragma unroll
            for (int qb = 0; qb < 4; ++qb) ol[qb] = __builtin_amdgcn_mfma_f32_16x16x32_bf16(pa[qb], ones, ol[qb], 0, 0, 0);
            __builtin_amdgcn_s_setprio(0);
        }
        if (t + 1 < nt) { A64_WRITE((t + 1) & 1); if (t + 2 < nt) A64_LOAD(t + 2); }
        A16_BAR();
    }
#pragma unroll
    for (int qb = 0; qb < 4; ++qb)
#pragma unroll
        for (int r = 0; r < 4; ++r) { const int q = qb * 16 + 4 * g + r; const float rl = 1.0f / ol[qb][r];
            bf16_t* op = O + (size_t)(qrow0 + wave * 64 + q) * 512 + h * 64 + i16;
#pragma unroll
            for (int dvb = 0; dvb < 4; ++dvb) op[dvb * 16] = (bf16_t)f2bf(o[qb][dvb][r] * rl); }
#undef A64_LOAD
#undef A64_WRITE
#undef A64_KF
}
#undef A16_BAR
}

namespace rt {
using at::bf16x8; using at::s16x4; using at::f32x16; using at::crow; using at::vtr;
constexpr int TSTR = 320;
constexpr int KSTR2 = 272;
constexpr size_t SLOT = 32768;
__device__ __forceinline__ bf16_t* slot_ptr(bf16_t* ST, int dir, int bh, int c) { return ST + ((size_t)((dir * 16 + bh) * 66 + c)) * 16384; }
__device__ __forceinline__ float log2_decay(const float* dec, int l, int h) { const float x = dec[l * 4 + h]; return -log1pf(expf(-x)) * 1.4426950408889634f; }
#define RT_BAR() do { asm volatile("s_waitcnt vmcnt(0) lgkmcnt(0)" ::: "memory"); __builtin_amdgcn_s_barrier(); asm volatile("" ::: "memory"); } while (0)
__device__ __forceinline__ g8::u32x4 scale8(const g8::u32x4& w, float s) { g8::f32x4 a, b; g8::unpack8(w, a, b); return g8::pack8(a * s, b * s); }
__device__ __forceinline__ bf16x8 tr_frag(const LAS unsigned char* tile, int k0, int cb, int lane) {
    const int hi = lane >> 5, q = (lane & 15) >> 2, p = lane & 3, g1 = (lane >> 4) & 1;
    const LAS unsigned char* a = tile + (k0 + 8 * hi + q) * TSTR + (cb * 32 + 16 * g1 + 4 * p) * 2;
    const s16x4 lo = vtr(a), hh = vtr(a + 4 * TSTR);
    return (bf16x8){lo[0], lo[1], lo[2], lo[3], hh[0], hh[1], hh[2], hh[3]};
}
__device__ __forceinline__ bf16x8 tr_frag_perm(const LAS unsigned char* tile, int k0, int cb, int lane) {
    const int hi = lane >> 5, q = (lane & 15) >> 2, p = lane & 3, g1 = (lane >> 4) & 1;
    const LAS unsigned char* a = tile + (k0 + 4 * hi + q) * TSTR + (cb * 32 + 16 * g1 + 4 * p) * 2;
    const s16x4 lo = vtr(a), hh = vtr(a + 8 * TSTR);
    return (bf16x8){lo[0], lo[1], lo[2], lo[3], hh[0], hh[1], hh[2], hh[3]};
}
__device__ __forceinline__ void chunk_kv_unit(LAS unsigned char* lds, const bf16_t* RET, bf16_t* ST, float lf, float lb, int bh, int c, int tid) {
    const int lane = tid & 63, wave = __builtin_amdgcn_readfirstlane(tid >> 6), b = bh >> 2, h = bh & 3;
    const int r0 = c < 2 ? ML + b * CTX + c * 128 : b * SEQ + (c - 2) * 128;
    LAS unsigned char* Kf = lds; LAS unsigned char* Kb = lds + 128 * TSTR; LAS unsigned char* Vt = lds + 2 * 128 * TSTR;
#pragma unroll
    for (int i = 0; i < 4; ++i) { const int ch = tid + i * 512, row = ch >> 4, cc = ch & 15;
        const g8::u32x4 kv = *(const g8::u32x4*)(RET + (size_t)(r0 + row) * 2048 + 512 + h * 128 + cc * 8), vv = *(const g8::u32x4*)(RET + (size_t)(r0 + row) * 2048 + 1024 + h * 128 + cc * 8);
        *(LAS g8::u32x4*)(Kf + row * TSTR + cc * 16) = scale8(kv, __builtin_amdgcn_exp2f(lf * (float)(127 - row)));
        *(LAS g8::u32x4*)(Kb + row * TSTR + cc * 16) = scale8(kv, __builtin_amdgcn_exp2f(lb * (float)row));
        *(LAS g8::u32x4*)(Vt + row * TSTR + cc * 16) = vv; }
    RT_BAR();
    const int dir = wave >> 2, db = wave & 3; const LAS unsigned char* Kt = dir ? Kb : Kf;
    f32x16 acc[4] = {};
#pragma unroll
    for (int s = 0; s < 8; ++s) { const bf16x8 a = tr_frag(Kt, 16 * s, db, lane);
#pragma unroll
        for (int vb = 0; vb < 4; ++vb) acc[vb] = __builtin_amdgcn_mfma_f32_32x32x16_bf16(a, tr_frag(Vt, 16 * s, vb, lane), acc[vb], 0, 0, 0); }
    bf16_t* dst = slot_ptr(ST, dir, bh, c) + (lane & 31);
#pragma unroll
    for (int vb = 0; vb < 4; ++vb)
#pragma unroll
        for (int r = 0; r < 16; ++r) dst[(size_t)(32 * db + crow(r, lane >> 5)) * 128 + vb * 32] = (bf16_t)f2bf(acc[vb][r]);
    RT_BAR();
}
__device__ __forceinline__ void scan_states(bf16_t* ST, const float* decf, const float* decb, int l, int gtid, int gsize) {
    for (int v = gtid; v < 2 * 16 * 2048; v += gsize) {
        const int dir = v >> 15, bh = (v >> 11) & 15, e = v & 2047, h = bh & 3;
        const float cdec = __builtin_amdgcn_exp2f(128.0f * log2_decay(dir ? decb : decf, l, h));
        g8::u32x4* base = (g8::u32x4*)slot_ptr(ST, dir, bh, 0) + e;
        g8::f32x4 s0, s1, a0, a1, b0, b1;
        g8::unpack8(base[0], a0, a1); g8::unpack8(base[2048], b0, b1);
        if (dir == 0) { s0 = a0 * cdec + b0; s1 = a1 * cdec + b1; } else { s0 = a0 + b0 * cdec; s1 = a1 + b1 * cdec; }
#pragma unroll 16
        for (int n = 0; n < 64; ++n) { g8::u32x4* p = base + (size_t)(2 + (dir ? 63 - n : n)) * 2048; g8::f32x4 k0, k1; g8::unpack8(*p, k0, k1);
            *p = g8::pack8(s0, s1); s0 = s0 * cdec + k0; s1 = s1 * cdec + k1; }
    }
}
__device__ __forceinline__ void chunk_out_unit(LAS unsigned char* lds, bf16_t* RET, const bf16_t* ST, const float* gng, const float* gnb, float lf, float lb, int bh, int c, int tid, bool dry = false) {
    const int lane = tid & 63, wave = __builtin_amdgcn_readfirstlane(tid >> 6), r32 = lane & 31, hi = lane >> 5, b = bh >> 2, h = bh & 3;
    const int r0 = c < 2 ? ML + b * CTX + c * 128 : b * SEQ + (c - 2) * 128;
    const int qb = wave & 3, dvh = wave >> 2;
    LAS unsigned char* Kt = lds; LAS unsigned char* Vt = lds + 128 * KSTR2; LAS unsigned char* St = Vt + 128 * TSTR;
    const bool has_f = (c != 0), has_b = (c != 1);
    const bf16_t* sf = slot_ptr((bf16_t*)ST, 0, bh, c == 1 ? 0 : c); const bf16_t* sb = slot_ptr((bf16_t*)ST, 1, bh, c == 0 ? 1 : c);
#pragma unroll
    for (int i = 0; i < 4; ++i) { const int ch = tid + i * 512, row = ch >> 4, cc = ch & 15;
        *(LAS g8::u32x4*)(Kt + row * KSTR2 + cc * 16) = *(const g8::u32x4*)(RET + (size_t)(r0 + row) * 2048 + 512 + h * 128 + cc * 8);
        *(LAS g8::u32x4*)(Vt + row * TSTR + cc * 16) = *(const g8::u32x4*)(RET + (size_t)(r0 + row) * 2048 + 1024 + h * 128 + cc * 8);
        if (has_f) *(LAS g8::u32x4*)(St + row * TSTR + cc * 16) = *(const g8::u32x4*)(sf + (size_t)row * 128 + cc * 8); }
    g8::u32x4 sbr[4];
    if (has_b) {
#pragma unroll
        for (int i = 0; i < 4; ++i) { const int ch = tid + i * 512, row = ch >> 4, cc = ch & 15; sbr[i] = *(const g8::u32x4*)(sb + (size_t)row * 128 + cc * 8); } }
    bf16x8 qf[8];
    { const bf16_t* qp = RET + (size_t)(r0 + qb * 32 + r32) * 2048 + h * 128 + hi * 8;
#pragma unroll
      for (int d0 = 0; d0 < 8; ++d0) qf[d0] = *(const bf16x8*)(qp + d0 * 16); }
    RT_BAR();
    f32x16 o[2] = {}, af[2] = {}, ab[2] = {};
    const int iq = qb * 32 + r32;
#pragma unroll
    for (int kt = 0; kt < 2; ++kt) {
        f32x16 p0 = {}, p1 = {};
#pragma unroll
        for (int d0 = 0; d0 < 8; ++d0) {
            const bf16x8 a0 = *(const LAS bf16x8*)(Kt + (64 * kt + r32) * KSTR2 + d0 * 32 + hi * 16), a1 = *(const LAS bf16x8*)(Kt + (64 * kt + 32 + r32) * KSTR2 + d0 * 32 + hi * 16);
            p0 = __builtin_amdgcn_mfma_f32_32x32x16_bf16(a0, qf[d0], p0, 0, 0, 0);
            p1 = __builtin_amdgcn_mfma_f32_32x32x16_bf16(a1, qf[d0], p1, 0, 0, 0);
        }
#pragma unroll
        for (int r = 0; r < 16; ++r) { const int j0 = 64 * kt + crow(r, hi), d0_ = iq - j0, d1_ = d0_ - 32;
            p0[r] *= __builtin_amdgcn_exp2f(d0_ >= 0 ? lf * (float)d0_ : lb * (float)(-d0_));
            p1[r] *= __builtin_amdgcn_exp2f(d1_ >= 0 ? lf * (float)d1_ : lb * (float)(-d1_)); }
        bf16x8 pa[4];
#pragma unroll
        for (int ks = 0; ks < 4; ++ks) { unsigned w[4];
#pragma unroll
            for (int j = 0; j < 4; ++j) { const int r = 8 * (ks & 1) + 2 * j; w[j] = (ks < 2) ? g8::cvtpk(p0[r], p0[r + 1]) : g8::cvtpk(p1[r], p1[r + 1]); }
            pa[ks] = __builtin_bit_cast(bf16x8, (g8::u32x4){w[0], w[1], w[2], w[3]}); }
#pragma unroll
        for (int ks = 0; ks < 4; ++ks)
#pragma unroll
            for (int d0 = 0; d0 < 2; ++d0) o[d0] = __builtin_amdgcn_mfma_f32_32x32x16_bf16(pa[ks], tr_frag_perm(Vt, 64 * kt + 16 * ks, dvh * 2 + d0, lane), o[d0], 0, 0, 0);
    }
    if (has_f) {
#pragma unroll
        for (int s = 0; s < 8; ++s)
#pragma unroll
            for (int d0 = 0; d0 < 2; ++d0) af[d0] = __builtin_amdgcn_mfma_f32_32x32x16_bf16(qf[s], tr_frag(St, 16 * s, dvh * 2 + d0, lane), af[d0], 0, 0, 0);
    }
    RT_BAR();
    if (has_b) {
#pragma unroll
        for (int i = 0; i < 4; ++i) { const int ch = tid + i * 512, row = ch >> 4, cc = ch & 15;
            *(LAS g8::u32x4*)(St + row * TSTR + cc * 16) = sbr[i]; }
    }
    RT_BAR();
    if (has_b) {
#pragma unroll
        for (int s = 0; s < 8; ++s)
#pragma unroll
            for (int d0 = 0; d0 < 2; ++d0) ab[d0] = __builtin_amdgcn_mfma_f32_32x32x16_bf16(qf[s], tr_frag(St, 16 * s, dvh * 2 + d0, lane), ab[d0], 0, 0, 0);
    }
    LAS float* Ot = (LAS float*)lds;
#pragma unroll
    for (int r = 0; r < 16; ++r) { const int i = qb * 32 + crow(r, hi); const float qdf = __builtin_amdgcn_exp2f(lf * (float)(i + 1)), qdb = __builtin_amdgcn_exp2f(lb * (float)(128 - i));
#pragma unroll
        for (int d0 = 0; d0 < 2; ++d0) Ot[i * 132 + dvh * 64 + d0 * 32 + r32] = o[d0][r] + qdf * af[d0][r] + qdb * ab[d0][r]; }
    RT_BAR();
    { const int row = tid >> 2, qt = tid & 3; const LAS float* op = Ot + row * 132 + qt * 32; float v[32]; float s = 0.f;
#pragma unroll
      for (int j = 0; j < 32; ++j) { v[j] = op[j]; s += v[j]; }
      s += dppx<0xB1>(s); s += dppx<0x4E>(s); const float mu = s * (1.0f / 128.f); float q = 0.f;
#pragma unroll
      for (int j = 0; j < 32; ++j) { v[j] -= mu; q += v[j] * v[j]; }
      q += dppx<0xB1>(q); q += dppx<0x4E>(q); const float rstd = 1.0f / sqrtf(q * (1.0f / 128.f) + EPS);
      bf16_t* rowp = RET + (size_t)(r0 + row) * 2048 + h * 128 + qt * 32; const float* gg = gng + h * 128 + qt * 32; const float* gb = gnb + h * 128 + qt * 32;
#pragma unroll
      for (int j8 = 0; j8 < 4; ++j8) { g8::f32x4 g0, g1; g8::unpack8(*(const g8::u32x4*)(rowp + 1536 + j8 * 8), g0, g1); g8::f32x4 y0, y1;
#pragma unroll
          for (int j = 0; j < 4; ++j) { const float ga = g0[j], gb_ = g1[j];
              y0[j] = ga * g8::fsigmoid(ga) * (v[j8 * 8 + j] * rstd * gg[j8 * 8 + j] + gb[j8 * 8 + j]);
              y1[j] = gb_ * g8::fsigmoid(gb_) * (v[j8 * 8 + 4 + j] * rstd * gg[j8 * 8 + 4 + j] + gb[j8 * 8 + 4 + j]); }
          if (!dry) *(g8::u32x4*)(rowp + j8 * 8) = g8::pack8(y0, y1); } }
    RT_BAR();
}
__device__ __forceinline__ void gmlp_unit(LAS unsigned char* lds, bf16_t* UV, const float* ws, const float* bs, const float* PARTV, const float* lng, const float* lnb, int cidx, int g, int tid, bool dry = false) {
    const int lane = tid & 63, wave = __builtin_amdgcn_readfirstlane(tid >> 6), r32 = lane & 31, hi = lane >> 5, r0 = cidx * 128;
    LAS unsigned char* Wt = lds; LAS unsigned char* Vt = lds + 128 * KSTR2;
    LAS float* st = (LAS float*)(lds + 128 * KSTR2 + 128 * TSTR);
    if (tid < 128) { const float* pp = PARTV + (size_t)(r0 + tid) * 32; float s1 = 0.f, s2 = 0.f;
#pragma unroll
        for (int q = 0; q < 8; ++q) { const g8::f32x4 a = *(const g8::f32x4*)(pp + 4 * q); s1 += a[0] + a[2]; s2 += a[1] + a[3]; }
        const float mu = s1 * (1.0f / 512.f), var = s2 * (1.0f / 512.f) - mu * mu; st[tid * 2] = mu; st[tid * 2 + 1] = 1.0f / sqrtf((var > 0.f ? var : 0.f) + EPS); }
#pragma unroll
    for (int i = 0; i < 4; ++i) { const int ch = tid + i * 512, row = ch >> 4, cc = ch & 15;
        const g8::f32x4 w0 = *(const g8::f32x4*)(ws + row * 128 + cc * 8), w1 = *(const g8::f32x4*)(ws + row * 128 + cc * 8 + 4);
        *(LAS g8::u32x4*)(Wt + row * KSTR2 + cc * 16) = g8::pack8(w0, w1); }
    g8::u32x4 vraw[4];
#pragma unroll
    for (int i = 0; i < 4; ++i) { const int ch = tid + i * 512, row = ch >> 4, cc = ch & 15; vraw[i] = *(const g8::u32x4*)(UV + (size_t)(r0 + row) * 1024 + 512 + g * 128 + cc * 8); }
    RT_BAR();
#pragma unroll
    for (int i = 0; i < 4; ++i) { const int ch = tid + i * 512, row = ch >> 4, cc = ch & 15; g8::f32x4 x0, x1;
        g8::unpack8(vraw[i], x0, x1);
        const float mu = st[row * 2], rstd = st[row * 2 + 1]; const float* gg = lng + g * 128 + cc * 8; const float* gb = lnb + g * 128 + cc * 8;
        const g8::f32x4 g0 = *(const g8::f32x4*)gg, g1 = *(const g8::f32x4*)(gg + 4), b0 = *(const g8::f32x4*)gb, b1 = *(const g8::f32x4*)(gb + 4);
        *(LAS g8::u32x4*)(Vt + row * TSTR + cc * 16) = g8::pack8((x0 - mu) * rstd * g0 + b0, (x1 - mu) * rstd * g1 + b1); }
    RT_BAR();
    const int ib = wave & 3, cb0 = (wave >> 2) * 2;
    f32x16 acc[2] = {};
#pragma unroll
    for (int s = 0; s < 8; ++s) { const bf16x8 a = *(const LAS bf16x8*)(Wt + (32 * ib + r32) * KSTR2 + s * 32 + hi * 16);
#pragma unroll
        for (int d0 = 0; d0 < 2; ++d0) acc[d0] = __builtin_amdgcn_mfma_f32_32x32x16_bf16(a, tr_frag(Vt, 16 * s, cb0 + d0, lane), acc[d0], 0, 0, 0); }
#pragma unroll
    for (int r = 0; r < 16; ++r) { const int i = 32 * ib + crow(r, hi); const float bi = bs[i];
#pragma unroll
        for (int d0 = 0; d0 < 2; ++d0) { bf16_t* up = UV + (size_t)(r0 + i) * 1024 + g * 128 + (cb0 + d0) * 32 + r32; const bf16_t nv = (bf16_t)f2bf(bf2f(*up) * (acc[d0][r] + bi)); if (!dry) *up = nv; } }
    RT_BAR();
}
#undef RT_BAR
}

__device__ __forceinline__ float grp_sum(float v, int width) {
#pragma unroll
    for (int o = 1; o < 64; o <<= 1) if (o < width) v += __shfl_xor(v, o);
    return v;
}
__device__ __forceinline__ void p_rowpass_a_vec(Frame& F, int l) {
    const int gw = F.bid * NWAVES + F.wave, NGW = F.G * NWAVES, lane = F.lane;
    const float* qag = FIN(I_QAG) + l * 384; const float* kvag = FIN(I_KVAG) + l * 256; const float* krg = FIN(I_KRG) + l * 32;
    const float* lng = FIN(I_LNG) + l * 512; const float* lnb = FIN(I_LNB) + l * 512;
    for (int r = gw; r < M; r += NGW) {
        g8::u32x4* pq = (g8::u32x4*)(F_CQ + (size_t)r * 384) + lane; g8::u32x4* pk = (g8::u32x4*)(F_CKV + (size_t)r * 256) + lane;
        g8::u32x4* pr = (g8::u32x4*)(F_KR + (size_t)r * 32) + lane; g8::u32x4* pv = (g8::u32x4*)(F_UV + (size_t)r * 1024 + 512) + lane;
        g8::u32x4 wq = {0u, 0u, 0u, 0u}, wk = wq, wr = wq; if (lane < 48) wq = *pq; if (lane < 32) wk = *pk; if (lane < 4) wr = *pr; const g8::u32x4 wv = *pv;
        g8::f32x4 q0, q1, k0, k1, r0, r1, v0, v1; g8::unpack8(wq, q0, q1); g8::unpack8(wk, k0, k1); g8::unpack8(wr, r0, r1); g8::unpack8(wv, v0, v1);
        const float rsq = 1.0f / sqrtf(wave_sum(sumsq8(q0, q1)) * (1.0f / 384.f) + EPS), rsk = 1.0f / sqrtf(wave_sum(sumsq8(k0, k1)) * (1.0f / 256.f) + EPS);
        const float rsr = 1.0f / sqrtf(wave_sum(sumsq8(r0, r1)) * (1.0f / 32.f) + EPS);
        const float mu = wave_sum((v0[0] + v0[1]) + (v0[2] + v0[3]) + (v1[0] + v1[1]) + (v1[2] + v1[3])) * (1.0f / 512.f);
        v0 = v0 - mu; v1 = v1 - mu; const float rsv = 1.0f / sqrtf(wave_sum(sumsq8(v0, v1)) * (1.0f / 512.f) + EPS);
        if (lane < 48) { const g8::f32x4 g0 = *(const g8::f32x4*)(qag + lane * 8), g1 = *(const g8::f32x4*)(qag + lane * 8 + 4); *pq = g8::pack8(q0 * rsq * g0, q1 * rsq * g1); }
        if (lane < 32) { const g8::f32x4 g0 = *(const g8::f32x4*)(kvag + lane * 8), g1 = *(const g8::f32x4*)(kvag + lane * 8 + 4); *pk = g8::pack8(k0 * rsk * g0, k1 * rsk * g1); }
        { const int vi = lane & 3; const g8::f32x4 g0 = *(const g8::f32x4*)(krg + vi * 8), g1 = *(const g8::f32x4*)(krg + vi * 8 + 4);
          g8::f32x4 y0 = r0 * rsr * g0, y1 = r1 * rsr * g1, p0, p1;
#pragma unroll
          for (int i = 0; i < 4; ++i) { p0[i] = dppx<0xB1>(y0[i]); p1[i] = dppx<0xB1>(y1[i]); }
          if (r < ML) rope8(y0, y1, p0, p1, F_ROPE + (size_t)(r & (SEQ - 1)) * 32, vi);
          if (lane < 4) *pr = g8::pack8(y0, y1); }
        { const g8::f32x4 g0 = *(const g8::f32x4*)(lng + lane * 8), g1 = *(const g8::f32x4*)(lng + lane * 8 + 4), b0 = *(const g8::f32x4*)(lnb + lane * 8), b1 = *(const g8::f32x4*)(lnb + lane * 8 + 4);
          *pv = g8::pack8(v0 * rsv * g0 + b0, v1 * rsv * g1 + b1); }
    }
}
__device__ __forceinline__ void p_rowpass_b_vec(Frame& F, int l) {
    const int gw = F.bid * NWAVES + F.wave, NGW = F.G * NWAVES, lane = F.lane, grp = lane >> 4, i = lane & 15;
    const float* qng = FIN(I_QNG) + l * 96; const float* kng = FIN(I_KNG) + l * 64;
    g8::f32x4 gq0 = {0.f, 0.f, 0.f, 0.f}, gq1 = gq0, gk0 = gq0, gk1 = gq0;
    if (i < 12) { gq0 = *(const g8::f32x4*)(qng + i * 8); gq1 = *(const g8::f32x4*)(qng + i * 8 + 4); }
    if (i < 8) { gk0 = *(const g8::f32x4*)(kng + i * 8); gk1 = *(const g8::f32x4*)(kng + i * 8 + 4); }
    for (int r = gw; r < M; r += NGW) {
        const float* tab = F_ROPE + (size_t)(r & (SEQ - 1)) * 32;
#pragma unroll
        for (int it = 0; it < 2; ++it) { const int h = it * 4 + grp;
            g8::u32x4* qp = (g8::u32x4*)(F_Q + (size_t)r * 768 + h * 96) + i;
            g8::u32x4 wq = {0u, 0u, 0u, 0u}; if (i < 12) wq = *qp;
            const g8::u32x4 wkv = *((const g8::u32x4*)(F_KVR + (size_t)r * 1024 + h * 128) + i);
            g8::u32x4 wkr = {0u, 0u, 0u, 0u}; if (i >= 8 && i < 12) wkr = *((const g8::u32x4*)(F_KR + (size_t)r * 32) + (i - 8));
            g8::f32x4 q0, q1, k0, k1; g8::unpack8(wq, q0, q1); g8::unpack8(wkv, k0, k1);
            const float rq = 1.0f / sqrtf(row16_sum(sumsq8(q0, q1)) * (1.0f / 96.f) + EPS);
            const float rk = 1.0f / sqrtf(row16_sum(i < 8 ? sumsq8(k0, k1) : 0.f) * (1.0f / 64.f) + EPS);
            g8::f32x4 y0 = q0 * rq * gq0, y1 = q1 * rq * gq1, p0, p1;
#pragma unroll
            for (int j = 0; j < 4; ++j) { p0[j] = dppx<0xB1>(y0[j]); p1[j] = dppx<0xB1>(y1[j]); }
            if (r < ML && i >= 8 && i < 12) rope8(y0, y1, p0, p1, tab, i - 8);
            if (i < 12) *qp = g8::pack8(y0 * QSCALE, y1 * QSCALE);
            g8::u32x4* kp = (g8::u32x4*)(F_K + (size_t)r * 768 + h * 96) + i;
            if (i < 8) *kp = g8::pack8(k0 * rk * gk0, k1 * rk * gk1);
            else if (i < 12) *kp = wkr;
            if (i >= 8) *((g8::u32x4*)(F_V + (size_t)r * 512 + h * 64) + (i - 8)) = wkv;
        }
    }
}

constexpr int LDS_TT = 131072;
__device__ __forceinline__ const char* smw(const Frame& F, int l, size_t off) { return (const char*)(ws_(F.A) + WS_WSM + (size_t)l * SMW_L + off); }
__device__ __forceinline__ void p_router_fast(Frame& F, int l, int ntok) {
    using at::bf16x8; using at::f32x16; using at::crow;
    LAS int* hist = (LAS int*)((LAS unsigned char*)F.lds);
    const int lane = F.lane, r32 = lane & 31, hi = lane >> 5;
    __syncthreads();
    if (F.tid < 64) hist[F.tid] = 0;
    __syncthreads();
    const bf16_t* Rh = (const bf16_t*)smw(F, l, SMW_RT); const bf16_t* Rl = Rh + 64 * 1024;
    const float* bias = FIN(I_MBIAS) + l * NEXP;
    LAS float* part = (LAS float*)((LAS unsigned char*)F.lds + 1024);
    LAS unsigned char* wb = (LAS unsigned char*)F.lds + 36864;
    constexpr int WBUF = 128 * 272;
    const int pair = F.wave & 3, half = F.wave >> 2, ntask = (ntok + 31) >> 5;
    const bf16_t* wsrc = Rh + (size_t)(F.tid >> 4) * 1024 + (F.tid & 15) * 8;
    const unsigned wdst = (unsigned)(F.tid >> 4) * 272u + (unsigned)(F.tid & 15) * 16u;
    for (int it = 0; (it * F.G) * 4 < ntask; ++it) {
        const int w = (it * F.G + F.bid) * 4 + pair; const bool live = w < ntask;
        const int tok = (live ? w : 0) * 32 + r32;
        const bf16_t* hp = F_H + (size_t)tok * D + hi * 8 + half * 64;
        g8::u32x4 wr[4]; bf16x8 hq[4], hn[4];
#pragma unroll
        for (int i = 0; i < 4; ++i) wr[i] = *(const g8::u32x4*)(wsrc + (size_t)i * 32 * 1024);
#pragma unroll
        for (int s2 = 0; s2 < 4; ++s2) hq[s2] = *(const bf16x8*)(hp + s2 * 16);
        __syncthreads();
#pragma unroll
        for (int i = 0; i < 4; ++i) *(LAS g8::u32x4*)(wb + wdst + i * 32 * 272) = wr[i];
        __syncthreads();
        f32x16 acc0 = {}, acc1 = {};
        for (int c = 0; c < 8; ++c) {
            const LAS unsigned char* ap = wb + (c & 1) * WBUF + r32 * 272 + (half * 64 + hi * 8) * 2;
            if (c + 1 < 8) {
#pragma unroll
                for (int i = 0; i < 4; ++i) wr[i] = *(const g8::u32x4*)(wsrc + (c + 1) * 128 + (size_t)i * 32 * 1024);
#pragma unroll
                for (int s2 = 0; s2 < 4; ++s2) hn[s2] = *(const bf16x8*)(hp + (c + 1) * 128 + s2 * 16); }
#pragma unroll
            for (int s2 = 0; s2 < 4; ++s2) {
                acc0 = __builtin_amdgcn_mfma_f32_32x32x16_bf16(*(const LAS bf16x8*)(ap + s2 * 32), hq[s2], acc0, 0, 0, 0);
                acc1 = __builtin_amdgcn_mfma_f32_32x32x16_bf16(*(const LAS bf16x8*)(ap + 32 * 272 + s2 * 32), hq[s2], acc1, 0, 0, 0);
                acc0 = __builtin_amdgcn_mfma_f32_32x32x16_bf16(*(const LAS bf16x8*)(ap + 64 * 272 + s2 * 32), hq[s2], acc0, 0, 0, 0);
                acc1 = __builtin_amdgcn_mfma_f32_32x32x16_bf16(*(const LAS bf16x8*)(ap + 96 * 272 + s2 * 32), hq[s2], acc1, 0, 0, 0); }
            if (c + 1 < 8) {
#pragma unroll
                for (int i = 0; i < 4; ++i) *(LAS g8::u32x4*)(wb + ((c + 1) & 1) * WBUF + wdst + i * 32 * 272) = wr[i];
#pragma unroll
                for (int s2 = 0; s2 < 4; ++s2) hq[s2] = hn[s2]; }
            __syncthreads();
        }
        if (half == 1) {
#pragma unroll
            for (int r = 0; r < 16; ++r) { part[(pair * 32 + r) * 64 + lane] = acc0[r]; part[(pair * 32 + 16 + r) * 64 + lane] = acc1[r]; } }
        __syncthreads();
        if (half == 0) {
#pragma unroll
            for (int r = 0; r < 16; ++r) { acc0[r] += part[(pair * 32 + r) * 64 + lane]; acc1[r] += part[(pair * 32 + 16 + r) * 64 + lane]; } }
        __syncthreads();
        if (half == 1 || !live) continue;
        float sel[32];
#pragma unroll
        for (int r = 0; r < 16; ++r) { const int e0 = crow(r, hi), e1 = 32 + e0;
            sel[r] = 1.0f / (1.0f + expf(-acc0[r])) + bias[e0]; sel[16 + r] = 1.0f / (1.0f + expf(-acc1[r])) + bias[e1]; }
        float wk[TOPK]; int ek[TOPK]; float wsum = 0.f;
#pragma unroll
        for (int k = 0; k < TOPK; ++k) {
            float bv = -INFINITY; int bi = 0;
#pragma unroll
            for (int j = 0; j < 32; ++j) { const int e = (j >> 4) * 32 + crow(j & 15, hi); if (sel[j] > bv || (sel[j] == bv && e < bi)) { bv = sel[j]; bi = e; } }
            const float ov = xlane32(bv, lane); const int oi = xlane32i(bi, lane);
            if (ov > bv || (ov == bv && oi < bi)) { bv = ov; bi = oi; }
#pragma unroll
            for (int j = 0; j < 32; ++j) { const int e = (j >> 4) * 32 + crow(j & 15, hi); sel[j] = (e == bi) ? -INFINITY : sel[j]; }
            ek[k] = bi; wk[k] = bv - bias[bi]; wsum += wk[k];
        }
        if (hi == 0) {
            const float sc = 2.5f / wsum;
#pragma unroll
            for (int k = 0; k < TOPK; ++k) { F_IDX[tok * TOPK + k] = ek[k]; F_WTS[tok * TOPK + k] = wk[k] * sc; F_SLOT[tok * TOPK + k] = atomicAdd((int*)&hist[ek[k]], 1) | (F.bid << 20); }
        }
    }
    __syncthreads();
    if (F.tid < 64) F_BLKBASE[(l * 256 + F.bid) * 64 + F.tid] = (int)atomicAdd(F_ctl + CW_CNT + l * 64 + F.tid, (unsigned)hist[F.tid]);
    for (int i = F.bid * NTHR + F.tid; i < APAD; i += F.G * NTHR) F_ROWTOK[i] = 0;
}

__device__ __forceinline__ void p_inproj_fast(Frame& F, int l) {
    SchedInproj S{(const char*)F_H, smw(F, l, SMW_WIN), F.G, F.bid}; EpiInproj E{F_RET, F_CQ, F_CKV, F_KR, F_UV, FWS(float, WS_PART), FWS(float, WS_PARTV), FIN(I_KRG) + l * 32, F_ROPE};
    g8::gemm_phase<false>((LAS unsigned char*)F.lds, S, E, F.tid);
}
__device__ __forceinline__ void p_mlaup_fast(Frame& F, int l) {
    SchedMlaUp S{(const char*)F_CQ, (const char*)F_CKV, smw(F, l, SMW_WUQ), smw(F, l, SMW_WUKV), F.G, F.bid}; EpiMlaFused E{F_Q, F_K, F_V, F_KR, FIN(I_QNG) + l * 96, FIN(I_KNG) + l * 64, F_ROPE, FWS(float, WS_PART), (LAS float*)((LAS unsigned char*)F.lds + LDS_TT)};
    g8::gemm_phase<false>((LAS unsigned char*)F.lds, S, E, F.tid);
}
template <int BR> __device__ __forceinline__ void p_merge_br(Frame& F, int l, int nrows) {
    const char* abr = BR == 0 ? (const char*)F_RET : (BR == 1 ? (const char*)F_AO : (const char*)F_UV);
    SchedMerge S{(const char*)F_H, smw(F, l, SMW_WG) + (size_t)BR * 1024 * 2048, abr, smw(F, l, SMW_WBR) + (size_t)BR * 1024 * 1024, BR == 0 ? 4096u : (BR == 1 ? 1024u : 2048u), F.G, F.bid, nrows / 256};
    EpiMerge<BR> E{F_Y, (u32x4*)(ws_(F.A) + WS_SCR + (size_t)F.bid * 131072)};
    g8::gemm_phase<false>((LAS unsigned char*)F.lds, S, E, F.tid);
}
__device__ __forceinline__ void p_merge_fast(Frame& F, int l, int nrows) {
    p_merge_br<0>(F, l, nrows); asm volatile("" : "+v"(F.tid));
    p_merge_br<1>(F, l, nrows); asm volatile("" : "+v"(F.tid));
    p_merge_br<2>(F, l, nrows);
}
__device__ __forceinline__ void p_out_fast(Frame& F, int l, int nrows) {
    SchedOut S{(const char*)F_Y, smw(F, l, SMW_WOUT), F.G, F.bid, nrows / 256};
    EpiResid E{FIN(I_X), FIN(I_CTX), F_X16, F_MOD + (size_t)l * 5 * 6144 + 2 * D, l};
    g8::gemm_phase<false>((LAS unsigned char*)F.lds, S, E, F.tid);
}
__device__ __forceinline__ void p_gateup_fast(Frame& F, int l, int ntok) {
    LAS int* tt = (LAS int*)((LAS unsigned char*)F.lds + LDS_TT); moe_tiles(F, l, tt);
    SchedGateUp S{(const char*)F_H, (const char*)(ws_(F.A) + WS_MOEW), smw(F, l, SMW_SHGU), F_ROWTOK, tt, F.G, F.bid, ntok / 256}; EpiGateUp E{F_HB, F_HBS};
    g8::gemm_phase<true>((LAS unsigned char*)F.lds, S, E, F.tid);
}
__device__ __forceinline__ void p_down_fast(Frame& F, int l, int ntok, bool routed_only = false) {
    LAS int* tt = (LAS int*)((LAS unsigned char*)F.lds + LDS_TT); moe_tiles(F, l, tt);
    SchedDown S{(const char*)F_HB, (const char*)F_HBS, (const char*)(ws_(F.A) + WS_MOEW), smw(F, l, SMW_SHD), tt, F.G, F.bid, routed_only ? 0 : ntok / 256};
    EpiDown E{(unsigned char*)F_OUT, FWS(bf16_t, WS_SCR)};
    g8::gemm_phase<false>((LAS unsigned char*)F.lds, S, E, F.tid);
}
#ifndef FAST_INPROJ
#define FAST_INPROJ 1
#endif
#ifndef FAST_MLAUP
#define FAST_MLAUP 1
#endif
#ifndef FAST_MERGE
#define FAST_MERGE 1
#endif
#ifndef FAST_OUT
#define FAST_OUT 1
#endif
#ifndef FAST_MOE
#define FAST_MOE 1
#endif
#ifndef FAST_ATTN
#define FAST_ATTN 1
#endif
#ifndef FAST_RET
#define FAST_RET 1
#endif
#ifndef FAST_ROWPASS
#define FAST_ROWPASS 1
#endif

constexpr int NPL = 14;
constexpr int NPH = 1 + DEPTH * NPL;
#define REFRESH() do { int ln_; asm volatile("v_mbcnt_lo_u32_b32 %0, -1, 0\n\tv_mbcnt_hi_u32_b32 %0, -1, %0" : "=v"(ln_)); F.lane = ln_; F.tid = F.wave * 64 + ln_; } while (0)
#define IN(k) (lo <= (k) && (k) < hi)
#ifdef PROBE_A
#define STAMP(k) do { if (F.bid == 0 && F.tid == 0) ((unsigned long long*)(ws_(F.A) + WS_CTL + 262144))[(k)] = __builtin_amdgcn_s_memrealtime(); } while (0)
#else
#define STAMP(k) do {} while (0)
#endif
#ifndef REP_BAR
#define REP_BAR 1
#endif
#define SEAM(k) do { if (lo <= (k) && (k) + 1 < hi) { for (int rb_ = 0; rb_ < REP_BAR; ++rb_) xcd_barrier(bar, F.tid); } STAMP((k) + 1); REFRESH(); } while (0)


template <int L> __device__ __forceinline__ void layer_body(Frame& F, int& lo, int& hi, const XcdBarrier& bar) {
    constexpr int l = L;
    {
        asm volatile("" : "+s"(lo), "+s"(hi));
        const int pb = 1 + l * NPL;
        const int nrows_mix = (l == 0) ? M : ML;
        if (l == 0) { if (IN(pb + 0)) { p_norm(F, l, 0, M); } SEAM(pb + 0); }
        if (IN(pb + 1)) { for (int rep = 0; rep < REP_INPROJ; ++rep) { if (FAST_INPROJ) p_inproj_fast(F, l); else p_inproj_naive(F, l); asm volatile("" : "+v"(F.tid)); } } SEAM(pb + 1);
        if (IN(pb + 2)) {
#if FAST_RET
            REFRESH();
            { const float* decf = FIN(I_DECF); const float* decb = FIN(I_DECB);
              for (int rep = 0; rep < REP_R1; ++rep)
              for (int u = F.bid; u < 16 * 66; u += F.G) { const int bh = u / 66, c = u % 66;
                  rt::chunk_kv_unit((LAS unsigned char*)F.lds, F_RET, F_ST, rt::log2_decay(decf, l, bh & 3), rt::log2_decay(decb, l, bh & 3), bh, c, F.tid); } }
#endif
        } SEAM(pb + 2);
        if (IN(pb + 3)) {
#if FAST_RET
            if (F.tid < 256) rt::scan_states(F_ST, FIN(I_DECF), FIN(I_DECB), l, F.bid * 256 + F.tid, F.G * 256);
            __syncthreads();
            REFRESH();
#endif
            for (int rep = 0; rep < REP_MLAUP; ++rep) { if (FAST_MLAUP) p_mlaup_fast(F, l); else p_mlaup_naive(F, l); asm volatile("" : "+v"(F.tid)); } } SEAM(pb + 3);
        STAMP(pb + 5);
        if (IN(pb + 5)) {
#if FAST_ATTN
            {
                const int vcu = (F.G % 8 == 0) ? (F.bid % 8) * (F.G / 8) + F.bid / 8 : F.bid;
                for (int rep = 0; rep < REP_ATTN; ++rep)
                for (int u = vcu; u < NB * 8 * 16; u += F.G) {
                    const int bh = u >> 4, qb = u & 15, b = bh >> 3, h = bh & 7;
                    at16::attn_unit64((LAS unsigned char*)F.lds, F_Q, F_K, F_V, F_AO, h, b * SEQ + qb * 512, ML + b * CTX, CTX / at::KT, b * SEQ, SEQ / at::KT, F.tid); }
                if (l == 0 && F.bid < NB * 8) { const int b = F.bid >> 3, h = F.bid & 7;
                    ATTN_NS::attn_unit((LAS unsigned char*)F.lds, F_Q, F_K, F_V, F_AO, h, ML + b * CTX, ML + b * CTX, CTX / at::KT, 0, 0, F.tid); }
            }
#else
            const int nu_att = NB * 8 * 256 + (l == 0 ? NB * 8 * 8 : 0);
            for (int u = F.bid; u < nu_att; u += F.G) {
                if (u < NB * 8 * 256) { const int qt = u & 255, h = (u >> 8) & 7, b = u >> 11; attn_unit_naive(F, h, b * SEQ + qt * 32, ML + b * CTX, CTX, b * SEQ, SEQ); }
                else { const int v = u - NB * 8 * 256; const int qt = v & 7, h = (v >> 3) & 7, b = v >> 6; attn_unit_naive(F, h, ML + b * CTX + qt * 32, ML + b * CTX, CTX, 0, 0); }
            }
#endif
#if FAST_RET
            REFRESH();
            { const float* decf = FIN(I_DECF); const float* decb = FIN(I_DECB); const float* gng = FIN(I_GNG) + l * 512; const float* gnb = FIN(I_GNB) + l * 512;
              const int ncr = (l == 0) ? 66 : 64, c0r = (l == 0) ? 0 : 2;
              for (int rep = REP_R3 - 1; rep >= 0; --rep)
              for (int u = (F.bid + F.G - 32) % F.G; u < 16 * ncr; u += F.G) { const int bh = u / ncr, c = c0r + u % ncr;
                  rt::chunk_out_unit((LAS unsigned char*)F.lds, F_RET, F_ST, gng, gnb, rt::log2_decay(decf, l, bh & 3), rt::log2_decay(decb, l, bh & 3), bh, c, F.tid, rep > 0); }
              REFRESH();
              const int nch = nrows_mix / 128;
              for (int rep = REP_GMLP - 1; rep >= 0; --rep)
              for (int u = (F.bid + F.G - 64) % F.G; u < nch * 4; u += F.G) { const int g = u & 3; rt::gmlp_unit((LAS unsigned char*)F.lds, F_UV, FIN(I_GWS) + ((size_t)l * 4 + g) * 128 * 128, FIN(I_GBS) + (l * 4 + g) * 128, FWS(float, WS_PARTV), FIN(I_LNG) + l * 512, FIN(I_LNB) + l * 512, u >> 2, g, F.tid, rep > 0); } }
#else
            const int nu_ret = NB * 4 * 256 + (l == 0 ? NB * 4 * 8 : 0);
            for (int u = F.bid; u < nu_ret; u += F.G) {
                if (u < NB * 4 * 256) { const int qt = u & 255, h = (u >> 8) & 3, b = u >> 10; ret_unit_naive(F, l, b, h, qt * 32, false); }
                else { const int v = u - NB * 4 * 256; const int qt = v & 7, h = (v >> 3) & 3, b = v >> 5; ret_unit_naive(F, l, b, h, qt * 32, true); }
            }
            const int nch = nrows_mix / 128;
            for (int u = F.bid; u < nch * 4; u += F.G) gmlp_unit_naive(F, l, u >> 2, u & 3);
#endif
        } SEAM(pb + 5);
        if (IN(pb + 6)) { for (int rep = 0; rep < REP_MERGE; ++rep) { if (FAST_MERGE) p_merge_fast(F, l, nrows_mix); else p_merge_naive(F, l, nrows_mix); asm volatile("" : "+v"(F.tid)); } } SEAM(pb + 6);
        if (IN(pb + 7)) { if (FAST_OUT) p_out_fast(F, l, nrows_mix); else p_out_naive(F, l, nrows_mix); REFRESH(); if (FAST_MOE) for (int rep = 0; rep < REP_CVTMOE; ++rep) p_cvt_moe(F, l); } SEAM(pb + 7);
        if (IN(pb + 8)) { for (int rep = 0; rep < REP_NORM2; ++rep) { p_norm2(F, l, nrows_mix); asm volatile("" : "+v"(F.tid)); } } SEAM(pb + 8);
        if (IN(pb + 9)) { for (int rep = 0; rep < REP_ROUTER; ++rep) { if (FAST_ROUTER) p_router_fast(F, l, nrows_mix); else p_router(F, l, nrows_mix); asm volatile("" : "+v"(F.tid)); __syncthreads(); } } SEAM(pb + 9);
        if (IN(pb + 10)) { p_scatter(F, l, nrows_mix); } SEAM(pb + 10);
        if (IN(pb + 11)) { for (int rep = 0; rep < REP_GATEUP; ++rep) { if (FAST_MOE) p_gateup_fast(F, l, nrows_mix); else p_moe_gateup_naive(F, l, nrows_mix); asm volatile("" : "+v"(F.tid)); } } SEAM(pb + 11);
        if (IN(pb + 12)) { for (int rep = REP_DOWN1 - 1; rep >= 0; --rep) { p_down_fast(F, l, nrows_mix, rep > 0); asm volatile("" : "+v"(F.tid)); } } SEAM(pb + 12);
        if (IN(pb + 13)) { if (l + 1 < DEPTH) p_combine<true>(F, l, nrows_mix); else p_combine<false>(F, l, nrows_mix); } SEAM(pb + 13);
    }
}

__global__ void __launch_bounds__(NTHR, 2) fwd_kernel(Args args) {
    extern __shared__ __attribute__((aligned(16))) unsigned char lds[];
    Frame F;
    F.lds = lds; F.tid = threadIdx.x; F.lane = F.tid & 63; F.wave = __builtin_amdgcn_readfirstlane(F.tid >> 6); F.G = gridDim.x; F.bid = blockIdx.x;
    F.A = &args;
    volatile LAS unsigned* MISC = (volatile LAS unsigned*)((LAS unsigned char*)lds + MISC_OFF);
    if (F.tid < 32) MISC[F.tid] = 0u;
    __syncthreads();
    int lo = args.ph_lo, hi = args.ph_hi;
    XcdBarrier bar; bar.bar = F_ctl + CW_BAR; bar.x = 0; bar.st = nullptr;
    if (hi - lo > 1) bar = xcd_barrier_post(F_ctl + CW_BAR, MISC + 8);
    STAMP(0);
    if (IN(0)) { for (int rep = 0; rep < REP_PRO; ++rep) { p_prologue(F); p_cvt_small(F); __syncthreads(); } } SEAM(0);
    static_assert(DEPTH == 2, "two explicit layer bodies");
    layer_body<0>(F, lo, hi, bar); layer_body<1>(F, lo, hi, bar);
#ifdef PROBE_A
    xcd_barrier(bar, F.tid);
    { const unsigned long long* ts = (const unsigned long long*)(ws_(F.A) + WS_CTL + 262144);
      float r = 1.0f; if (PROBE_A >= 0) { const float tus = (float)(ts[PROBE_A + 1] - ts[PROBE_A]) * 0.01f;
          const float q = exp2f(rintf(log2f(tus > 1.0f ? tus : 1.0f) * 3.1062837f) * (1.0f / 3.1062837f)); r = q / (float)(PROBE_TMAX); r = r > 1.0f ? 1.0f : r; }
      const float eps = 0.08f * r; float4* o = (float4*)F_out;
      for (int i = F.bid * NTHR + F.tid; i < ML * D / 4; i += F.G * NTHR) { float4 v = o[i]; v.x += eps; v.y += eps; v.z += eps; v.w += eps; o[i] = v; } }
#endif
#undef IN
#undef SEAM
}

#ifndef MK_PER_PHASE
#define MK_PER_PHASE 0
#endif
extern "C" void kernel_launch(void* const* d_in, const int* in_sizes, int n_in, void* d_out, int out_size, void* d_ws, size_t ws_size, hipStream_t stream) {
    static int grid = 0;
    if (grid == 0) {
        if (n_in != 36 || out_size != ML * D || ws_size < WS_END) { fprintf(stderr, "kernel_launch: unexpected problem (n_in %d out %d ws %zu)\n", n_in, out_size, ws_size); grid = -1; return; }
        int dev = 0, cus = 0;
        if (hipGetDevice(&dev) != hipSuccess || hipDeviceGetAttribute(&cus, hipDeviceAttributeMultiprocessorCount, dev) != hipSuccess) { grid = -1; return; }
        if (hipFuncSetAttribute((const void*)fwd_kernel, hipFuncAttributeMaxDynamicSharedMemorySize, LDS_BYTES) != hipSuccess) { fprintf(stderr, "kernel_launch: hipFuncSetAttribute failed\n"); grid = -1; return; }
        int per_cu = 0;
        if (hipOccupancyMaxActiveBlocksPerMultiprocessor(&per_cu, (const void*)fwd_kernel, NTHR, LDS_BYTES) != hipSuccess || per_cu < 1) fprintf(stderr, "kernel_launch: occupancy query says %d\n", per_cu);
        (void)hipGetLastError();
        grid = cus > 256 ? 256 : cus;
    }
    if (grid < 0) return;
    (void)hipMemsetAsync((char*)d_ws + WS_CTL, 0, CTL_ZERO_BYTES, stream);
    Args a{};
    for (int i = 0; i < 36; ++i) a.in[i] = (const float*)d_in[i];
    a.out = (float*)d_out; a.ws = (unsigned char*)d_ws;
#if MK_PER_PHASE
    for (int p = 0; p < NPH; ++p) { a.ph_lo = p; a.ph_hi = p + 1; hipLaunchKernelGGL(fwd_kernel, dim3(grid), dim3(NTHR), LDS_BYTES, stream, a); }
#else
    a.ph_lo = 0; a.ph_hi = NPH; hipLaunchKernelGGL(fwd_kernel, dim3(grid), dim3(NTHR), LDS_BYTES, stream, a);
#endif
}
```

```cpp
#include <hip/hip_runtime.h>
#include <cstdio>
#include <cstdint>

constexpr int D = 1024, NB = 4, SEQ = 8192, CTX = 256, DEPTH = 2;
constexpr int ML = NB * SEQ;
constexpr int MC = NB * CTX;
constexpr int M = ML + MC;
constexpr int N_IN = 6816, OFF_CQ = 2048, OFF_CKV = 2432, OFF_KR = 2688, OFF_UV = 2720, OFF_MERGE = 3744;
constexpr int NEXP = 64, TOPK = 6, DEXP = 256;
constexpr int APAD = 219136;
constexpr float EPS = 1e-6f;
#ifndef FAST_ROUTER
#define FAST_ROUTER 1
#endif
#ifndef ATTN_NS
#define ATTN_NS at16
#endif
#ifndef REP_ATTN
#define REP_ATTN 1
#endif
#ifndef REP_R3
#define REP_R3 1
#endif
#ifndef REP_GMLP
#define REP_GMLP 1
#endif
#ifndef REP_NORM1
#define REP_NORM1 1
#endif
#ifndef REP_CVTMOE
#define REP_CVTMOE 1
#endif
#ifndef REP_R1
#define REP_R1 1
#endif
#ifndef REP_PRO
#define REP_PRO 1
#endif
#ifndef REP_MERGE
#define REP_MERGE 1
#endif
#ifndef REP_GATEUP
#define REP_GATEUP 1
#endif
#ifndef REP_MLAUP
#define REP_MLAUP 1
#endif
#ifndef REP_DOWN1
#define REP_DOWN1 1
#endif
#ifndef REP_INPROJ
#define REP_INPROJ 1
#endif
#ifndef REP_NORM2
#define REP_NORM2 1
#endif
#ifndef REP_ROUTER
#define REP_ROUTER 1
#endif
constexpr float QSCALE = 0.14724649622f;

constexpr size_t MiB = 1u << 20;
constexpr size_t WS_CTL = 0, CTL_ZERO_BYTES = 1 * MiB;
constexpr size_t WS_MOD = 1 * MiB;
constexpr size_t WS_ROPE = 2 * MiB;
constexpr size_t WS_XC = 4 * MiB;
constexpr size_t WS_IDX = 8 * MiB;
constexpr size_t WS_WTS = 9 * MiB;
constexpr size_t WS_SLOT = 10 * MiB;
constexpr size_t WS_INV = 11 * MiB;
constexpr size_t WS_ROWTOK = 12 * MiB;
constexpr size_t WS_BLKBASE = 13 * MiB;
constexpr size_t WS_WSM = 14 * MiB;
constexpr size_t SMW_WIN = 0, SMW_WG = SMW_WIN + (size_t)3840 * 2048, SMW_WUQ = SMW_WG + (size_t)3072 * 2048, SMW_WUKV = SMW_WUQ + (size_t)1024 * 768,
                 SMW_WBR = SMW_WUKV + (size_t)1024 * 512, SMW_WOUT = SMW_WBR + (size_t)3 * 1024 * 1024, SMW_SHGU = SMW_WOUT + (size_t)1024 * 2048,
                 SMW_SHD = SMW_SHGU + (size_t)512 * 2048, SMW_RT = SMW_SHD + (size_t)1024 * 512, SMW_L = SMW_RT + (size_t)2 * 64 * 1024 * 2;
static_assert(WS_WSM + 2 * SMW_L <= 60 * MiB, "small weights");
constexpr size_t WS_MOEW = 126 * MiB;
constexpr size_t WS_SCR = 566 * MiB;
constexpr size_t WS_H = 60 * MiB;
constexpr size_t WS_RET = 126 * MiB;
constexpr size_t WS_CQ = 258 * MiB;
constexpr size_t WS_CKV = WS_CQ + (size_t)M * 384 * 2;
constexpr size_t WS_KR = WS_CKV + (size_t)M * 256 * 2;
constexpr size_t WS_AO = 258 * MiB;
constexpr size_t WS_UV = 302 * MiB;
constexpr size_t WS_Q = 368 * MiB;
constexpr size_t WS_K = WS_Q + (size_t)M * 768 * 2;
constexpr size_t WS_Y = 368 * MiB;
constexpr size_t WS_V = 467 * MiB;
constexpr size_t WS_ST = 500 * MiB;
constexpr size_t WS_HB = 222 * MiB;
constexpr size_t WS_HBS = 329 * MiB;
constexpr size_t WS_OUT = 346 * MiB;
constexpr size_t WS_PART = 632 * MiB;
constexpr size_t WS_PARTV = 636 * MiB;
constexpr size_t WS_RS = 641 * MiB;
constexpr size_t WS_END = 642 * MiB;
static_assert(WS_KR + (size_t)M * 32 * 2 <= WS_UV && WS_K + (size_t)M * 768 * 2 <= WS_V && WS_V + (size_t)M * 512 * 2 <= WS_ST, "ws map");
static_assert(WS_HB + (size_t)APAD * 256 * 2 <= WS_HBS && WS_HBS + (size_t)M * 256 * 2 <= WS_OUT && WS_OUT + (size_t)APAD * 512 * 2 <= WS_END, "ws map moe");
constexpr int CW_BAR = 4096;
constexpr int CW_MFLAG = 20480;
constexpr int CW_CNT = 16384;

constexpr int NWAVES = 8, NTHR = 512;
constexpr int LDS_BYTES = 147456;
constexpr int MISC_OFF = 139264;

#define LAS __attribute__((address_space(3)))
#define GAS __attribute__((address_space(1)))
typedef unsigned short bf16_t;
__device__ __forceinline__ unsigned f2bf(float f) { unsigned u = __builtin_bit_cast(unsigned, f); return (u + 0x7fffu + ((u >> 16) & 1u)) >> 16; }
__device__ __forceinline__ float bf2f(bf16_t h) { return __builtin_bit_cast(float, (unsigned)h << 16); }
__device__ __forceinline__ float sigmoidf_(float x) { return 1.0f / (1.0f + expf(-x)); }
__device__ __forceinline__ float siluf_(float x) { return x / (1.0f + expf(-x)); }
__device__ __forceinline__ float gelu_tanh(float x) { const float u = 0.7978845608028654f * (x + 0.044715f * x * x * x); return 0.5f * x * (1.0f + tanhf(u)); }
__device__ __forceinline__ float xlane32(float v, int lane) { return __builtin_bit_cast(float, __builtin_amdgcn_ds_bpermute((lane ^ 32) << 2, __builtin_bit_cast(int, v))); }
__device__ __forceinline__ int xlane32i(int v, int lane) { return __builtin_amdgcn_ds_bpermute((lane ^ 32) << 2, v); }
template <int CTRL> __device__ __forceinline__ float dppx(float v) { return __builtin_bit_cast(float, __builtin_amdgcn_update_dpp(0, __builtin_bit_cast(int, v), CTRL, 0xf, 0xf, true)); }
__device__ __forceinline__ float row16_sum(float v) { v += dppx<0xB1>(v); v += dppx<0x4E>(v); v += dppx<0x141>(v); v += dppx<0x140>(v); return v; }
__device__ __forceinline__ float wave_sum(float v) {
    v = row16_sum(v);
    const float a = __builtin_bit_cast(float, __builtin_amdgcn_readlane(__builtin_bit_cast(int, v), 0)), b = __builtin_bit_cast(float, __builtin_amdgcn_readlane(__builtin_bit_cast(int, v), 16));
    const float c = __builtin_bit_cast(float, __builtin_amdgcn_readlane(__builtin_bit_cast(int, v), 32)), d = __builtin_bit_cast(float, __builtin_amdgcn_readlane(__builtin_bit_cast(int, v), 48));
    return (a + b) + (c + d);
}

#define XB_TMO      128
#define XB_XCNT(j)  (256  + 64 * (j))
#define XB_XSUB(j)  (1280 + 64 * (j))
#define XB_XGEN(j)  (2304 + 64 * (j))
#define XB_TOP      3328
#define XB_TOPGEN   3392
#define XCD_BAR_WORDS 3456
#define XB_SPIN_CAP (1u << 22)
__device__ __forceinline__ unsigned xb_ld(unsigned* p)              { return __hip_atomic_load(p, __ATOMIC_RELAXED, __HIP_MEMORY_SCOPE_AGENT); }
__device__ __forceinline__ unsigned xb_add(unsigned* p, unsigned v) { return __hip_atomic_fetch_add(p, v, __ATOMIC_RELAXED, __HIP_MEMORY_SCOPE_AGENT); }
__device__ __forceinline__ unsigned xb_xcc_id() { return (unsigned)__builtin_amdgcn_s_getreg((3 << 11) | 20) & 0xFu; }
#define XB_SPIN(cond, bar) do { unsigned _sp = 0; while (cond) { __builtin_amdgcn_s_sleep(1); \
    if ((++_sp & 255u) == 0u) { if (xb_ld(&(bar)[XB_TMO])) break; if (_sp > XB_SPIN_CAP) { atomicAdd(&(bar)[XB_TMO], 1u); break; } } } } while (0)
struct XcdBarrier { unsigned* bar; unsigned x; volatile LAS unsigned* st; };
__device__ __forceinline__ XcdBarrier xcd_barrier_post(unsigned* bar, volatile LAS unsigned* st) {
    XcdBarrier b; b.bar = bar; b.x = xb_xcc_id(); b.st = st;
    if (threadIdx.x == 0) (void)xb_add(&bar[XB_XCNT(b.x)], 1u);
    return b;
}
__device__ __forceinline__ void xcd_barrier_complete(unsigned* bar, unsigned x, unsigned& nloc, unsigned& nx) {
    const unsigned G = gridDim.x * gridDim.y * gridDim.z;
    unsigned sum, cnt, mine, sp = 0u;
    for (;;) {
        sum = 0u; cnt = 0u; mine = 0u;
#pragma unroll
        for (unsigned j = 0; j < 16; ++j) { const unsigned c = xb_ld(&bar[XB_XCNT(j)]); sum += c; cnt += (c > 0u) ? 1u : 0u; mine = (j == x) ? c : mine; }
        if (sum == G) break;
        __builtin_amdgcn_s_sleep(1);
        if ((++sp & 255u) == 0u) { if (xb_ld(&bar[XB_TMO])) break; if (sp > XB_SPIN_CAP) { atomicAdd(&bar[XB_TMO], 1u); break; } }
    }
    nloc = mine > 0u ? mine : 1u; nx = cnt > 0u ? cnt : 1u;
}
__device__ __forceinline__ void xcd_barrier(const XcdBarrier& b, int tid) {
    asm volatile("s_waitcnt vmcnt(0)" ::: "memory");
    __syncthreads();
    if (tid == 0) {
        GAS unsigned* barg = (GAS unsigned*)b.bar; unsigned bx = b.x;
        asm volatile("" : "+s"(barg), "+s"(bx));
        unsigned* bar = (unsigned*)barg;
        __builtin_amdgcn_s_waitcnt(0);
        unsigned nloc = b.st[0], nx = b.st[1];
        if (nloc == 0u) { xcd_barrier_complete(bar, bx, nloc, nx); b.st[0] = nloc; b.st[1] = nx; }
        const unsigned old = xb_add(&bar[XB_XSUB(bx)], 1u);
        const unsigned gen = old / nloc;
        if (old + 1u == (gen + 1u) * nloc) {
            __builtin_amdgcn_fence(__ATOMIC_RELEASE, "agent");
            asm volatile("s_waitcnt vmcnt(0)" ::: "memory");
            const unsigned og = xb_add(&bar[XB_TOP], 1u);
            const unsigned tg = og / nx;
            if (og + 1u == (tg + 1u) * nx) xb_add(&bar[XB_TOPGEN], 1u);
            else XB_SPIN(xb_ld(&bar[XB_TOPGEN]) == tg, bar);
            __builtin_amdgcn_fence(__ATOMIC_ACQUIRE, "agent");
            xb_add(&bar[XB_XGEN(bx)], 1u);
            asm volatile("s_waitcnt vmcnt(0)" ::: "memory");
        } else {
            XB_SPIN(xb_ld(&bar[XB_XGEN(bx)]) == gen, bar);
            __builtin_amdgcn_fence(__ATOMIC_ACQUIRE, "agent");
            asm volatile("s_waitcnt vmcnt(0)" ::: "memory");
        }
    }
    __syncthreads();
}

struct Args {
    const float* in[36]; float* out; unsigned char* ws; int ph_lo, ph_hi;
};
enum { I_X = 0, I_C, I_CTX, I_CCTX, I_ADAW, I_ADAB, I_N1G, I_N2G, I_WIN, I_DECF, I_DECB, I_GNG, I_GNB, I_WBRRET,
       I_QAG, I_WUQ, I_KVAG, I_WUKV, I_QNG, I_KNG, I_KRG, I_WBRMLA, I_LNG, I_LNB, I_GWS, I_GBS, I_WBRG, I_WOUT,
       I_ROUTER, I_MBIAS, I_WG, I_WU, I_WD, I_SG, I_SU, I_SD };

struct Frame {
    unsigned char* lds; int tid, lane, wave, G, bid;
    const Args* A;
};
__device__ __forceinline__ unsigned long long uni64_(unsigned long long v) { const unsigned a = __builtin_amdgcn_readfirstlane((unsigned)v), b = __builtin_amdgcn_readfirstlane((unsigned)(v >> 32)); return ((unsigned long long)b << 32) | a; }
__device__ __forceinline__ const float* fin_(const Args* A, int i) { asm volatile("" : "+v"(i)); i = __builtin_amdgcn_readfirstlane(i); const GAS float* g = (const GAS float*)uni64_((unsigned long long)A->in[i]); asm volatile("" : "+s"(g)); return (const float*)g; }
#define FIN(i) fin_(F.A, (i))
__device__ __forceinline__ unsigned char* ws_(const Args* A) { GAS unsigned char* g = (GAS unsigned char*)uni64_((unsigned long long)A->ws); asm volatile("" : "+s"(g)); return (unsigned char*)g; }
#define FWS(T, off) ((T*)(ws_(F.A) + (off)))
__device__ __forceinline__ float* out_(const Args* A) { GAS float* g = (GAS float*)uni64_((unsigned long long)A->out); asm volatile("" : "+s"(g)); return (float*)g; }
#define F_out out_(F.A)
#define F_ctl FWS(unsigned, WS_CTL)
#define F_MOD FWS(float, WS_MOD)
#define F_ROPE FWS(float, WS_ROPE)
#define F_XC FWS(float, WS_XC)
#define F_IDX FWS(int, WS_IDX)
#define F_WTS FWS(float, WS_WTS)
#define F_SLOT FWS(int, WS_SLOT)
#define F_INV FWS(int, WS_INV)
#define F_ROWTOK FWS(int, WS_ROWTOK)
#define F_BLKBASE FWS(int, WS_BLKBASE)
#define F_H ((bf16_t*)out_(F.A))
#define F_X16 FWS(bf16_t, WS_H)
#define F_RET FWS(bf16_t, WS_RET)
#define F_CQ FWS(bf16_t, WS_CQ)
#define F_CKV FWS(bf16_t, WS_CKV)
#define F_KR FWS(bf16_t, WS_KR)
#define F_AO FWS(bf16_t, WS_AO)
#define F_UV FWS(bf16_t, WS_UV)
#define F_Q FWS(bf16_t, WS_Q)
#define F_K FWS(bf16_t, WS_K)
#define F_V FWS(bf16_t, WS_V)
#define F_Y FWS(bf16_t, WS_Y)
#define F_ST FWS(bf16_t, WS_ST)
#define F_KVR FWS(bf16_t, WS_SCR)
#define F_HB FWS(bf16_t, WS_HB)
#define F_HBS FWS(bf16_t, WS_HBS)
#define F_OUT FWS(bf16_t, WS_OUT)
__device__ __forceinline__ int row_batch(int r) { return r < ML ? (r >> 13) : 4; }
__device__ __forceinline__ const float* x_row_src(const Frame& F, int l, int r) { return r < ML ? ((l == 0 ? FIN(I_X) : F_out) + (size_t)r * D) : (F_XC + (size_t)(r - ML) * D); }
__device__ __forceinline__ float* x_row_dst(const Frame& F, int r) { return r < ML ? (F_out + (size_t)r * D) : (F_XC + (size_t)(r - ML) * D); }

__device__ __forceinline__ void ngemm_acc(float (&acc)[4][4], const bf16_t* A, int lda, const int* rowidx, int row0, int nrows,
                                          const float* W, int ldw, int col0, int ncols, int K, float* sA, float* sW, int tid) {
    const int ty = tid >> 4, tx = tid & 15;
    const int lr = tid >> 2, lk = (tid & 3) * 8;
    const int wk = tid >> 4, wc = (tid & 15) * 4;
    const bool rv = (row0 + lr) < nrows;
    const bf16_t* arow = nullptr;
    if (rv) { const int rr = rowidx ? rowidx[row0 + lr] : (row0 + lr); arow = A + (size_t)rr * lda; }
    const bool cv = (col0 + wc) < ncols;
    for (int k0 = 0; k0 < K; k0 += 32) {
        uint4 av = make_uint4(0u, 0u, 0u, 0u);
        if (rv) av = *(const uint4*)(arow + k0 + lk);
        float4 wv = make_float4(0.f, 0.f, 0.f, 0.f);
        if (cv) wv = *(const float4*)(W + (size_t)(k0 + wk) * ldw + col0 + wc);
        __syncthreads();
        float* sa = sA + lr * 33 + lk;
        sa[0] = __builtin_bit_cast(float, av.x << 16); sa[1] = __builtin_bit_cast(float, av.x & 0xffff0000u);
        sa[2] = __builtin_bit_cast(float, av.y << 16); sa[3] = __builtin_bit_cast(float, av.y & 0xffff0000u);
        sa[4] = __builtin_bit_cast(float, av.z << 16); sa[5] = __builtin_bit_cast(float, av.z & 0xffff0000u);
        sa[6] = __builtin_bit_cast(float, av.w << 16); sa[7] = __builtin_bit_cast(float, av.w & 0xffff0000u);
        *(float4*)(sW + wk * 64 + wc) = wv;
        __syncthreads();
#pragma unroll 8
        for (int kk = 0; kk < 32; ++kk) {
            const float4 w = *(const float4*)(sW + kk * 64 + tx * 4);
            float a[4];
#pragma unroll
            for (int i = 0; i < 4; ++i) a[i] = sA[(ty * 4 + i) * 33 + kk];
#pragma unroll
            for (int i = 0; i < 4; ++i) { acc[i][0] += a[i] * w.x; acc[i][1] += a[i] * w.y; acc[i][2] += a[i] * w.z; acc[i][3] += a[i] * w.w; }
        }
    }
}
#define ZERO_ACC(a) do { _Pragma("unroll") for (int _i = 0; _i < 4; ++_i) _Pragma("unroll") for (int _j = 0; _j < 4; ++_j) a[_i][_j] = 0.f; } while (0)

namespace g8 {
typedef short bf16x8 __attribute__((ext_vector_type(8)));
typedef float f32x4 __attribute__((ext_vector_type(4)));
typedef unsigned u32x4 __attribute__((ext_vector_type(4)));
typedef float f32x2 __attribute__((ext_vector_type(2)));
typedef __bf16 bf16x2_t __attribute__((ext_vector_type(2)));
constexpr int HTB = 16384, STAGE_BYTES = 8 * HTB;
__device__ __forceinline__ int lds_byte(int r, int c) { const int st = (r >> 4) * 2 + (c >> 5), rr = r & 15, cc = c & 31, ob = rr * 64 + cc * 2; return st * 1024 + (ob ^ (((ob >> 9) & 1) << 5)); }
__device__ __forceinline__ void stage_rc(int b, int& R, int& C) { const int st = b / 1024, sb = b % 1024, swz = sb ^ (((sb >> 9) & 1) << 5); R = (st >> 1) * 16 + swz / 64; C = (st & 1) * 32 + (swz % 64) / 2; }
__device__ __forceinline__ int perm32(int rho) { const int n = rho >> 4, i = rho & 15; return 8 * (i >> 2) + 4 * n + (i & 3); }
__device__ __forceinline__ unsigned cvtpk(float lo, float hi) { f32x2 v = {lo, hi}; bf16x2_t b = __builtin_convertvector(v, bf16x2_t); return __builtin_bit_cast(unsigned, b); }
__device__ __forceinline__ float fsigmoid(float x) { return __builtin_amdgcn_rcpf(1.0f + __builtin_amdgcn_exp2f(-1.4426950408889634f * x)); }
__device__ __forceinline__ u32x4 pack8(const f32x4& a, const f32x4& b) { u32x4 w; w.x = cvtpk(a[0], a[1]); w.y = cvtpk(a[2], a[3]); w.z = cvtpk(b[0], b[1]); w.w = cvtpk(b[2], b[3]); return w; }
__device__ __forceinline__ void unpack8(const u32x4& w, f32x4& a, f32x4& b) {
    a[0] = __builtin_bit_cast(float, w.x << 16); a[1] = __builtin_bit_cast(float, w.x & 0xffff0000u); a[2] = __builtin_bit_cast(float, w.y << 16); a[3] = __builtin_bit_cast(float, w.y & 0xffff0000u);
    b[0] = __builtin_bit_cast(float, w.z << 16); b[1] = __builtin_bit_cast(float, w.z & 0xffff0000u); b[2] = __builtin_bit_cast(float, w.w << 16); b[3] = __builtin_bit_cast(float, w.w & 0xffff0000u); }

struct GUnit { const char* A; const char* B; const int* rows; int arow0; unsigned lda2, ldb2; int nt; int pm, pn, tag; };

#define G8_ROWS(u, ra) do { _Pragma("unroll") for (int _h = 0; _h < 2; ++_h) { \
        const int _x0 = (u).arow0 + _h * 128 + R0, _x1 = (u).arow0 + _h * 128 + R1; \
        ra[_h][0] = (u).rows ? (u).rows[_x0] : _x0; ra[_h][1] = (u).rows ? (u).rows[_x1] : _x1; } } while (0)

template <bool GATHER, class Sched, class Epi>
__device__ __forceinline__ void gemm_phase(LAS unsigned char* lds, const Sched& S, const Epi& E, int tid_in) {
    int tid = tid_in; asm volatile("" : "+v"(tid));
    const int wid = __builtin_amdgcn_readfirstlane(tid >> 6), lane = tid & 63, wr = wid >> 2, wc = wid & 3, fr = lane & 15, fq = lane >> 4;
    int R0, C0, R1, C1; stage_rc(tid * 16, R0, C0); stage_rc(tid * 16 + 8192, R1, C1);
    const int Rb0 = (R0 & ~31) + perm32(R0 & 31), Rb1 = (R1 & ~31) + perm32(R1 & 31);
    const unsigned ldsw = (unsigned)wid * 1024u, cb0 = (unsigned)C0 * 2u, cb1 = (unsigned)C1 * 2u;
    const int aoff = lds_byte(wr * 64 + fr, fq * 8), boff = lds_byte(wc * 32 + fr, fq * 8);
#define G8_SA(b, h) (((b) * 2 + (h)) * HTB)
#define G8_SB(b, h) ((4 + (b) * 2 + (h)) * HTB)
#define G8_GLDS(gptr, bufoff, i) __builtin_amdgcn_global_load_lds((const unsigned*)(gptr), (LAS unsigned*)(lds + (bufoff) + ldsw + (i) * 8192), 16, 0, 0)
#define G8_STAGE_A(bufoff, gbase, ld2, ra2, arow, h, kb) do { if constexpr (GATHER) { \
        G8_GLDS((gbase) + (size_t)((unsigned)(ra2)[0] * (ld2) + cb0 + (kb)), bufoff, 0); G8_GLDS((gbase) + (size_t)((unsigned)(ra2)[1] * (ld2) + cb1 + (kb)), bufoff, 1); } else { \
        G8_GLDS((gbase) + (size_t)((unsigned)((arow) + (h) * 128 + R0) * (ld2) + cb0 + (kb)), bufoff, 0); G8_GLDS((gbase) + (size_t)((unsigned)((arow) + (h) * 128 + R1) * (ld2) + cb1 + (kb)), bufoff, 1); } } while (0)
#define G8_STAGE_B(bufoff, gbase, ld2, h, kb) do { G8_GLDS((gbase) + (size_t)((unsigned)((h) * 128 + Rb0) * (ld2) + cb0 + (kb)), bufoff, 0); G8_GLDS((gbase) + (size_t)((unsigned)((h) * 128 + Rb1) * (ld2) + cb1 + (kb)), bufoff, 1); } while (0)
#define G8_LDA(dst, b, h) do { _Pragma("unroll") for (int m = 0; m < 4; ++m) _Pragma("unroll") for (int k = 0; k < 2; ++k) dst[m][k] = *(const LAS bf16x8*)(lds + G8_SA(b, h) + aoff + m * 2048 + k * 1024); } while (0)
#define G8_LDB(dst, b, h) do { _Pragma("unroll") for (int n = 0; n < 2; ++n) _Pragma("unroll") for (int k = 0; k < 2; ++k) dst[n][k] = *(const LAS bf16x8*)(lds + G8_SB(b, h) + boff + n * 2048 + k * 1024); } while (0)
#define G8_MMA(ai, bj, At, Bt) do { __builtin_amdgcn_s_setprio(1); _Pragma("unroll") for (int m = 0; m < 4; ++m) _Pragma("unroll") for (int n = 0; n < 2; ++n) _Pragma("unroll") for (int k = 0; k < 2; ++k) \
        acc[ai][bj][m][n] = __builtin_amdgcn_mfma_f32_16x16x32_bf16(Bt[n][k], At[m][k], acc[ai][bj][m][n], 0, 0, 0); __builtin_amdgcn_s_setprio(0); } while (0)
#define G8_WAIT_V(n) asm volatile("s_waitcnt vmcnt(" #n ")" ::: "memory")
#define G8_WAIT_L(n) asm volatile("s_waitcnt lgkmcnt(" #n ")" ::: "memory")
#define G8_BAR __builtin_amdgcn_s_barrier()
#define G8_SCHED __builtin_amdgcn_sched_barrier(0)
    GUnit cur, nxt; int ui = 0;
    if (!S.get(0, cur)) return;
#define G8_OPAQUE(u) do { (u).lda2 = (unsigned)__builtin_amdgcn_readfirstlane((int)(u).lda2); (u).ldb2 = (unsigned)__builtin_amdgcn_readfirstlane((int)(u).ldb2); (u).nt = __builtin_amdgcn_readfirstlane((u).nt); (u).arow0 = __builtin_amdgcn_readfirstlane((u).arow0); \
    asm volatile("" : "+s"((u).lda2), "+s"((u).ldb2), "+s"((u).nt), "+s"((u).arow0)); } while (0)
    G8_OPAQUE(cur);
    int ra_c[2][2], ra_n[2][2];
    if constexpr (GATHER) { G8_ROWS(cur, ra_c); }
    f32x4 acc[2][2][4][2];
#pragma unroll
    for (int a = 0; a < 2; ++a)
#pragma unroll
        for (int b = 0; b < 2; ++b)
#pragma unroll
            for (int m = 0; m < 4; ++m)
#pragma unroll
                for (int n = 0; n < 2; ++n) acc[a][b][m][n] = (f32x4){0.f, 0.f, 0.f, 0.f};
    bf16x8 At[4][2], B0[2][2], B1[2][2];
    G8_STAGE_B(G8_SB(0, 0), cur.B, cur.ldb2, 0, 0u); G8_STAGE_B(G8_SB(0, 1), cur.B, cur.ldb2, 1, 0u); G8_STAGE_A(G8_SA(0, 0), cur.A, cur.lda2, ra_c[0], cur.arow0, 0, 0u); G8_STAGE_A(G8_SA(0, 1), cur.A, cur.lda2, ra_c[1], cur.arow0, 1, 0u);
    if (wr == 1) G8_BAR;
    G8_WAIT_V(2); G8_BAR;
    G8_STAGE_B(G8_SB(1, 0), cur.B, cur.ldb2, 0, 128u); G8_STAGE_A(G8_SA(1, 0), cur.A, cur.lda2, ra_c[0], cur.arow0, 0, 128u); G8_STAGE_B(G8_SB(1, 1), cur.B, cur.ldb2, 1, 128u);
    G8_WAIT_V(6); G8_BAR;
    for (;;) {
        const bool has_next = S.get(ui + 1, nxt);
        if (has_next) G8_OPAQUE(nxt);
        if (has_next) { if constexpr (GATHER) { G8_ROWS(nxt, ra_n); } }
        else { nxt = cur;
            if constexpr (GATHER) {
#pragma unroll
            for (int h = 0; h < 2; ++h)
#pragma unroll
                for (int i = 0; i < 2; ++i) ra_n[h][i] = ra_c[h][i]; } }
        const int nt = cur.nt;
        for (int t = 0; t < nt; t += 2) {
            const bool last = (t == nt - 2);
            const char* a2 = last ? nxt.A : cur.A; const char* b2 = last ? nxt.B : cur.B;
            const unsigned la2 = last ? nxt.lda2 : cur.lda2, lb2 = last ? nxt.ldb2 : cur.ldb2;
            const unsigned k1 = (unsigned)(t + 1) * 128u, k2 = last ? 0u : (unsigned)(t + 2) * 128u, k3 = k2 + 128u;
            const int ar2 = last ? nxt.arow0 : cur.arow0; (void)ar2;
            int ra2[2][2];
            if constexpr (GATHER) {
#pragma unroll
            for (int h = 0; h < 2; ++h)
#pragma unroll
                for (int i = 0; i < 2; ++i) ra2[h][i] = last ? ra_n[h][i] : ra_c[h][i]; }
            G8_LDB(B0, 0, 0); G8_LDB(B1, 0, 1); G8_SCHED; G8_LDA(At, 0, 0); G8_STAGE_A(G8_SA(1, 1), cur.A, cur.lda2, ra_c[1], cur.arow0, 1, k1);
            G8_WAIT_V(8); G8_WAIT_L(0); G8_BAR; G8_MMA(0, 0, At, B0); G8_MMA(0, 1, At, B1); G8_BAR; G8_SCHED;
            G8_LDA(At, 0, 1); G8_STAGE_B(G8_SB(0, 0), b2, lb2, 0, k2); G8_STAGE_B(G8_SB(0, 1), b2, lb2, 1, k2); G8_STAGE_A(G8_SA(0, 0), a2, la2, ra2[0], ar2, 0, k2);
            G8_WAIT_V(8); G8_WAIT_L(0); G8_BAR; G8_MMA(1, 0, At, B0); G8_MMA(1, 1, At, B1); G8_BAR; G8_SCHED;
            G8_LDB(B0, 1, 0); G8_LDB(B1, 1, 1); G8_SCHED; G8_LDA(At, 1, 0); G8_STAGE_A(G8_SA(0, 1), a2, la2, ra2[1], ar2, 1, k2);
            G8_WAIT_V(8); G8_WAIT_L(0); G8_BAR; G8_MMA(0, 0, At, B0); G8_MMA(0, 1, At, B1); G8_BAR; G8_SCHED;
            G8_LDA(At, 1, 1); G8_STAGE_B(G8_SB(1, 0), b2, lb2, 0, k3); G8_STAGE_B(G8_SB(1, 1), b2, lb2, 1, k3); G8_STAGE_A(G8_SA(1, 0), a2, la2, ra2[0], ar2, 0, k3);
            G8_WAIT_V(8); G8_WAIT_L(0); G8_BAR; G8_MMA(1, 0, At, B0); G8_MMA(1, 1, At, B1); G8_BAR; G8_SCHED;
        }
        if (wr == 0) G8_BAR;
        { int efr = fr, efq = fq, etid = tid; asm volatile("" : "+v"(efr), "+v"(efq), "+v"(etid));
          E(acc, cur, wr, wc, efr, efq, etid); }
        if (!has_next) break;
#pragma unroll
        for (int a = 0; a < 2; ++a)
#pragma unroll
            for (int b = 0; b < 2; ++b)
#pragma unroll
                for (int m = 0; m < 4; ++m)
#pragma unroll
                    for (int n = 0; n < 2; ++n) acc[a][b][m][n] = (f32x4){0.f, 0.f, 0.f, 0.f};
        cur = nxt; ++ui;
        if constexpr (GATHER) {
#pragma unroll
        for (int h = 0; h < 2; ++h)
#pragma unroll
            for (int i = 0; i < 2; ++i) ra_c[h][i] = ra_n[h][i]; }
        if (wr == 1) G8_BAR;
    }
    G8_WAIT_V(0);
    G8_BAR;
#undef G8_SA
#undef G8_SB
#undef G8_GLDS
#undef G8_OPAQUE
#undef G8_STAGE_A
#undef G8_STAGE_B
#undef G8_LDA
#undef G8_LDB
#undef G8_MMA
#undef G8_WAIT_V
#undef G8_WAIT_L
#undef G8_BAR
#undef G8_SCHED
}
__device__ __forceinline__ bool tile_order(int i, int G, int c, int nM, int nN, int& pm, int& pn) {
    const int nwg = nM * nN; const long L = (long)i * G + c; if (L >= nwg) return false;
    int wgid = (int)L; { const int q = nwg / 8, r = nwg % 8, xcd = wgid % 8, off = wgid / 8; wgid = (xcd < r ? xcd * (q + 1) : r * (q + 1) + (xcd - r) * q) + off; }
    const int nig = 8 * nN, gid = wgid / nig, fm = gid * 8, gsz = (nM - fm) < 8 ? (nM - fm) : 8;
    pm = fm + ((wgid % nig) % gsz); pn = (wgid % nig) / gsz; return true;
}
}

__device__ __forceinline__ float sumsq8(const g8::f32x4& a, const g8::f32x4& b) { return (a[0] * a[0] + a[1] * a[1]) + (a[2] * a[2] + a[3] * a[3]) + (b[0] * b[0] + b[1] * b[1]) + (b[2] * b[2] + b[3] * b[3]); }
__device__ __forceinline__ void p_prologue(Frame& F) {
    float* sred = (float*)F.lds;
    const float* cvp = FIN(I_C); const float* ccp = FIN(I_CCTX); const float* adab = FIN(I_ADAB); const float* adaw = FIN(I_ADAW);
    float* ssil = sred + 8 * 64 * 5;
    if (F.bid < 2 * 96) { for (int i = F.tid; i < 5 * D; i += NTHR) { const float v = i < 4 * D ? cvp[i] : ccp[i - 4 * D]; ssil[i] = siluf_(v); } }
    __syncthreads();
    for (int u = F.bid; u < 2 * 96; u += F.G) {
        const int l = u / 96, n0 = (u % 96) * 64, n = n0 + (F.tid & 63), ks = F.tid >> 6;
        float a[5] = {0.f, 0.f, 0.f, 0.f, 0.f};
        const float* W = adaw + (size_t)l * D * 6144;
        const float* Wn = W + (size_t)(ks * 128) * 6144 + n; const float* sk = ssil + ks * 128;
        for (int k0 = 0; k0 < 128; k0 += 16) {
            float wv[16];
#pragma unroll
            for (int j = 0; j < 16; ++j) wv[j] = Wn[(size_t)(k0 + j) * 6144];
#pragma unroll
            for (int j = 0; j < 16; ++j) {
#pragma unroll
                for (int b = 0; b < 5; ++b) a[b] += sk[b * D + k0 + j] * wv[j]; }
        }
        __syncthreads();
#pragma unroll
        for (int b = 0; b < 5; ++b) sred[(ks * 64 + (F.tid & 63)) * 5 + b] = a[b];
        __syncthreads();
        if (F.tid < 64 * 5) { const int c = F.tid / 5, b = F.tid % 5; float s = 0.f;
            for (int q = 0; q < 8; ++q) s += sred[(q * 64 + c) * 5 + b];
            F_MOD[((size_t)l * 5 + b) * 6144 + n0 + c] = s + adab[l * 6144 + n0 + c]; }
    }
    const int gt = F.bid * NTHR + F.tid, GT = F.G * NTHR;
    for (int i = gt; i < SEQ * 16; i += GT) {
        const int t = i >> 4, a = (i >> 3) & 1, f = i & 7;
        const float inv = powf(10000.0f, -(float)f / 8.0f);
        const float pos = a == 0 ? (float)(t >> 6) : (float)(t & 63);
        const float ang = pos * inv;
        F_ROPE[t * 32 + a * 16 + f] = cosf(ang); F_ROPE[t * 32 + a * 16 + 8 + f] = sinf(ang);
    }
}

__device__ __forceinline__ void p_norm(Frame& F, int l, int which, int nrows) {
    const int gw = F.bid * NWAVES + F.wave, NGW = F.G * NWAVES;
    const float* g = FIN(which == 0 ? I_N1G : I_N2G) + l * D;
    const float* xlat = FIN(I_X); const float* xctx = FIN(I_CTX);
    g8::f32x4 gg[4];
#pragma unroll
    for (int j = 0; j < 4; ++j) gg[j] = *(const g8::f32x4*)(g + j * 256 + F.lane * 4);
    for (int rb = gw; rb < nrows; rb += 4 * NGW) {
        g8::f32x4 v[4][4]; int rr[4];
#pragma unroll
        for (int q = 0; q < 4; ++q) { const int r = rb + q * NGW; rr[q] = r < nrows ? r : rb;
            const g8::f32x4* xr = (const g8::f32x4*)(rr[q] < ML ? xlat + (size_t)rr[q] * D : xctx + (size_t)(rr[q] - ML) * D) + F.lane;
#pragma unroll
            for (int j = 0; j < 4; ++j) v[q][j] = xr[64 * j]; }
#pragma unroll
        for (int q = 0; q < 4; ++q) { if (rb + q * NGW >= nrows) break; const int r = rr[q];
            float s = 0.f;
#pragma unroll
            for (int j = 0; j < 4; ++j) s += (v[q][j][0] * v[q][j][0] + v[q][j][1] * v[q][j][1]) + (v[q][j][2] * v[q][j][2] + v[q][j][3] * v[q][j][3]);
            const float rstd = 1.0f / sqrtf(wave_sum(s) * (1.0f / D) + EPS);
            const float* mod = F_MOD + ((size_t)l * 5 + row_batch(r)) * 6144 + (which == 0 ? 0 : 3 * D);
#pragma unroll
            for (int j = 0; j < 4; ++j) { const int e = j * 256 + F.lane * 4;
                const g8::f32x4 sh = *(const g8::f32x4*)(mod + e), sc = *(const g8::f32x4*)(mod + D + e);
                const g8::f32x4 o = (v[q][j] * rstd * gg[j]) * (sc + 1.0f) + sh;
                uint2 w; w.x = g8::cvtpk(o[0], o[1]); w.y = g8::cvtpk(o[2], o[3]);
                *(uint2*)(F_H + (size_t)r * D + e) = w; } }
    }
}

__device__ __forceinline__ void p_norm2(Frame& F, int l, int nrows) {
    const int gw = F.bid * NWAVES + F.wave, NGW = F.G * NWAVES, e = F.lane * 16;
    const float* g = FIN(I_N2G) + l * D + e;
    constexpr int NLB = ML / 16;
    const int nseg = NLB + (nrows > ML ? nrows - ML : 0);
    for (int seg = gw; seg < nseg; seg += NGW) {
        const int r0 = seg < NLB ? seg * 16 : ML + (seg - NLB), n = seg < NLB ? 16 : 1;
        const float* mod = F_MOD + ((size_t)l * 5 + row_batch(r0)) * 6144 + 3 * D + e;
        g8::f32x4 gs[4], sh[4];
#pragma unroll
        for (int q = 0; q < 4; ++q) { sh[q] = *(const g8::f32x4*)(mod + 4 * q); gs[q] = *(const g8::f32x4*)(g + 4 * q) * (*(const g8::f32x4*)(mod + D + 4 * q) + 1.0f); }
        for (int j0 = 0; j0 < n; j0 += 8) {
            g8::u32x4 v[8][2];
#pragma unroll
            for (int q = 0; q < 8; ++q) { const int r = r0 + (j0 + q < n ? j0 + q : j0); const bf16_t* xr = F_X16 + (size_t)r * D + e; v[q][0] = *(const g8::u32x4*)xr; v[q][1] = *(const g8::u32x4*)(xr + 8); }
#pragma unroll
            for (int q = 0; q < 8; ++q) { if (j0 + q >= n) break; const int r = r0 + j0 + q;
                g8::f32x4 a0, a1, a2, a3; g8::unpack8(v[q][0], a0, a1); g8::unpack8(v[q][1], a2, a3);
                const float rstd = 1.0f / sqrtf(wave_sum(sumsq8(a0, a1) + sumsq8(a2, a3)) * (1.0f / D) + EPS);
                *(g8::u32x4*)(F_H + (size_t)r * D + e) = g8::pack8(a0 * rstd * gs[0] + sh[0], a1 * rstd * gs[1] + sh[1]);
                *(g8::u32x4*)(F_H + (size_t)r * D + e + 8) = g8::pack8(a2 * rstd * gs[2] + sh[2], a3 * rstd * gs[3] + sh[3]); }
        }
    }
}

__device__ __forceinline__ void p_inproj_naive(Frame& F, int l) {
    float* sA = (float*)F.lds; float* sW = sA + 128 * 33;
    const float* W = FIN(I_WIN) + (size_t)l * D * N_IN;
    constexpr int NT_N = (OFF_MERGE + 63) / 64, NT_M = M / 128;
    const int ty = F.tid >> 4, tx = F.tid & 15;
    for (int t = F.bid; t < NT_M * NT_N; t += F.G) {
        const int tm = t / NT_N, tn = t % NT_N; float acc[4][4]; ZERO_ACC(acc);
        ngemm_acc(acc, F_H, D, nullptr, tm * 128, M, W, N_IN, tn * 64, OFF_MERGE, D, sA, sW, F.tid);
#pragma unroll
        for (int i = 0; i < 4; ++i)
#pragma unroll
            for (int j = 0; j < 4; ++j) {
                const int r = tm * 128 + ty * 4 + i, c = tn * 64 + tx * 4 + j; if (c >= OFF_MERGE) continue;
                float v = acc[i][j];
                if (c < OFF_CQ) { if (c >= 512 && c < 1024) v *= 0.08838834764831845f; F_RET[(size_t)r * 2048 + c] = (bf16_t)f2bf(v); }
                else if (c < OFF_CKV) F_CQ[(size_t)r * 384 + (c - OFF_CQ)] = (bf16_t)f2bf(v);
                else if (c < OFF_KR) F_CKV[(size_t)r * 256 + (c - OFF_CKV)] = (bf16_t)f2bf(v);
                else if (c < OFF_UV) F_KR[(size_t)r * 32 + (c - OFF_KR)] = (bf16_t)f2bf(v);
                else F_UV[(size_t)r * 1024 + (c - OFF_UV)] = (bf16_t)f2bf(gelu_tanh(v));
            }
    }
}

__device__ __forceinline__ float rope_elem(const float* tab  , int d, float y, float yp) {
    const int a = d >> 4, j = d & 15, f = j & 7; const float c = tab[a * 16 + f], s = tab[a * 16 + 8 + f];
    return (j < 8) ? (y * c - yp * s) : (yp * s + y * c);
}
__device__ __forceinline__ void p_rowpass_a(Frame& F, int l) {
    const int gw = F.bid * NWAVES + F.wave, NGW = F.G * NWAVES, lane = F.lane;
    const float* qag = FIN(I_QAG) + l * 384; const float* kvag = FIN(I_KVAG) + l * 256; const float* krg = FIN(I_KRG) + l * 32;
    const float* lng = FIN(I_LNG) + l * 512; const float* lnb = FIN(I_LNB) + l * 512;
    for (int r = gw; r < M; r += NGW) {
        { bf16_t* p = F_CQ + (size_t)r * 384; float x[6]; float s = 0.f;
#pragma unroll
          for (int j = 0; j < 6; ++j) { x[j] = bf2f(p[lane + 64 * j]); s += x[j] * x[j]; }
          const float rstd = 1.0f / sqrtf(wave_sum(s) * (1.0f / 384.f) + EPS);
#pragma unroll
          for (int j = 0; j < 6; ++j) p[lane + 64 * j] = (bf16_t)f2bf(x[j] * rstd * qag[lane + 64 * j]); }
        { bf16_t* p = F_CKV + (size_t)r * 256; float x[4]; float s = 0.f;
#pragma unroll
          for (int j = 0; j < 4; ++j) { x[j] = bf2f(p[lane + 64 * j]); s += x[j] * x[j]; }
          const float rstd = 1.0f / sqrtf(wave_sum(s) * (1.0f / 256.f) + EPS);
#pragma unroll
          for (int j = 0; j < 4; ++j) p[lane + 64 * j] = (bf16_t)f2bf(x[j] * rstd * kvag[lane + 64 * j]); }
        { bf16_t* p = F_KR + (size_t)r * 32; const int d = lane & 31; const float x = lane < 32 ? bf2f(p[d]) : 0.f;
          const float rstd = 1.0f / sqrtf(wave_sum(x * x) * (1.0f / 32.f) + EPS);
          float y = x * rstd * krg[d]; const float yp = __shfl_xor(y, 8);
          if (r < ML) y = rope_elem(F_ROPE + (size_t)(r & (SEQ - 1)) * 32, d, y, yp);
          if (lane < 32) p[d] = (bf16_t)f2bf(y); }
        { bf16_t* p = F_UV + (size_t)r * 1024 + 512; float x[8]; float s = 0.f;
#pragma unroll
          for (int j = 0; j < 8; ++j) { x[j] = bf2f(p[lane + 64 * j]); s += x[j]; }
          const float mu = wave_sum(s) * (1.0f / 512.f); float q = 0.f;
#pragma unroll
          for (int j = 0; j < 8; ++j) { x[j] -= mu; q += x[j] * x[j]; }
          const float rstd = 1.0f / sqrtf(wave_sum(q) * (1.0f / 512.f) + EPS);
#pragma unroll
          for (int j = 0; j < 8; ++j) p[lane + 64 * j] = (bf16_t)f2bf(x[j] * rstd * lng[lane + 64 * j] + lnb[lane + 64 * j]); }
    }
}

__device__ __forceinline__ void p_mlaup_naive(Frame& F, int l) {
    float* sA = (float*)F.lds; float* sW = sA + 128 * 33;
    const int ty = F.tid >> 4, tx = F.tid & 15;
    constexpr int NT_M = M / 128, NQ = 768 / 64, NKV = 1024 / 64;
    for (int t = F.bid; t < NT_M * (NQ + NKV); t += F.G) {
        const int tm = t / (NQ + NKV), tn = t % (NQ + NKV); float acc[4][4]; ZERO_ACC(acc);
        if (tn < NQ) {
            ngemm_acc(acc, F_CQ, 384, nullptr, tm * 128, M, FIN(I_WUQ) + (size_t)l * 384 * 768, 768, tn * 64, 768, 384, sA, sW, F.tid);
#pragma unroll
            for (int i = 0; i < 4; ++i)
#pragma unroll
                for (int j = 0; j < 4; ++j) F_Q[(size_t)(tm * 128 + ty * 4 + i) * 768 + tn * 64 + tx * 4 + j] = (bf16_t)f2bf(acc[i][j]);
        } else {
            const int tk = tn - NQ;
            ngemm_acc(acc, F_CKV, 256, nullptr, tm * 128, M, FIN(I_WUKV) + (size_t)l * 256 * 1024, 1024, tk * 64, 1024, 256, sA, sW, F.tid);
#pragma unroll
            for (int i = 0; i < 4; ++i)
#pragma unroll
                for (int j = 0; j < 4; ++j) F_KVR[(size_t)(tm * 128 + ty * 4 + i) * 1024 + tk * 64 + tx * 4 + j] = (bf16_t)f2bf(acc[i][j]);
        }
    }
}
__device__ __forceinline__ void p_rowpass_b(Frame& F, int l) {
    const int gw = F.bid * NWAVES + F.wave, NGW = F.G * NWAVES, lane = F.lane;
    const float* qng = FIN(I_QNG) + l * 96; const float* kng = FIN(I_KNG) + l * 64;
    for (int r = gw; r < M; r += NGW) {
        const float* tab = F_ROPE + (size_t)(r & (SEQ - 1)) * 32;
        const float krv = lane < 32 ? bf2f(F_KR[(size_t)r * 32 + lane]) : 0.f;
        for (int h = 0; h < 8; ++h) {
            bf16_t* q = F_Q + (size_t)r * 768 + h * 96;
            const float x0 = bf2f(q[lane]), x1 = lane < 32 ? bf2f(q[64 + lane]) : 0.f;
            const float rstd = 1.0f / sqrtf(wave_sum(x0 * x0 + x1 * x1) * (1.0f / 96.f) + EPS);
            const float y0 = x0 * rstd * qng[lane]; float y1 = x1 * rstd * qng[64 + (lane & 31)];
            const float yp = __shfl_xor(y1, 8);
            if (r < ML) y1 = rope_elem(tab, lane & 31, y1, yp);
            q[lane] = (bf16_t)f2bf(y0 * QSCALE); if (lane < 32) q[64 + lane] = (bf16_t)f2bf(y1 * QSCALE);
            const bf16_t* kv = F_KVR + (size_t)r * 1024 + h * 128;
            const float k0 = bf2f(kv[lane]);
            const float rk = 1.0f / sqrtf(wave_sum(k0 * k0) * (1.0f / 64.f) + EPS);
            bf16_t* ko = F_K + (size_t)r * 768 + h * 96;
            ko[lane] = (bf16_t)f2bf(k0 * rk * kng[lane]); if (lane < 32) ko[64 + lane] = (bf16_t)f2bf(krv);
            F_V[(size_t)r * 512 + h * 64 + lane] = kv[64 + lane];
        }
    }
}

__device__ __forceinline__ void attn_unit_naive(Frame& F, int h, int qrow0, int kr0, int kn0, int kr1, int kn1) {
    float* sQ = (float*)F.lds;
    float* sK = sQ + 32 * 97;
    float* sV = sK + 64 * 97;
    float* sS = sV + 64 * 64;
    float* sM = sS + 32 * 65;
    const int tid = F.tid;
    __syncthreads();
    for (int i = tid; i < 32 * 96; i += NTHR) { const int rr = i / 96, d = i % 96; sQ[rr * 97 + d] = bf2f(F_Q[(size_t)(qrow0 + rr) * 768 + h * 96 + d]); }
    if (tid < 32) { sM[tid] = -INFINITY; sM[32 + tid] = 0.f; sM[64 + tid] = 0.f; }
    float o[4] = {0.f, 0.f, 0.f, 0.f};
    const int srow = tid >> 4, scol = tid & 15;
    const int orow = (tid >> 6) * 4, ocol = tid & 63;
    const int ntile = (kn0 + kn1) / 64;
    for (int kt = 0; kt < ntile; ++kt) {
        const int j0 = kt * 64; const int krow = j0 < kn0 ? kr0 + j0 : kr1 + (j0 - kn0);
        __syncthreads();
        for (int i = tid; i < 64 * 96; i += NTHR) { const int rr = i / 96, d = i % 96; sK[rr * 97 + d] = bf2f(F_K[(size_t)(krow + rr) * 768 + h * 96 + d]); }
        for (int i = tid; i < 64 * 64; i += NTHR) { const int rr = i >> 6, d = i & 63; sV[rr * 64 + d] = bf2f(F_V[(size_t)(krow + rr) * 512 + h * 64 + d]); }
        __syncthreads();
        float s[4] = {0.f, 0.f, 0.f, 0.f};
        for (int d = 0; d < 96; ++d) { const float qv = sQ[srow * 97 + d];
#pragma unroll
            for (int jj = 0; jj < 4; ++jj) s[jj] += qv * sK[(scol + 16 * jj) * 97 + d]; }
#pragma unroll
        for (int jj = 0; jj < 4; ++jj) sS[srow * 65 + scol + 16 * jj] = s[jj];
        __syncthreads();
        if (tid < 32) { float mx = sM[tid];
            for (int j = 0; j < 64; ++j) mx = fmaxf(mx, sS[tid * 65 + j]);
            const float al = exp2f(sM[tid] - mx); float ls = 0.f;
            for (int j = 0; j < 64; ++j) { const float p = exp2f(sS[tid * 65 + j] - mx); sS[tid * 65 + j] = p; ls += p; }
            sM[tid] = mx; sM[32 + tid] = sM[32 + tid] * al + ls; sM[64 + tid] = al; }
        __syncthreads();
#pragma unroll
        for (int i = 0; i < 4; ++i) { float a = o[i] * sM[64 + orow + i];
            for (int j = 0; j < 64; ++j) a += sS[(orow + i) * 65 + j] * sV[j * 64 + ocol];
            o[i] = a; }
    }
#pragma unroll
    for (int i = 0; i < 4; ++i) F_AO[(size_t)(qrow0 + orow + i) * 512 + h * 64 + ocol] = (bf16_t)f2bf(o[i] / sM[32 + orow + i]);
}

__device__ __forceinline__ void ret_unit_naive(Frame& F, int l, int b, int h, int qpos0, bool isctx) {
    float* sQ = (float*)F.lds;
    float* sK = sQ + 32 * 129;
    float* sV = sK + 64 * 129;
    float* sS = sV + 64 * 128;
    float* sT = sS + 32 * 65;
    const int tid = F.tid;
    const float df = FIN(I_DECF)[l * 4 + h], db = FIN(I_DECB)[l * 4 + h];
    const float lf = -log1pf(expf(-df)) * 1.4426950408889634f, lb = -log1pf(expf(-db)) * 1.4426950408889634f;
    const int qrow0 = isctx ? ML + b * CTX + qpos0 : b * SEQ + qpos0;
    __syncthreads();
    for (int i = tid; i < 32 * 128; i += NTHR) { const int rr = i >> 7, d = i & 127; sQ[rr * 129 + d] = bf2f(F_RET[(size_t)(qrow0 + rr) * 2048 + h * 128 + d]); }
    float o[8];
#pragma unroll
    for (int i = 0; i < 8; ++i) o[i] = 0.f;
    const int srow = tid >> 4, scol = tid & 15;
    const int orow = (tid >> 7) * 8, ocol = tid & 127;
    const int ntile = isctx ? CTX / 64 : (CTX + SEQ) / 64;
    for (int kt = 0; kt < ntile; ++kt) {
        const int j0 = kt * 64; const bool kctx = j0 < CTX;
        const int kpos0 = kctx ? j0 : j0 - CTX; const int krow = kctx ? ML + b * CTX + kpos0 : b * SEQ + kpos0;
        __syncthreads();
        for (int i = tid; i < 64 * 128; i += NTHR) { const int rr = i >> 7, d = i & 127;
            sK[rr * 129 + d] = bf2f(F_RET[(size_t)(krow + rr) * 2048 + 512 + h * 128 + d]);
            sV[rr * 128 + d] = bf2f(F_RET[(size_t)(krow + rr) * 2048 + 1024 + h * 128 + d]); }
        __syncthreads();
        float s[4] = {0.f, 0.f, 0.f, 0.f};
        for (int d = 0; d < 128; ++d) { const float qv = sQ[srow * 129 + d];
#pragma unroll
            for (int jj = 0; jj < 4; ++jj) s[jj] += qv * sK[(scol + 16 * jj) * 129 + d]; }
        const int i_ = qpos0 + srow;
#pragma unroll
        for (int jj = 0; jj < 4; ++jj) { const int j_ = kpos0 + scol + 16 * jj; float w;
            if (isctx == kctx) w = (j_ <= i_) ? exp2f(lf * (float)(i_ - j_)) : exp2f(lb * (float)(j_ - i_));
            else w = exp2f(lf * (float)(i_ + CTX - j_)) + exp2f(lb * (float)(SEQ - i_ + j_));
            sS[srow * 65 + scol + 16 * jj] = s[jj] * w; }
        __syncthreads();
#pragma unroll
        for (int i = 0; i < 8; ++i) { float a = o[i];
            for (int j = 0; j < 64; ++j) a += sS[(orow + i) * 65 + j] * sV[j * 128 + ocol];
            o[i] = a; }
    }
    __syncthreads();
    float* sO = sK;
#pragma unroll
    for (int i = 0; i < 8; ++i) sO[(orow + i) * 129 + ocol] = o[i];
    __syncthreads();
    if (tid < 32) { float mu = 0.f; for (int d = 0; d < 128; ++d) mu += sO[tid * 129 + d]; mu *= (1.0f / 128.f);
        float q = 0.f; for (int d = 0; d < 128; ++d) { const float dd = sO[tid * 129 + d] - mu; q += dd * dd; }
        sT[tid] = mu; sT[32 + tid] = 1.0f / sqrtf(q * (1.0f / 128.f) + EPS); }
    __syncthreads();
    const float gg = FIN(I_GNG)[l * 512 + h * 128 + ocol], gb = FIN(I_GNB)[l * 512 + h * 128 + ocol];
#pragma unroll
    for (int i = 0; i < 8; ++i) { const int rr = orow + i; const size_t base = (size_t)(qrow0 + rr) * 2048 + h * 128 + ocol;
        const float gate = bf2f(F_RET[base + 1536]);
        F_RET[base] = (bf16_t)f2bf(siluf_(gate) * ((o[i] - sT[rr]) * sT[32 + rr] * gg + gb)); }
}

__device__ __forceinline__ void gmlp_unit_naive(Frame& F, int l, int cidx, int g) {
    float* sV = (float*)F.lds;
    float* sW = sV + 128 * 128;
    const int tid = F.tid, r0 = cidx * 128;
    const float* ws = FIN(I_GWS) + ((size_t)l * 4 + g) * 128 * 128; const float* bs = FIN(I_GBS) + (l * 4 + g) * 128;
    __syncthreads();
    for (int i = tid; i < 128 * 128; i += NTHR) { const int rr = i >> 7, c = i & 127;
        sV[rr * 128 + c] = bf2f(F_UV[(size_t)(r0 + rr) * 1024 + 512 + g * 128 + c]); sW[rr * 129 + c] = ws[i]; }
    __syncthreads();
    const int ig = (tid >> 7) * 32, c = tid & 127;
    for (int i = ig; i < ig + 32; ++i) { float a = bs[i];
        for (int j = 0; j < 128; ++j) a += sW[i * 129 + j] * sV[j * 128 + c];
        bf16_t* up = F_UV + (size_t)(r0 + i) * 1024 + g * 128 + c; *up = (bf16_t)f2bf(bf2f(*up) * a); }
}

__device__ __forceinline__ void p_merge_naive(Frame& F, int l, int nrows) {
    float* sA = (float*)F.lds; float* sW = sA + 128 * 33;
    const int ty = F.tid >> 4, tx = F.tid & 15;
    const float* Win = FIN(I_WIN) + (size_t)l * D * N_IN;
    const int ntm = nrows / 128;
    for (int t = F.bid; t < ntm * 16; t += F.G) {
        const int tm = t >> 4, tn = t & 15; float y[4][4]; ZERO_ACC(y);
#pragma unroll 1
        for (int br = 0; br < 3; ++br) {
            float g[4][4]; ZERO_ACC(g); float a[4][4]; ZERO_ACC(a);
            ngemm_acc(g, F_H, D, nullptr, tm * 128, nrows, Win + OFF_MERGE + br * 1024, N_IN, tn * 64, 1024, D, sA, sW, F.tid);
            const bf16_t* A = br == 0 ? F_RET : (br == 1 ? F_AO : F_UV); const int lda = br == 0 ? 2048 : (br == 1 ? 512 : 1024);
            const float* Wb = FIN(br == 0 ? I_WBRRET : (br == 1 ? I_WBRMLA : I_WBRG)) + (size_t)l * 512 * D;
            ngemm_acc(a, A, lda, nullptr, tm * 128, nrows, Wb, D, tn * 64, 1024, 512, sA, sW, F.tid);
#pragma unroll
            for (int i = 0; i < 4; ++i)
#pragma unroll
                for (int j = 0; j < 4; ++j) y[i][j] += sigmoidf_(g[i][j]) * a[i][j];
        }
#pragma unroll
        for (int i = 0; i < 4; ++i)
#pragma unroll
            for (int j = 0; j < 4; ++j) F_Y[(size_t)(tm * 128 + ty * 4 + i) * D + tn * 64 + tx * 4 + j] = (bf16_t)f2bf(y[i][j]);
    }
}
__device__ __forceinline__ void p_out_naive(Frame& F, int l, int nrows) {
    float* sA = (float*)F.lds; float* sW = sA + 128 * 33;
    const int ty = F.tid >> 4, tx = F.tid & 15;
    const int ntm = nrows / 128;
    for (int t = F.bid; t < ntm * 16; t += F.G) {
        const int tm = t >> 4, tn = t & 15; float acc[4][4]; ZERO_ACC(acc);
        ngemm_acc(acc, F_Y, D, nullptr, tm * 128, nrows, FIN(I_WOUT) + (size_t)l * D * D, D, tn * 64, D, D, sA, sW, F.tid);
#pragma unroll
        for (int i = 0; i < 4; ++i) { const int r = tm * 128 + ty * 4 + i; const float* xs = x_row_src(F, l, r); float* xd = x_row_dst(F, r);
            const float* ga = F_MOD + ((size_t)l * 5 + row_batch(r)) * 6144 + 2 * D;
#pragma unroll
            for (int j = 0; j < 4; ++j) { const int c = tn * 64 + tx * 4 + j; xd[c] = xs[c] + ga[c] * acc[i][j]; } }
    }
}

__device__ __forceinline__ void p_router(Frame& F, int l, int ntok) {
    int* hist = (int*)F.lds;
    const int gw = F.bid * NWAVES + F.wave, NGW = F.G * NWAVES, lane = F.lane;
    __syncthreads();
    if (F.tid < 64) hist[F.tid] = 0;
    __syncthreads();
    const float* R = FIN(I_ROUTER) + (size_t)l * D * NEXP; const float bias = FIN(I_MBIAS)[l * NEXP + lane];
    for (int r = gw; r < ntok; r += NGW) {
        const bf16_t* hrow = F_H + (size_t)r * D; float a = 0.f;
        for (int k = 0; k < D; k += 8) { const uint4 hv = *(const uint4*)(hrow + k);
            a += __builtin_bit_cast(float, hv.x << 16) * R[(k + 0) * NEXP + lane]; a += __builtin_bit_cast(float, hv.x & 0xffff0000u) * R[(k + 1) * NEXP + lane];
            a += __builtin_bit_cast(float, hv.y << 16) * R[(k + 2) * NEXP + lane]; a += __builtin_bit_cast(float, hv.y & 0xffff0000u) * R[(k + 3) * NEXP + lane];
            a += __builtin_bit_cast(float, hv.z << 16) * R[(k + 4) * NEXP + lane]; a += __builtin_bit_cast(float, hv.z & 0xffff0000u) * R[(k + 5) * NEXP + lane];
            a += __builtin_bit_cast(float, hv.w << 16) * R[(k + 6) * NEXP + lane]; a += __builtin_bit_cast(float, hv.w & 0xffff0000u) * R[(k + 7) * NEXP + lane]; }
        const float score = sigmoidf_(a); float sel = score + bias;
        float wk[TOPK]; int ek[TOPK]; float wsum = 0.f;
#pragma unroll
        for (int k = 0; k < TOPK; ++k) {
            float bv = sel; int bi = lane;
#pragma unroll
            for (int o = 1; o < 64; o <<= 1) { const float ov = __shfl_xor(bv, o); const int oi = __shfl_xor(bi, o); if (ov > bv || (ov == bv && oi < bi)) { bv = ov; bi = oi; } }
            ek[k] = bi; wk[k] = __shfl(score, bi); wsum += wk[k]; if (lane == bi) sel = -INFINITY;
        }
        if (lane == 0) {
#pragma unroll
            for (int k = 0; k < TOPK; ++k) { F_IDX[r * TOPK + k] = ek[k]; F_WTS[r * TOPK + k] = wk[k] / wsum * 2.5f; F_SLOT[r * TOPK + k] = atomicAdd(&hist[ek[k]], 1) | (F.bid << 20); }
        }
    }
    __syncthreads();
    if (F.tid < 64) F_BLKBASE[(l * 256 + F.bid) * 64 + F.tid] = (int)atomicAdd(F_ctl + CW_CNT + l * 64 + F.tid, (unsigned)hist[F.tid]);
    for (int i = F.bid * NTHR + F.tid; i < APAD; i += F.G * NTHR) F_ROWTOK[i] = 0;
}
__device__ __forceinline__ void moe_offsets(Frame& F, int l, int* ps) {
    __syncthreads();
    if (F.tid < 64) { const int e = F.tid; const int c = (int)F_ctl[CW_CNT + l * 64 + e]; const int n = ((c + 255) >> 8) << 8; int incl = n;
#pragma unroll
        for (int o = 1; o < 64; o <<= 1) { const int v = __builtin_amdgcn_ds_bpermute(((e - o) & 63) << 2, incl); if (e >= o) incl += v; }
        ps[e] = incl - n; ps[65 + e] = c; if (e == 63) ps[64] = incl; }
    __syncthreads();
}
__device__ __forceinline__ void p_scatter(Frame& F, int l, int ntok) {
    int* ps = (int*)F.lds; moe_offsets(F, l, ps);
    for (int i = F.bid * NTHR + F.tid; i < ntok * TOPK; i += F.G * NTHR) {
        const int r = i / TOPK; const int e = F_IDX[i]; const int sl = F_SLOT[i]; const int blk = sl >> 20;
        const int row = ps[e] + F_BLKBASE[(l * 256 + blk) * 64 + e] + (sl & 0xFFFFF);
        F_ROWTOK[row] = r; F_INV[i] = row;
    }
}
__device__ __forceinline__ void p_moe_gateup_naive(Frame& F, int l, int ntok) {
    int* ps = (int*)F.lds; moe_offsets(F, l, ps);
    float* sA = (float*)(F.lds + 1024); float* sW = sA + 128 * 33;
    const int ty = F.tid >> 4, tx = F.tid & 15;
    int tbase = 0, t = F.bid;
    for (int e = 0; e < NEXP; ++e) {
        const int cnt = ps[65 + e], nt = ((cnt + 127) >> 7) * 4;
        for (; t < tbase + nt; t += F.G) {
            const int tt = t - tbase, tm = tt >> 2, tn = tt & 3; float g[4][4], u[4][4]; ZERO_ACC(g); ZERO_ACC(u);
            const float* Wg = FIN(I_WG) + ((size_t)l * NEXP + e) * D * DEXP; const float* Wu = FIN(I_WU) + ((size_t)l * NEXP + e) * D * DEXP;
            ngemm_acc(g, F_H, D, F_ROWTOK + ps[e], tm * 128, cnt, Wg, DEXP, tn * 64, DEXP, D, sA, sW, F.tid);
            ngemm_acc(u, F_H, D, F_ROWTOK + ps[e], tm * 128, cnt, Wu, DEXP, tn * 64, DEXP, D, sA, sW, F.tid);
#pragma unroll
            for (int i = 0; i < 4; ++i) { const int rr = tm * 128 + ty * 4 + i; if (rr >= cnt) continue;
#pragma unroll
                for (int j = 0; j < 4; ++j) F_HB[(size_t)(ps[e] + rr) * DEXP + tn * 64 + tx * 4 + j] = (bf16_t)f2bf(siluf_(g[i][j]) * u[i][j]); }
        }
        tbase += nt;
    }
    const int ntm = ntok / 128;
    for (int t = F.bid; t < ntm * 4; t += F.G) {
        const int tm = t >> 2, tn = t & 3; float g[4][4], u[4][4]; ZERO_ACC(g); ZERO_ACC(u);
        ngemm_acc(g, F_H, D, nullptr, tm * 128, ntok, FIN(I_SG) + (size_t)l * D * DEXP, DEXP, tn * 64, DEXP, D, sA, sW, F.tid);
        ngemm_acc(u, F_H, D, nullptr, tm * 128, ntok, FIN(I_SU) + (size_t)l * D * DEXP, DEXP, tn * 64, DEXP, D, sA, sW, F.tid);
#pragma unroll
        for (int i = 0; i < 4; ++i)
#pragma unroll
            for (int j = 0; j < 4; ++j) F_HBS[(size_t)(tm * 128 + ty * 4 + i) * DEXP + tn * 64 + tx * 4 + j] = (bf16_t)f2bf(siluf_(g[i][j]) * u[i][j]);
    }
}
__device__ __forceinline__ void p_moe_down_naive(Frame& F, int l, int ntok, int c0) {
    int* ps = (int*)F.lds; moe_offsets(F, l, ps);
    float* sA = (float*)(F.lds + 1024); float* sW = sA + 128 * 33;
    const int ty = F.tid >> 4, tx = F.tid & 15;
    int tbase = 0, t = F.bid;
    for (int e = 0; e < NEXP; ++e) {
        const int cnt = ps[65 + e], nt = ((cnt + 127) >> 7) * 8;
        for (; t < tbase + nt; t += F.G) {
            const int tt = t - tbase, tm = tt >> 3, tn = tt & 7; float acc[4][4]; ZERO_ACC(acc);
            const float* Wd = FIN(I_WD) + ((size_t)l * NEXP + e) * DEXP * D;
            ngemm_acc(acc, F_HB + (size_t)ps[e] * DEXP, DEXP, nullptr, tm * 128, cnt, Wd, D, c0 + tn * 64, D, DEXP, sA, sW, F.tid);
#pragma unroll
            for (int i = 0; i < 4; ++i) { const int rr = tm * 128 + ty * 4 + i; if (rr >= cnt) continue;
#pragma unroll
                for (int j = 0; j < 4; ++j) F_OUT[(size_t)(ps[e] + rr) * 512 + tn * 64 + tx * 4 + j] = (bf16_t)f2bf(acc[i][j]); }
        }
        tbase += nt;
    }
    if (c0 == 0) {
        const int ntm = ntok / 128;
        for (int t = F.bid; t < ntm * 16; t += F.G) {
            const int tm = t >> 4, tn = t & 15; float acc[4][4]; ZERO_ACC(acc);
            ngemm_acc(acc, F_HBS, DEXP, nullptr, tm * 128, ntok, FIN(I_SD) + (size_t)l * DEXP * D, D, tn * 64, D, DEXP, sA, sW, F.tid);
#pragma unroll
            for (int i = 0; i < 4; ++i) { const int r = tm * 128 + ty * 4 + i; float* xd = x_row_dst(F, r);
                const float* gf = F_MOD + ((size_t)l * 5 + row_batch(r)) * 6144 + 5 * D;
#pragma unroll
                for (int j = 0; j < 4; ++j) { const int c = tn * 64 + tx * 4 + j; xd[c] += gf[c] * acc[i][j]; } }
        }
    }
}
typedef float f32x2_t __attribute__((ext_vector_type(2)));
__device__ __forceinline__ void acc16(f32x2_t (&s)[8], float w, const g8::u32x4& v) {
    const f32x2_t w2 = {w, w};
#pragma unroll
    for (int q = 0; q < 4; ++q) { const f32x2_t lo = __builtin_amdgcn_cvt_pk_f32_fp8(v[q], false), hi = __builtin_amdgcn_cvt_pk_f32_fp8(v[q], true);
        s[2 * q] = __builtin_elementwise_fma(w2, lo, s[2 * q]); s[2 * q + 1] = __builtin_elementwise_fma(w2, hi, s[2 * q + 1]); } }
template <bool NORM_NEXT> __device__ __forceinline__ void p_combine(Frame& F, int l, int ntok) {
    const int gw = F.bid * NWAVES + F.wave, NGW = F.G * NWAVES, lane = F.lane;
    const float* g1 = NORM_NEXT ? FIN(I_N1G) + (l + 1) * D : nullptr;
    const unsigned char* OUT8 = (const unsigned char*)F_OUT;
    LAS int* tabI = (LAS int*)((LAS unsigned char*)F.lds) + F.wave * 512; LAS float* tabW = (LAS float*)(tabI + 256);
    constexpr int NLB = ML / 16;
    const int nseg = NLB + (ntok > ML ? ntok - ML : 0);
    for (int seg = gw; seg < nseg; seg += NGW) {
        const int r0 = seg < NLB ? seg * 16 : ML + (seg - NLB), n = seg < NLB ? 16 : 1;
        int l16 = lane * 16; asm volatile("" : "+v"(l16));
        for (int e = lane; e < n * TOPK; e += 64) { tabI[e] = F_INV[r0 * TOPK + e]; tabW[e] = F_WTS[r0 * TOPK + e]; }
        const int bt = row_batch(r0);
        g8::f32x4 gt[4], gs[4], sh[4];
        { const float* gf = F_MOD + ((size_t)l * 5 + bt) * 6144 + 5 * D + l16;
#pragma unroll
          for (int q = 0; q < 4; ++q) gt[q] = *(const g8::f32x4*)(gf + 4 * q);
          if constexpr (NORM_NEXT) { const float* mod = F_MOD + ((size_t)(l + 1) * 5 + bt) * 6144 + l16;
#pragma unroll
              for (int q = 0; q < 4; ++q) { sh[q] = *(const g8::f32x4*)(mod + 4 * q); gs[q] = *(const g8::f32x4*)(g1 + l16 + 4 * q) * (*(const g8::f32x4*)(mod + D + 4 * q) + 1.0f); } } }
        asm volatile("s_waitcnt vmcnt(0) lgkmcnt(0)" ::: "memory");
        for (int j = 0; j < n; j += 2) {
            const bool hb = j + 1 < n; const int ra = r0 + j, jb = hb ? j + 1 : j, rb_ = r0 + jb;
            bf16_t* xa = F_X16 + (size_t)ra * D + l16; bf16_t* xb = F_X16 + (size_t)rb_ * D + l16;
            int ia[TOPK], ib[TOPK]; float wa[TOPK], wb[TOPK];
#pragma unroll
            for (int k = 0; k < TOPK; ++k) { ia[k] = tabI[j * TOPK + k]; ib[k] = tabI[jb * TOPK + k]; wa[k] = tabW[j * TOPK + k]; wb[k] = tabW[jb * TOPK + k]; }
            g8::u32x4 va[TOPK], vb[TOPK];
#pragma unroll
            for (int k = 0; k < TOPK; ++k) { va[k] = *(const g8::u32x4*)(OUT8 + (size_t)ia[k] * 1024 + l16); vb[k] = *(const g8::u32x4*)(OUT8 + (size_t)ib[k] * 1024 + l16); }
            const bf16_t* shp = FWS(bf16_t, WS_SCR) + l16; const g8::u32x4 sha0 = *(const g8::u32x4*)(shp + (size_t)ra * 1024), sha1 = *(const g8::u32x4*)(shp + (size_t)ra * 1024 + 8), shb0 = *(const g8::u32x4*)(shp + (size_t)rb_ * 1024), shb1 = *(const g8::u32x4*)(shp + (size_t)rb_ * 1024 + 8);
            const g8::u32x4 xa0 = *(const g8::u32x4*)xa, xa1 = *(const g8::u32x4*)(xa + 8), xb0 = *(const g8::u32x4*)xb, xb1 = *(const g8::u32x4*)(xb + 8);
            f32x2_t sa2[8], sb2[8];
#pragma unroll
            for (int i = 0; i < 8; ++i) { sa2[i] = (f32x2_t){0.f, 0.f}; sb2[i] = (f32x2_t){0.f, 0.f}; }
#pragma unroll
            for (int k = 0; k < TOPK; ++k) { acc16(sa2, wa[k], va[k]); acc16(sb2, wb[k], vb[k]); }
            float sa[16], sb[16];
#pragma unroll
            for (int i = 0; i < 8; ++i) { sa[2 * i] = sa2[i][0]; sa[2 * i + 1] = sa2[i][1]; sb[2 * i] = sb2[i][0]; sb[2 * i + 1] = sb2[i][1]; }
            { g8::f32x4 a0, a1; g8::unpack8(sha0, a0, a1); _Pragma("unroll") for (int i = 0; i < 4; ++i) { sa[i] += a0[i]; sa[4 + i] += a1[i]; } g8::unpack8(sha1, a0, a1); _Pragma("unroll") for (int i = 0; i < 4; ++i) { sa[8 + i] += a0[i]; sa[12 + i] += a1[i]; }
              g8::unpack8(shb0, a0, a1); _Pragma("unroll") for (int i = 0; i < 4; ++i) { sb[i] += a0[i]; sb[4 + i] += a1[i]; } g8::unpack8(shb1, a0, a1); _Pragma("unroll") for (int i = 0; i < 4; ++i) { sb[8 + i] += a0[i]; sb[12 + i] += a1[i]; } }
            g8::f32x4 xav[4], xbv[4];
            g8::unpack8(xa0, xav[0], xav[1]); g8::unpack8(xa1, xav[2], xav[3]); g8::unpack8(xb0, xbv[0], xbv[1]); g8::unpack8(xb1, xbv[2], xbv[3]);
#pragma unroll
            for (int q = 0; q < 4; ++q)
#pragma unroll
                for (int i = 0; i < 4; ++i) { xav[q][i] += gt[q][i] * sa[4 * q + i]; xbv[q][i] += gt[q][i] * sb[4 * q + i]; }
            if constexpr (!NORM_NEXT) {
#pragma unroll
                for (int q = 0; q < 4; ++q) { *(g8::f32x4*)(F_out + (size_t)ra * D + l16 + 4 * q) = xav[q]; if (hb) *(g8::f32x4*)(F_out + (size_t)rb_ * D + l16 + 4 * q) = xbv[q]; }
            } else {
                *(g8::u32x4*)xa = g8::pack8(xav[0], xav[1]); *(g8::u32x4*)(xa + 8) = g8::pack8(xav[2], xav[3]);
                if (hb) { *(g8::u32x4*)xb = g8::pack8(xbv[0], xbv[1]); *(g8::u32x4*)(xb + 8) = g8::pack8(xbv[2], xbv[3]); }
#pragma unroll
                for (int t = 0; t < 2; ++t) { if (t == 1 && !hb) break; const int r = t ? rb_ : ra;
                    const g8::f32x4 v0 = t ? xbv[0] : xav[0], v1 = t ? xbv[1] : xav[1], v2 = t ? xbv[2] : xav[2], v3 = t ? xbv[3] : xav[3];
                    const float rstd = 1.0f / sqrtf(wave_sum(sumsq8(v0, v1) + sumsq8(v2, v3)) * (1.0f / D) + EPS);
                    *(g8::u32x4*)(F_H + (size_t)r * D + l16) = g8::pack8(v0 * rstd * gs[0] + sh[0], v1 * rstd * gs[1] + sh[1]);
                    *(g8::u32x4*)(F_H + (size_t)r * D + l16 + 8) = g8::pack8(v2 * rstd * gs[2] + sh[2], v3 * rstd * gs[3] + sh[3]); }
            }
        }
    }
}
__device__ __forceinline__ void cvt_item(const float* W, int ldw, int k0, int n0, bf16_t* dst  , int ldt, LAS float* scr, int lane, const float* gk = nullptr  ) {
#pragma unroll 8
    for (int i = 0; i < 32; ++i) { const int kk = 2 * i + (lane >> 5); scr[kk * 33 + (lane & 31)] = W[(size_t)(k0 + kk) * ldw + n0 + (lane & 31)] * (gk ? gk[k0 + kk] : 1.0f); }
    asm volatile("s_waitcnt lgkmcnt(0)" ::: "memory");
    const int c = lane & 7;
#pragma unroll
    for (int j = 0; j < 4; ++j) { const int n = (lane >> 3) + 8 * j; const LAS float* s = scr + (8 * c) * 33 + n;
        uint4 o; o.x = g8::cvtpk(s[0 * 33], s[1 * 33]); o.y = g8::cvtpk(s[2 * 33], s[3 * 33]); o.z = g8::cvtpk(s[4 * 33], s[5 * 33]); o.w = g8::cvtpk(s[6 * 33], s[7 * 33]);
        *(uint4*)(dst + (size_t)n * ldt + k0 + 8 * c) = o; }
    asm volatile("s_waitcnt lgkmcnt(0)" ::: "memory");
}
#define CVT_JOBG(Wp, Kk, ldw_, c0_, ncols_, dstp, gk_) do { const int _nb = (ncols_) / 32, _ni = ((Kk) / 64) * _nb; \
    if (it < _ni) { const int _kb = it / _nb, _nbi = it % _nb; cvt_item((Wp), (ldw_), 64 * _kb, (c0_) + 32 * _nbi, (dstp) + (size_t)(32 * _nbi) * (Kk), (Kk), scr, lane, (gk_)); return; } it -= _ni; } while (0)
#define CVT_JOB(Wp, Kk, ldw_, c0_, ncols_, dstp) do { const int _nb = (ncols_) / 32, _ni = ((Kk) / 64) * _nb; \
    if (it < _ni) { const int _kb = it / _nb, _nbi = it % _nb; cvt_item((Wp), (ldw_), 64 * _kb, (c0_) + 32 * _nbi, (dstp) + (size_t)(32 * _nbi) * (Kk), (Kk), scr, lane); return; } it -= _ni; } while (0)
constexpr int CVT_SMALL_ITEMS = 16 * 5 + 6 * 24 + 4 * 32 + 2 * 16 * 8;
__device__ __forceinline__ void cvt_small_item(Frame& F, int l, int it, LAS float* scr, int lane) {
    unsigned char* base = ws_(F.A) + WS_WSM + (size_t)l * SMW_L;
    const float* win = FIN(I_WIN) + (size_t)l * D * N_IN;
    CVT_JOB(win, 1024, N_IN, 2560, 160, (bf16_t*)(base + SMW_WIN) + (size_t)2560 * 1024);
#pragma unroll
    for (int hh = 0; hh < 8; ++hh) CVT_JOBG(FIN(I_WUQ) + (size_t)l * 384 * 768, 384, 768, hh * 96, 96, (bf16_t*)(base + SMW_WUQ) + (size_t)hh * 128 * 384, FIN(I_QAG) + l * 384);
    CVT_JOBG(FIN(I_WUKV) + (size_t)l * 256 * 1024, 256, 1024, 0, 1024, (bf16_t*)(base + SMW_WUKV), FIN(I_KVAG) + l * 256);
    CVT_JOB(FIN(I_SG) + (size_t)l * D * DEXP, 1024, DEXP, 0, 128, (bf16_t*)(base + SMW_SHGU));
    CVT_JOB(FIN(I_SG) + (size_t)l * D * DEXP, 1024, DEXP, 128, 128, (bf16_t*)(base + SMW_SHGU) + (size_t)256 * 1024);
    CVT_JOB(FIN(I_SU) + (size_t)l * D * DEXP, 1024, DEXP, 0, 128, (bf16_t*)(base + SMW_SHGU) + (size_t)128 * 1024);
    CVT_JOB(FIN(I_SU) + (size_t)l * D * DEXP, 1024, DEXP, 128, 128, (bf16_t*)(base + SMW_SHGU) + (size_t)384 * 1024);
}
struct CvtPanel { const float* W; int ldw; bf16_t* dst0; int ldt; int gu_map, up; };
constexpr int CVT_SMALL_PANELS = 160 + 64 + 192 + 96 + 64 + 16;
__device__ __forceinline__ CvtPanel cvt_small_panel(Frame& F, int itg) {
    const int l = itg / CVT_SMALL_PANELS; int p = itg % CVT_SMALL_PANELS; CvtPanel c; c.gu_map = 0; c.up = 0;
    unsigned char* base = ws_(F.A) + WS_WSM + (size_t)l * SMW_L;
    const float* W; int K, ldw, c0, nb; bf16_t* dst;
    if (p < 416) { W = FIN(I_WIN) + (size_t)l * D * N_IN; K = 1024; ldw = N_IN;
        if (p < 160) { c0 = 0; nb = 10; dst = (bf16_t*)(base + SMW_WIN); }
        else if (p < 224) { p -= 160; c0 = 2720; nb = 4; dst = (bf16_t*)(base + SMW_WIN) + (size_t)2816 * 1024; }
        else { p -= 224; c0 = 3744; nb = 12; dst = (bf16_t*)(base + SMW_WG); } }
    else if (p < 512) { p -= 416; const int br = p >> 5; p &= 31; W = FIN(br == 0 ? I_WBRRET : (br == 1 ? I_WBRMLA : I_WBRG)) + (size_t)l * 512 * D; K = 512; ldw = D; c0 = 0; nb = 4; dst = (bf16_t*)(base + SMW_WBR) + (size_t)br * 1024 * 512; }
    else if (p < 576) { p -= 512; W = FIN(I_WOUT) + (size_t)l * D * D; K = 1024; ldw = D; c0 = 0; nb = 4; dst = (bf16_t*)(base + SMW_WOUT); }
    else { p -= 576; W = FIN(I_SD) + (size_t)l * DEXP * D; K = 256; ldw = D; c0 = 0; nb = 4; dst = (bf16_t*)(base + SMW_SHD); }
    const int kb = p / nb, nbi = p - kb * nb;
    c.W = W + (size_t)kb * 64 * ldw + c0 + nbi * 256; c.ldw = ldw; c.dst0 = dst + (size_t)(nbi * 256) * K + kb * 64; c.ldt = K; return c;
}
template <class PG> __device__ __forceinline__ void cvt_panels(Frame& F, int nit, int first, int stride, const PG& pg) {
    LAS float* scr = (LAS float*)((LAS unsigned char*)F.lds); const int tid = F.tid;
    int it = first; if (it >= nit) return;
    CvtPanel cur = pg(F, it); g8::f32x4 rv[8];
#pragma unroll
    for (int i = 0; i < 8; ++i) { const int idx = tid + i * 512, kk = idx >> 6, c4 = (idx & 63) * 4; rv[i] = *(const g8::f32x4*)(cur.W + (size_t)kk * cur.ldw + c4); }
    for (;;) {
        __syncthreads();
#pragma unroll
        for (int i = 0; i < 8; ++i) { const int idx = tid + i * 512, kk = idx >> 6, c4 = (idx & 63) * 4; LAS float* p = scr + kk * 257 + c4; p[0] = rv[i][0]; p[1] = rv[i][1]; p[2] = rv[i][2]; p[3] = rv[i][3]; }
        __syncthreads();
        const int nx = it + stride; const bool more = nx < nit; CvtPanel nxt = cur;
        if (more) { nxt = pg(F, nx);
#pragma unroll
            for (int i = 0; i < 8; ++i) { const int idx = tid + i * 512, kk = idx >> 6, c4 = (idx & 63) * 4; rv[i] = *(const g8::f32x4*)(nxt.W + (size_t)kk * nxt.ldw + c4); } }
        { const int n = tid >> 1, k0 = (tid & 1) * 32; const int row = cur.gu_map ? ((n >> 7) * 256 + cur.up * 128 + (n & 127)) : n;
          bf16_t* d = cur.dst0 + (size_t)row * cur.ldt + k0;
#pragma unroll
          for (int j = 0; j < 4; ++j) { g8::f32x4 a, b;
#pragma unroll
              for (int e = 0; e < 4; ++e) { a[e] = scr[(k0 + j * 8 + e) * 257 + n]; b[e] = scr[(k0 + j * 8 + 4 + e) * 257 + n]; }
              *(g8::u32x4*)(d + j * 8) = g8::pack8(a, b); } }
        if (!more) break;
        cur = nxt; it = nx;
    }
    __syncthreads();
}
struct SmallPG { __device__ __forceinline__ CvtPanel operator()(Frame& F, int it) const { return cvt_small_panel(F, it); } };
__device__ __forceinline__ void p_cvt_small(Frame& F) {
    __syncthreads();
    cvt_panels(F, 2 * CVT_SMALL_PANELS, F.bid, F.G, SmallPG{});
    LAS float* scr = (LAS float*)((LAS unsigned char*)F.lds + F.wave * 16384);
    const int gw = F.bid * NWAVES + F.wave, NGW = F.G * NWAVES;
    for (int it = gw; it < 2 * CVT_SMALL_ITEMS; it += NGW) cvt_small_item(F, it / CVT_SMALL_ITEMS, it % CVT_SMALL_ITEMS, scr, F.lane);
    for (int i = F.bid * NTHR + F.tid; i < 2 * 64 * 1024; i += F.G * NTHR) { const int l = i >> 16, e = (i >> 10) & 63, k = i & 1023;
        const float v = FIN(I_ROUTER)[(size_t)l * D * NEXP + k * NEXP + e]; const unsigned h = f2bf(v); const float vh = __builtin_bit_cast(float, h << 16);
        bf16_t* rt = (bf16_t*)(ws_(F.A) + WS_WSM + (size_t)l * SMW_L + SMW_RT); rt[e * 1024 + k] = (bf16_t)h; rt[64 * 1024 + e * 1024 + k] = (bf16_t)f2bf(v - vh); }
    for (int i = F.bid * NTHR + F.tid; i < 2 * 8 * 32 * 768 / 16; i += F.G * NTHR) { const int l = i / (8 * 32 * 48), rem = i % (8 * 32 * 48), hh = rem / (32 * 48), w = rem % (32 * 48);
        ((uint4*)(ws_(F.A) + WS_WSM + (size_t)l * SMW_L + SMW_WUQ + (size_t)(hh * 128 + 96) * 768))[w] = make_uint4(0u, 0u, 0u, 0u); }
    for (int l = 0; l < 2; ++l) { uint4* z = (uint4*)(ws_(F.A) + WS_WSM + (size_t)l * SMW_L + SMW_WIN + (size_t)2720 * 2048);
        for (int i = F.bid * NTHR + F.tid; i < 96 * 2048 / 16; i += F.G * NTHR) z[i] = make_uint4(0u, 0u, 0u, 0u); }
}
__device__ __forceinline__ CvtPanel cvt_moe_panel(Frame& F, int l, int it) {
    const int e = it / 48, p = it % 48; unsigned char* base = ws_(F.A) + WS_MOEW + (size_t)e * (1536 * 1024); CvtPanel c;
    if (p < 32) { const int up = p >> 4, kb = p & 15; c.W = FIN(up ? I_WU : I_WG) + ((size_t)l * NEXP + e) * D * DEXP + (size_t)kb * 64 * DEXP; c.ldw = DEXP; c.dst0 = (bf16_t*)base + kb * 64; c.ldt = 1024; c.gu_map = 1; c.up = up; }
    else { const int q = p - 32, kb = q >> 2, nb = q & 3; c.W = FIN(I_WD) + ((size_t)l * NEXP + e) * DEXP * D + (size_t)kb * 64 * D + nb * 256; c.ldw = D; c.dst0 = (bf16_t*)(base + 1024 * 1024) + (size_t)nb * 256 * 256 + kb * 64; c.ldt = 256; c.gu_map = 0; c.up = 0; }
    return c;
}
struct MoePG { int l; __device__ __forceinline__ CvtPanel operator()(Frame& F, int it) const { return cvt_moe_panel(F, l, it); } };
__device__ __forceinline__ void p_cvt_moe(Frame& F, int l, int nskip = 0) {
    if (F.bid < nskip) return;
    cvt_panels(F, NEXP * 48, F.bid - nskip, F.G - nskip, MoePG{l});
}

__device__ __forceinline__ void rope8_fly(g8::f32x4& a, g8::f32x4& b, const g8::f32x4& pa, const g8::f32x4& pb, float pos, bool first) {
    const float ir[8] = {0.15915494309f, 0.05032921210f, 0.01591549431f, 0.00503292121f, 0.00159154943f, 0.00050329212f, 0.00015915494f, 0.00005032921f};
#pragma unroll
    for (int e = 0; e < 4; ++e) { const float x0 = __builtin_amdgcn_fractf(pos * ir[e]), x1 = __builtin_amdgcn_fractf(pos * ir[4 + e]);
        const float c0 = __builtin_amdgcn_cosf(x0), s0 = __builtin_amdgcn_sinf(x0), c1 = __builtin_amdgcn_cosf(x1), s1 = __builtin_amdgcn_sinf(x1);
        if (first) { a[e] = a[e] * c0 - pa[e] * s0; b[e] = b[e] * c1 - pb[e] * s1; } else { a[e] = pa[e] * s0 + a[e] * c0; b[e] = pb[e] * s1 + b[e] * c1; } }
}
__device__ __forceinline__ void rope8(g8::f32x4& a, g8::f32x4& b, const g8::f32x4& pa, const g8::f32x4& pb, const float* tab, int vi) {
    const int ax = vi >> 1; const bool first = (vi & 1) == 0;
    const g8::f32x4 c0 = *(const g8::f32x4*)(tab + ax * 16), c1 = *(const g8::f32x4*)(tab + ax * 16 + 4), s0 = *(const g8::f32x4*)(tab + ax * 16 + 8), s1 = *(const g8::f32x4*)(tab + ax * 16 + 12);
    if (first) { a = a * c0 - pa * s0; b = b * c1 - pb * s1; } else { a = pa * s0 + a * c0; b = pb * s1 + b * c1; }
}

using g8::f32x4; using g8::u32x4; using g8::GUnit;
#define EPI_ARGS const f32x4 (&acc)[2][2][4][2], const GUnit& u, int wr, int wc, int fr, int fq, int tid
#define EPI_FOR(...) do { _Pragma("unroll") for (int ai = 0; ai < 2; ++ai) _Pragma("unroll") for (int m = 0; m < 4; ++m) { const int lr = ai * 128 + wr * 64 + m * 16 + fr; \
    _Pragma("unroll") for (int bj = 0; bj < 2; ++bj) { const int lc = bj * 128 + wc * 32 + 8 * fq; f32x4 v0 = acc[ai][bj][m][0], v1 = acc[ai][bj][m][1]; const int gi = (ai * 4 + m) * 2 + bj; (void)gi; __VA_ARGS__ } asm volatile("" ::: "memory"); } } while (0)
__device__ __forceinline__ f32x4 gelu4(f32x4 x) { f32x4 o;
#pragma unroll
    for (int i = 0; i < 4; ++i) { const float t = x[i]; o[i] = t * g8::fsigmoid(1.5957691216057308f * (t + 0.044715f * t * t * t)); } return o; }

struct SchedInproj { const char* A; const char* B; int G, c;
    __device__ __forceinline__ bool get(int i, GUnit& u) const { int pm, pn; if (!g8::tile_order(i, G, c, M / 256, 15, pm, pn)) return false;
        u.A = A; u.B = B + (size_t)pn * 256 * 2048; u.rows = nullptr; u.arow0 = pm * 256; u.lda2 = 2048u; u.ldb2 = 2048u; u.nt = 16; u.pm = pm; u.pn = pn; u.tag = 0; return true; } };
__device__ __forceinline__ float fq_sum(float v, int lane) {
    v += __builtin_bit_cast(float, __builtin_amdgcn_ds_bpermute((lane ^ 16) << 2, __builtin_bit_cast(int, v)));
    v += __builtin_bit_cast(float, __builtin_amdgcn_ds_bpermute((lane ^ 32) << 2, __builtin_bit_cast(int, v))); return v; }
struct EpiInproj { bf16_t *RET, *CQ, *CKV, *KR, *UV; float *PART, *PARTV; const float *krg, *rope;
    __device__ __forceinline__ void operator()(EPI_ARGS) const {
        const int r0 = u.pm * 256, lane = tid & 63;
        if (u.pn < 8) { const float sc = (u.pn == 2 || u.pn == 3) ? 0.08838834764831845f : 1.0f;
            EPI_FOR({ *(u32x4*)(RET + (size_t)(r0 + lr) * 2048 + u.pn * 256 + lc) = g8::pack8(v0 * sc, v1 * sc); });
        } else if (u.pn < 11) {
            const bool lat = r0 < ML;
            EPI_FOR({ const int c = (u.pn - 8) * 256 + lc; const int r = r0 + lr;
                const float ss = fq_sum(sumsq8(v0, v1), lane); if (fq == 0 && c < 672) PART[(size_t)r * 24 + (c >> 5)] = ss;
                if (c < 384) *(u32x4*)(CQ + (size_t)r * 384 + c) = g8::pack8(v0, v1);
                else if (c < 640) *(u32x4*)(CKV + (size_t)r * 256 + (c - 384)) = g8::pack8(v0, v1);
                else if (c < 672) {
                    const float rstd = 1.0f / sqrtf(ss * (1.0f / 32.f) + EPS); const g8::f32x4 g0 = *(const g8::f32x4*)(krg + 8 * fq), g1 = *(const g8::f32x4*)(krg + 8 * fq + 4);
                    g8::f32x4 y0 = v0 * rstd * g0, y1 = v1 * rstd * g1, p0, p1;
                    _Pragma("unroll") for (int i = 0; i < 4; ++i) { p0[i] = __builtin_bit_cast(float, __builtin_amdgcn_ds_bpermute((lane ^ 16) << 2, __builtin_bit_cast(int, y0[i]))); p1[i] = __builtin_bit_cast(float, __builtin_amdgcn_ds_bpermute((lane ^ 16) << 2, __builtin_bit_cast(int, y1[i]))); }
                    if (lat) { const int t = r & (SEQ - 1); rope8_fly(y0, y1, p0, p1, (float)((fq >> 1) ? (t & 63) : (t >> 6)), (fq & 1) == 0); }
                    *(u32x4*)(KR + (size_t)r * 32 + 8 * fq) = g8::pack8(y0, y1); } });
        } else {
            EPI_FOR({ const g8::f32x4 z0 = gelu4(v0), z1 = gelu4(v1); const int c = (u.pn - 11) * 256 + lc; const int r = r0 + lr;
                *(u32x4*)(UV + (size_t)r * 1024 + c) = g8::pack8(z0, z1);
                if (u.pn >= 13) { const float s1 = fq_sum((z0[0] + z0[1]) + (z0[2] + z0[3]) + (z1[0] + z1[1]) + (z1[2] + z1[3]), lane), s2 = fq_sum(sumsq8(z0, z1), lane);
                    if (fq == 0) { float* pp = PARTV + ((size_t)r * 16 + ((c - 512) >> 5)) * 2; pp[0] = s1; pp[1] = s2; } } });
        }
    } };
struct SchedMlaUp { const char *CQ, *CKV, *WQ, *WKV; int G, c, pm0, nM;
    __device__ __forceinline__ bool get(int i, GUnit& u) const { int pm, pn; if (!g8::tile_order(i, G, c, nM, 8, pm, pn)) return false;
        pm += pm0; u.rows = nullptr; u.arow0 = pm * 256; u.pm = pm;
        if (pn < 4) { u.A = CQ; u.lda2 = 768u; u.B = WQ + (size_t)pn * 256 * 768; u.ldb2 = 768u; u.nt = 6; u.pn = pn; u.tag = 0; }
        else { u.A = CKV; u.lda2 = 512u; u.B = WKV + (size_t)(pn - 4) * 256 * 512; u.ldb2 = 512u; u.nt = 4; u.pn = pn - 4; u.tag = 1; }
        return true; } };
#define EPI_BAR() do { asm volatile("s_waitcnt lgkmcnt(0)" ::: "memory"); __builtin_amdgcn_s_barrier(); asm volatile("" ::: "memory"); } while (0)
struct EpiMlaFused { bf16_t *Q, *K, *V; const bf16_t* KRN; const float *qng, *kng, *rope, *RS; LAS float* SS;
    __device__ __forceinline__ void operator()(EPI_ARGS) const {
        const int r0 = u.pm * 256, lane = tid & 63;
        const bool act = (u.tag == 0) ? (wc < 3) : (wc < 2);
        float rs[8];
#pragma unroll
        for (int ai = 0; ai < 2; ++ai)
#pragma unroll
            for (int m = 0; m < 4; ++m) rs[ai * 4 + m] = RS[(size_t)(r0 + ai * 128 + wr * 64 + m * 16 + fr) * 2 + (u.tag == 0 ? 0 : 1)];
        EPI_FOR({ const float rsr = rs[ai * 4 + m]; v0 = v0 * rsr; v1 = v1 * rsr; float ss = sumsq8(v0, v1);
            ss += __builtin_bit_cast(float, __builtin_amdgcn_ds_bpermute((lane ^ 16) << 2, __builtin_bit_cast(int, ss)));
            ss += __builtin_bit_cast(float, __builtin_amdgcn_ds_bpermute((lane ^ 32) << 2, __builtin_bit_cast(int, ss)));
            if (fq == 0) SS[(lr * 2 + bj) * 4 + wc] = act ? ss : 0.f; });
        u32x4 krn[8];
        if (u.tag == 1 && wc == 2) {
#pragma unroll
            for (int i = 0; i < 8; ++i) krn[i] = *(const u32x4*)(KRN + (size_t)(r0 + (i >> 2) * 128 + wr * 64 + (i & 3) * 16 + fr) * 32 + 8 * fq); }
        EPI_BAR();
        const int hcg = (u.tag == 0 ? (wc < 3 ? wc : 0) : (wc & 1)) * 32 + 8 * fq; const float* gp_ = (u.tag == 0 ? qng : kng) + hcg;
        const g8::f32x4 gq0 = *(const g8::f32x4*)gp_, gq1 = *(const g8::f32x4*)(gp_ + 4);
        if (u.tag == 0) {
            const bool lat = r0 < ML;
            EPI_FOR({ const float rsr = rs[ai * 4 + m]; v0 = v0 * rsr; v1 = v1 * rsr; const g8::f32x4 t = *(const LAS g8::f32x4*)(SS + (lr * 2 + bj) * 4); const float rstd = 1.0f / sqrtf(((t[0] + t[1]) + t[2]) * (1.0f / 96.f) + EPS);
                if (wc < 3) { const int hc = wc * 32 + 8 * fq;
                    g8::f32x4 y0 = v0 * rstd * gq0, y1 = v1 * rstd * gq1;
                    if (wc == 2 && lat) { g8::f32x4 p0, p1;
                        _Pragma("unroll") for (int i = 0; i < 4; ++i) { p0[i] = __builtin_bit_cast(float, __builtin_amdgcn_ds_bpermute((lane ^ 16) << 2, __builtin_bit_cast(int, y0[i]))); p1[i] = __builtin_bit_cast(float, __builtin_amdgcn_ds_bpermute((lane ^ 16) << 2, __builtin_bit_cast(int, y1[i]))); }
                        const int t = (r0 + lr) & (SEQ - 1); rope8_fly(y0, y1, p0, p1, (float)((fq >> 1) ? (t & 63) : (t >> 6)), (fq & 1) == 0); }
                    *(u32x4*)(Q + (size_t)(r0 + lr) * 768 + (2 * u.pn + bj) * 96 + hc) = g8::pack8(y0 * QSCALE, y1 * QSCALE); } });
        } else {
            EPI_FOR({ const int h = 2 * u.pn + bj; const float rsr = rs[ai * 4 + m]; v0 = v0 * rsr; v1 = v1 * rsr;
                if (wc < 2) { const LAS float* t = SS + (lr * 2 + bj) * 4; const float rk = 1.0f / sqrtf((t[0] + t[1]) * (1.0f / 64.f) + EPS); const int hc = wc * 32 + 8 * fq;
                    *(u32x4*)(K + (size_t)(r0 + lr) * 768 + h * 96 + hc) = g8::pack8(v0 * rk * gq0, v1 * rk * gq1); }
                else { *(u32x4*)(V + (size_t)(r0 + lr) * 512 + h * 64 + (wc - 2) * 32 + 8 * fq) = g8::pack8(v0, v1);
                    if (wc == 2) *(u32x4*)(K + (size_t)(r0 + lr) * 768 + h * 96 + 64 + 8 * fq) = krn[ai * 4 + m]; } });
        }
        EPI_BAR();
    } };
struct SchedMerge { const char *H, *WG, *ABR, *WBR; unsigned lda2; int G, c, nM, br;
    __device__ __forceinline__ bool get(int i, GUnit& u) const { int pm, pn; const int it = i >> 1, nwg = nM * 4, nfull = nwg / G, rem = nwg - nfull * G; int cc = c, fl = 0;
        if (rem > 0 && it == nfull) { cc = c - rem * br; if (cc < 0) cc += G; fl = 1 + cc; }
        if (!g8::tile_order(it, G, cc, nM, 4, pm, pn)) return false;
        u.rows = nullptr; u.arow0 = pm * 256; u.pm = pm; u.pn = pn; u.tag = (i & 1) | (fl << 1);
        if ((i & 1) == 0) { u.A = H; u.lda2 = 2048u; u.B = WG + (size_t)(pn * 256) * 2048; u.ldb2 = 2048u; u.nt = 16; }
        else { u.A = ABR; u.lda2 = lda2; u.B = WBR + (size_t)pn * 256 * 1024; u.ldb2 = 1024u; u.nt = 8; }
        return true; } };
template <int BR> struct EpiMerge { bf16_t* Y; u32x4* scrT; unsigned* mflag;
    __device__ __forceinline__ void operator()(EPI_ARGS) const {
        const int r0 = u.pm * 256, fl = u.tag >> 1;
        if ((u.tag & 1) == 0) { EPI_FOR({ f32x4 s0, s1;
                _Pragma("unroll") for (int i = 0; i < 4; ++i) { s0[i] = g8::fsigmoid(v0[i]); s1[i] = g8::fsigmoid(v1[i]); }
                scrT[gi * 512 + tid] = g8::pack8(s0, s1); });
        } else {
            if (BR > 0 && fl) {
                if (tid == 0) { unsigned sp = 0; while (xb_ld(mflag + fl - 1) < (unsigned)BR) { __builtin_amdgcn_s_sleep(1); if (++sp > XB_SPIN_CAP) break; } }
                EPI_BAR(); __builtin_amdgcn_fence(__ATOMIC_ACQUIRE, "agent"); }
#pragma unroll
            for (int ai = 0; ai < 2; ++ai) { u32x4 tv[4][2], yv[4][2];
#pragma unroll
                for (int m = 0; m < 4; ++m)
#pragma unroll
                    for (int bj = 0; bj < 2; ++bj) { const int lr = ai * 128 + wr * 64 + m * 16 + fr, lc = bj * 128 + wc * 32 + 8 * fq, gi = (ai * 4 + m) * 2 + bj;
                        tv[m][bj] = scrT[gi * 512 + tid]; if (BR > 0) yv[m][bj] = *(const u32x4*)(Y + (size_t)(r0 + lr) * 1024 + u.pn * 256 + lc); }
#pragma unroll
                for (int m = 0; m < 4; ++m)
#pragma unroll
                    for (int bj = 0; bj < 2; ++bj) { const int lr = ai * 128 + wr * 64 + m * 16 + fr, lc = bj * 128 + wc * 32 + 8 * fq;
                        f32x4 t0, t1; g8::unpack8(tv[m][bj], t0, t1); f32x4 y0 = t0 * acc[ai][bj][m][0], y1 = t1 * acc[ai][bj][m][1];
                        if (BR > 0) { f32x4 p0, p1; g8::unpack8(yv[m][bj], p0, p1); y0 += p0; y1 += p1; }
                        *(u32x4*)(Y + (size_t)(r0 + lr) * 1024 + u.pn * 256 + lc) = g8::pack8(y0, y1); }
                asm volatile("" ::: "memory"); }
            if (BR < 2 && fl) {
                asm volatile("s_waitcnt vmcnt(0)" ::: "memory"); EPI_BAR();
                if (tid == 0) { __builtin_amdgcn_fence(__ATOMIC_RELEASE, "agent"); __hip_atomic_store(mflag + fl - 1, (unsigned)(BR + 1), __ATOMIC_RELAXED, __HIP_MEMORY_SCOPE_AGENT); } }
        }
    } };
struct SchedOut { const char *Y, *W; int G, c, nM;
    __device__ __forceinline__ bool get(int i, GUnit& u) const { int pm, pn; if (!g8::tile_order(i, G, c, nM, 4, pm, pn)) return false;
        u.A = Y; u.B = W + (size_t)pn * 256 * 2048; u.rows = nullptr; u.arow0 = pm * 256; u.lda2 = 2048u; u.ldb2 = 2048u; u.nt = 16; u.pm = pm; u.pn = pn; u.tag = 0; return true; } };
struct EpiResid { const float* xlat32; const float* xctx32; bf16_t* X16; const float* modg; int l;
    __device__ __forceinline__ void operator()(EPI_ARGS) const {
        const int r0 = u.pm * 256; const bool lat = r0 < ML;
        const float* g = modg + (size_t)(lat ? (r0 >> 13) : 4) * 6144 + u.pn * 256 + wc * 32 + 8 * fq;
        f32x4 gv[2][2];
#pragma unroll
        for (int bj = 0; bj < 2; ++bj) { gv[bj][0] = *(const f32x4*)(g + bj * 128); gv[bj][1] = *(const f32x4*)(g + bj * 128 + 4); }
        const size_t c0 = (size_t)u.pn * 256 + wc * 32 + 8 * fq;
        bf16_t* xd0 = X16 + (size_t)r0 * D + c0;
        if (l == 0) {
            const float* xs0 = (lat ? xlat32 + (size_t)r0 * D : xctx32 + (size_t)(r0 - ML) * D) + c0;
#pragma unroll
            for (int ai = 0; ai < 2; ++ai) { f32x4 xv[4][2][2];
#pragma unroll
                for (int m = 0; m < 4; ++m)
#pragma unroll
                    for (int bj = 0; bj < 2; ++bj) { const float* xp = xs0 + (size_t)(ai * 128 + wr * 64 + m * 16 + fr) * D + bj * 128;
                        xv[m][bj][0] = *(const f32x4*)xp; xv[m][bj][1] = *(const f32x4*)(xp + 4); }
#pragma unroll
                for (int m = 0; m < 4; ++m)
#pragma unroll
                    for (int bj = 0; bj < 2; ++bj)
                        *(u32x4*)(xd0 + (size_t)(ai * 128 + wr * 64 + m * 16 + fr) * D + bj * 128) = g8::pack8(xv[m][bj][0] + gv[bj][0] * acc[ai][bj][m][0], xv[m][bj][1] + gv[bj][1] * acc[ai][bj][m][1]);
                asm volatile("" ::: "memory"); }
        } else {
#pragma unroll
            for (int ai = 0; ai < 2; ++ai) { u32x4 xw[4][2];
#pragma unroll
                for (int m = 0; m < 4; ++m)
#pragma unroll
                    for (int bj = 0; bj < 2; ++bj) xw[m][bj] = *(const u32x4*)(xd0 + (size_t)(ai * 128 + wr * 64 + m * 16 + fr) * D + bj * 128);
#pragma unroll
                for (int m = 0; m < 4; ++m)
#pragma unroll
                    for (int bj = 0; bj < 2; ++bj) { f32x4 x0, x1; g8::unpack8(xw[m][bj], x0, x1);
                        *(u32x4*)(xd0 + (size_t)(ai * 128 + wr * 64 + m * 16 + fr) * D + bj * 128) = g8::pack8(x0 + gv[bj][0] * acc[ai][bj][m][0], x1 + gv[bj][1] * acc[ai][bj][m][1]); }
                asm volatile("" ::: "memory"); }
        }
    } };
__device__ __forceinline__ void moe_tiles(Frame& F, int l, LAS int* tt) {
    __syncthreads();
    if (F.tid < 64) { const int e = F.tid; const int c = (int)F_ctl[CW_CNT + l * 64 + e]; const int n = (c + 255) >> 8; int incl = n;
#pragma unroll
        for (int o = 1; o < 64; o <<= 1) { const int v = __builtin_amdgcn_ds_bpermute(((e - o) & 63) << 2, incl); if (e >= o) incl += v; }
        const int start = incl - n; for (int j = 0; j < n; ++j) tt[1 + start + j] = e; if (e == 63) tt[0] = incl; }
    __syncthreads();
}
struct SchedGateUp { const char *H, *MOEW, *SHGU; const int* rowtok; const LAS int* tt; int G, c, nsh  ;
    __device__ __forceinline__ bool get(int i, GUnit& u) const { const int ntr = __builtin_amdgcn_readfirstlane(tt[0]);
        const int xcd = c & 7, q = i * (G >> 3) + (c >> 3), g = (q >> 1) * 8 + xcd, pn = q & 1;
        u.A = H; u.lda2 = 2048u; u.ldb2 = 2048u; u.nt = 16;
        if (g < ntr) { const int e = __builtin_amdgcn_readfirstlane(tt[1 + g]); u.rows = rowtok; u.arow0 = g * 256; u.B = MOEW + (size_t)e * (1536 * 1024) + (size_t)pn * 256 * 2048; u.pm = g; u.pn = pn; u.tag = 0; return true; }
        const int g2 = g - ntr; if (g2 >= nsh) return false;
        u.rows = nullptr; u.arow0 = g2 * 256; u.B = SHGU + (size_t)pn * 256 * 2048; u.pm = g2; u.pn = pn; u.tag = 1; return true; }
};
struct EpiGateUp { bf16_t *HB, *HBS;
    __device__ __forceinline__ void operator()(EPI_ARGS) const {
        bf16_t* dst = (u.tag == 0 ? HB : HBS) + (size_t)(u.pm * 256) * DEXP + u.pn * 128;
#pragma unroll
        for (int ai = 0; ai < 2; ++ai)
#pragma unroll
            for (int m = 0; m < 4; ++m) { const int lr = ai * 128 + wr * 64 + m * 16 + fr; f32x4 h0, h1;
#pragma unroll
                for (int i = 0; i < 4; ++i) { const float g0 = acc[ai][0][m][0][i], g1 = acc[ai][0][m][1][i];
                    h0[i] = g0 * g8::fsigmoid(g0) * acc[ai][1][m][0][i]; h1[i] = g1 * g8::fsigmoid(g1) * acc[ai][1][m][1][i]; }
                *(u32x4*)(dst + (size_t)lr * DEXP + wc * 32 + 8 * fq) = g8::pack8(h0, h1); }
    } };
struct SchedDown { const char *HB, *HBS, *MOEW, *SHD; const LAS int* tt; int G, c, nsh;
    __device__ __forceinline__ bool get(int i, GUnit& u) const { const int ntr = __builtin_amdgcn_readfirstlane(tt[0]);
        const int xcd = c & 7, q = i * (G >> 3) + (c >> 3), g = (q >> 2) * 8 + xcd, pn = q & 3;
        u.rows = nullptr; u.lda2 = 512u; u.ldb2 = 512u; u.nt = 4;
        if (g < ntr) { const int e = __builtin_amdgcn_readfirstlane(tt[1 + g]); u.A = HB; u.arow0 = g * 256; u.B = MOEW + (size_t)e * (1536 * 1024) + 1024 * 1024 + (size_t)(pn * 256) * 512; u.pm = g; u.pn = pn; u.tag = 0; return true; }
        const int g2 = g - ntr; if (g2 >= nsh) return false;
        u.A = HBS; u.arow0 = g2 * 256; u.B = SHD + (size_t)pn * 256 * 512; u.pm = g2; u.pn = pn; u.tag = 1; return true; } };
__device__ __forceinline__ unsigned pack_fp8x4(const f32x4& v) { unsigned w = 0;
    w = __builtin_amdgcn_cvt_pk_fp8_f32(__builtin_amdgcn_fmed3f(v[0], -448.f, 448.f), __builtin_amdgcn_fmed3f(v[1], -448.f, 448.f), w, false);
    w = __builtin_amdgcn_cvt_pk_fp8_f32(__builtin_amdgcn_fmed3f(v[2], -448.f, 448.f), __builtin_amdgcn_fmed3f(v[3], -448.f, 448.f), w, true); return w; }
struct EpiDown { unsigned char* OUT8; bf16_t* SHOUT;
    __device__ __forceinline__ void operator()(EPI_ARGS) const {
        if (u.tag == 0) { EPI_FOR({ uint2 w; w.x = pack_fp8x4(v0); w.y = pack_fp8x4(v1); *(uint2*)(OUT8 + (size_t)(u.pm * 256 + lr) * 1024 + u.pn * 256 + lc) = w; }); }
        else { EPI_FOR({ *(u32x4*)(SHOUT + (size_t)(u.pm * 256 + lr) * 1024 + u.pn * 256 + lc) = g8::pack8(v0, v1); }); }
    } };
namespace at {
typedef short bf16x8 __attribute__((ext_vector_type(8)));
typedef short s16x4 __attribute__((ext_vector_type(4)));
typedef float f32x16 __attribute__((ext_vector_type(16)));
constexpr int KSTR = 208, VSTR = 192, KT = 128  , KBUF = KT * KSTR, VBUF = KT * VSTR, STAGE = KBUF + VBUF, LDS_WSF = 2 * STAGE;
__device__ __forceinline__ int crow(int r, int hi) { return (r & 3) + 8 * (r >> 2) + 4 * hi; }
__device__ __forceinline__ s16x4 vtr(const LAS unsigned char* p) { return __builtin_bit_cast(s16x4, __builtin_amdgcn_ds_read_tr16_b64_v4i16((LAS s16x4*)p)); }
#define AT_BAR() do { asm volatile("s_waitcnt lgkmcnt(0)" ::: "memory"); __builtin_amdgcn_s_barrier(); asm volatile("" ::: "memory"); } while (0)
__device__ __forceinline__ void attn_unit(LAS unsigned char* lds, const bf16_t* __restrict__ Q, const bf16_t* __restrict__ K, const bf16_t* __restrict__ V, bf16_t* __restrict__ O,
                                          int h, int qrow0, int kr0, int kn0, int kr1, int kn1, int tid) {
    const int lane = tid & 63, wave = __builtin_amdgcn_readfirstlane(tid >> 6), r32 = lane & 31, hi = lane >> 5;
    unsigned ko_[3], kw_[3];
#pragma unroll
    for (int i = 0; i < 3; ++i) { const int ch = tid + 512 * i, kr = ch / 12, kc = ch % 12; ko_[i] = kr * 768 + kc * 8; kw_[i] = kr * KSTR + kc * 16; }
    const int vr = tid >> 3, vc = tid & 7; const unsigned vo = vr * 512 + vc * 8, vw = KBUF + vr * VSTR + vc * 16;
    const int nt = kn0 + kn1;
    g8::u32x4 rk[3], rv[2];
#define AT_LOAD(t) do { const int _t = (t); const int _row = _t < kn0 ? kr0 + KT * _t : kr1 + KT * (_t - kn0); const bf16_t* _kb = K + (size_t)_row * 768 + h * 96; const bf16_t* _vb = V + (size_t)_row * 512 + h * 64; \
        _Pragma("unroll") for (int _i = 0; _i < 3; ++_i) rk[_i] = *(const g8::u32x4*)(_kb + ko_[_i]); \
        rv[0] = *(const g8::u32x4*)(_vb + vo); rv[1] = *(const g8::u32x4*)(_vb + vo + 64 * 512); } while (0)
#define AT_WRITE(buf) do { LAS unsigned char* _b = lds + (buf) * STAGE; _Pragma("unroll") for (int _i = 0; _i < 3; ++_i) *(LAS g8::u32x4*)(_b + kw_[_i]) = rk[_i]; \
        *(LAS g8::u32x4*)(_b + vw) = rv[0]; *(LAS g8::u32x4*)(_b + vw + 64 * VSTR) = rv[1]; } while (0)
    AT_LOAD(0);
    bf16x8 qf[6];
    { const bf16_t* qp = Q + (size_t)(qrow0 + wave * 32 + r32) * 768 + h * 96 + hi * 8;
#pragma unroll
      for (int d0 = 0; d0 < 6; ++d0) qf[d0] = *(const bf16x8*)(qp + d0 * 16); }
    AT_WRITE(0);
    if (nt > 1) AT_LOAD(1);
    AT_BAR();
    f32x16 o0 = {}, o1 = {}; float lsum = 0.f;
    const unsigned kroff = r32 * KSTR + hi * 16;
    const unsigned vroff = KBUF + (4 * hi + ((lane & 15) >> 2)) * VSTR + ((lane >> 4) & 1) * 32 + (lane & 3) * 8;
    for (int t = 0; t < nt; ++t) {
        const LAS unsigned char* sb = lds + (t & 1) * STAGE;
        f32x16 p[4] = {};
#define AT_KLD(dst, d0) do { _Pragma("unroll") for (int x = 0; x < 4; ++x) dst[x] = *(const LAS bf16x8*)(sb + kroff + 32 * x * KSTR + (d0) * 32); } while (0)
#define AT_KMM(src, d0) do { __builtin_amdgcn_s_setprio(1); _Pragma("unroll") for (int x = 0; x < 4; ++x) p[x] = __builtin_amdgcn_mfma_f32_32x32x16_bf16(src[x], qf[d0], p[x], 0, 0, 0); __builtin_amdgcn_s_setprio(0); } while (0)
        { bf16x8 ka[4], kb[4];
          AT_KLD(ka, 0); __builtin_amdgcn_sched_barrier(0);
          AT_KLD(kb, 1); __builtin_amdgcn_sched_barrier(0); AT_KMM(ka, 0); __builtin_amdgcn_sched_barrier(0);
          AT_KLD(ka, 2); __builtin_amdgcn_sched_barrier(0); AT_KMM(kb, 1); __builtin_amdgcn_sched_barrier(0);
          AT_KLD(kb, 3); __builtin_amdgcn_sched_barrier(0); AT_KMM(ka, 2); __builtin_amdgcn_sched_barrier(0);
          AT_KLD(ka, 4); __builtin_amdgcn_sched_barrier(0); AT_KMM(kb, 3); __builtin_amdgcn_sched_barrier(0);
          AT_KLD(kb, 5); __builtin_amdgcn_sched_barrier(0); AT_KMM(ka, 4); __builtin_amdgcn_sched_barrier(0);
          AT_KMM(kb, 5); __builtin_amdgcn_sched_barrier(0); }
#undef AT_KLD
#undef AT_KMM
        float s = 0.f;
#pragma unroll
        for (int x = 0; x < 4; ++x)
#pragma unroll
            for (int r = 0; r < 16; ++r) { p[x][r] = __builtin_amdgcn_exp2f(p[x][r]); s += p[x][r]; }
        lsum += s;
#define AT_VLD(dst, ks) do { _Pragma("unroll") for (int d0 = 0; d0 < 2; ++d0) { const s16x4 lo = vtr(sb + vroff + (16 * (ks)) * VSTR + d0 * 64), hh = vtr(sb + vroff + (16 * (ks) + 8) * VSTR + d0 * 64); \
            dst[d0] = (bf16x8){lo[0], lo[1], lo[2], lo[3], hh[0], hh[1], hh[2], hh[3]}; } } while (0)
#define AT_PMM(src, ks) do { unsigned w[4]; _Pragma("unroll") for (int j = 0; j < 4; ++j) { const int r = 8 * ((ks) & 1) + 2 * j; w[j] = g8::cvtpk(p[(ks) >> 1][r], p[(ks) >> 1][r + 1]); } \
            const bf16x8 pa = __builtin_bit_cast(bf16x8, (g8::u32x4){w[0], w[1], w[2], w[3]}); __builtin_amdgcn_s_setprio(1); \
            o0 = __builtin_amdgcn_mfma_f32_32x32x16_bf16(pa, src[0], o0, 0, 0, 0); o1 = __builtin_amdgcn_mfma_f32_32x32x16_bf16(pa, src[1], o1, 0, 0, 0); __builtin_amdgcn_s_setprio(0); } while (0)
        { bf16x8 va[2], vb[2];
          AT_VLD(va, 0); __builtin_amdgcn_sched_barrier(0);
          AT_VLD(vb, 1); __builtin_amdgcn_sched_barrier(0); AT_PMM(va, 0); __builtin_amdgcn_sched_barrier(0);
          AT_VLD(va, 2); __builtin_amdgcn_sched_barrier(0); AT_PMM(vb, 1); __builtin_amdgcn_sched_barrier(0);
          AT_VLD(vb, 3); __builtin_amdgcn_sched_barrier(0); AT_PMM(va, 2); __builtin_amdgcn_sched_barrier(0);
          AT_VLD(va, 4); __builtin_amdgcn_sched_barrier(0); AT_PMM(vb, 3); __builtin_amdgcn_sched_barrier(0);
          AT_VLD(vb, 5); __builtin_amdgcn_sched_barrier(0); AT_PMM(va, 4); __builtin_amdgcn_sched_barrier(0);
          AT_VLD(va, 6); __builtin_amdgcn_sched_barrier(0); AT_PMM(vb, 5); __builtin_amdgcn_sched_barrier(0);
          AT_VLD(vb, 7); __builtin_amdgcn_sched_barrier(0); AT_PMM(va, 6); __builtin_amdgcn_sched_barrier(0);
          AT_PMM(vb, 7); __builtin_amdgcn_sched_barrier(0); }
#undef AT_VLD
#undef AT_PMM
        if (t + 1 < nt) { AT_WRITE((t + 1) & 1); if (t + 2 < nt) AT_LOAD(t + 2); }
        AT_BAR();
    }
    lsum += xlane32(lsum, lane);
    LAS float* wsf = (LAS float*)(lds + LDS_WSF) + wave * 32;
    if (hi == 0) wsf[r32] = lsum;
    asm volatile("s_waitcnt lgkmcnt(0)" ::: "memory");
    bf16_t* op = O + (size_t)(qrow0 + wave * 32) * 512 + h * 64 + r32;
#pragma unroll
    for (int r = 0; r < 16; ++r) { const int q = crow(r, hi); const float rl = 1.0f / wsf[q];
        op[(size_t)q * 512] = (bf16_t)f2bf(o0[r] * rl); op[(size_t)q * 512 + 32] = (bf16_t)f2bf(o1[r] * rl); }
    AT_BAR();
#undef AT_LOAD
#undef AT_WRITE
}
#undef AT_BAR
}

namespace at16 {
using at::bf16x8; using at::s16x4; using at::vtr;
typedef float f32x4_t __attribute__((ext_vector_type(4)));
constexpr int KSTR = 256, VSTR = 160, KT = 128, KBUF = KT * KSTR, VBUF = KT * VSTR, STAGE = KBUF + VBUF, LDS_WSF = 2 * STAGE;
#define A16_BAR() do { asm volatile("s_waitcnt lgkmcnt(0)" ::: "memory"); __builtin_amdgcn_s_barrier(); asm volatile("" ::: "memory"); } while (0)
__device__ __forceinline__ void attn_unit(LAS unsigned char* lds, const bf16_t* __restrict__ Q, const bf16_t* __restrict__ K, const bf16_t* __restrict__ V, bf16_t* __restrict__ O,
                                          int h, int qrow0, int kr0, int kn0, int kr1, int kn1, int tid) {
    const int lane = tid & 63, wave = __builtin_amdgcn_readfirstlane(tid >> 6), i16 = lane & 15, g = lane >> 4;
    unsigned ko_[3], kw_[3];
#pragma unroll
    for (int i = 0; i < 3; ++i) { const int ch = tid + 512 * i, kr = ch / 12, kc = ch % 12; ko_[i] = kr * 768 + kc * 8; kw_[i] = kr * KSTR + ((kc ^ (kr & 15)) << 4); }
    const int vr = tid >> 3, vc = tid & 7; const unsigned vo = vr * 512 + vc * 8, vw = KBUF + vr * VSTR + vc * 16;
    const int nt = kn0 + kn1;
    g8::u32x4 rk[3], rv[2];
#define A16_LOAD(t) do { const int _t = (t); const int _row = _t < kn0 ? kr0 + KT * _t : kr1 + KT * (_t - kn0); const bf16_t* _kb = K + (size_t)_row * 768 + h * 96; const bf16_t* _vb = V + (size_t)_row * 512 + h * 64; \
        _Pragma("unroll") for (int _i = 0; _i < 3; ++_i) rk[_i] = *(const g8::u32x4*)(_kb + ko_[_i]); \
        rv[0] = *(const g8::u32x4*)(_vb + vo); rv[1] = *(const g8::u32x4*)(_vb + vo + 64 * 512); } while (0)
#define A16_WRITE(buf) do { LAS unsigned char* _b = lds + (buf) * STAGE; _Pragma("unroll") for (int _i = 0; _i < 3; ++_i) *(LAS g8::u32x4*)(_b + kw_[_i]) = rk[_i]; \
        *(LAS g8::u32x4*)(_b + vw) = rv[0]; *(LAS g8::u32x4*)(_b + vw + 64 * VSTR) = rv[1]; } while (0)
    A16_LOAD(0);
    bf16x8 qf[2][3];
#pragma unroll
    for (int qb = 0; qb < 2; ++qb) { const bf16_t* qp = Q + (size_t)(qrow0 + wave * 32 + qb * 16 + i16) * 768 + h * 96 + g * 8;
#pragma unroll
        for (int s = 0; s < 3; ++s) qf[qb][s] = *(const bf16x8*)(qp + s * 32); }
    A16_WRITE(0);
    if (nt > 1) A16_LOAD(1);
    A16_BAR();
    f32x4_t o[2][4] = {}, ol[2] = {};
    const bf16x8 ones = {(short)0x3F80, (short)0x3F80, (short)0x3F80, (short)0x3F80, (short)0x3F80, (short)0x3F80, (short)0x3F80, (short)0x3F80};
    unsigned kroff[3];
#pragma unroll
    for (int s2 = 0; s2 < 3; ++s2) kroff[s2] = i16 * KSTR + (((4 * s2 + g) ^ i16) << 4);
    const unsigned vroff = KBUF + (4 * g + (i16 >> 2)) * VSTR + (i16 & 3) * 8;
#define A16_KF(kbg, s) (*(const LAS bf16x8*)(sb + kroff[s] + (16 * (kbg)) * KSTR))
#define A16_VLD(vfx, hf, ks2) do { _Pragma("unroll") for (int dvb = 0; dvb < 4; ++dvb) { const LAS unsigned char* vp = sb + vroff + (64 * (hf) + 32 * (ks2)) * VSTR + dvb * 32; \
        const s16x4 lo = vtr(vp), hh = vtr(vp + 16 * VSTR); vfx[dvb] = (bf16x8){lo[0], lo[1], lo[2], lo[3], hh[0], hh[1], hh[2], hh[3]}; } } while (0)
#define A16_EXPQ(kb, qb) do { _Pragma("unroll") for (int r = 0; r < 4; ++r) st[kb][qb][r] = __builtin_amdgcn_exp2f(st[kb][qb][r]); } while (0)
#define A16_CVT(pax, ks2) do { _Pragma("unroll") for (int qb = 0; qb < 2; ++qb) { const f32x4_t a = st[2 * (ks2)][qb], b = st[2 * (ks2) + 1][qb]; \
        pax[qb] = __builtin_bit_cast(bf16x8, (g8::u32x4){g8::cvtpk(a[0], a[1]), g8::cvtpk(a[2], a[3]), g8::cvtpk(b[0], b[1]), g8::cvtpk(b[2], b[3])}); } } while (0)
#define A16_PV(pax, vfx, dvb) do { __builtin_amdgcn_s_setprio(1); _Pragma("unroll") for (int qb = 0; qb < 2; ++qb) o[qb][dvb] = __builtin_amdgcn_mfma_f32_16x16x32_bf16(pax[qb], vfx[dvb], o[qb][dvb], 0, 0, 0); __builtin_amdgcn_s_setprio(0); } while (0)
#define A16_PL(pax) do { __builtin_amdgcn_s_setprio(1); _Pragma("unroll") for (int qb = 0; qb < 2; ++qb) ol[qb] = __builtin_amdgcn_mfma_f32_16x16x32_bf16(pax[qb], ones, ol[qb], 0, 0, 0); __builtin_amdgcn_s_setprio(0); } while (0)
#define A16_SB() __builtin_amdgcn_sched_barrier(0)
    for (int t = 0; t < nt; ++t) {
        const LAS unsigned char* sb = lds + (t & 1) * STAGE;
        bf16x8 kf[2][3];
#pragma unroll
        for (int s = 0; s < 3; ++s) kf[0][s] = A16_KF(0, s);
#pragma unroll
        for (int s = 0; s < 3; ++s) kf[1][s] = A16_KF(1, s);
        A16_SB();
#pragma unroll
        for (int hf = 0; hf < 2; ++hf) {
            f32x4_t st[4][2];
            bf16x8 vf0[4], vf1[4], pa0[2], pa1[2];
#pragma unroll
            for (int kb = 0; kb < 4; ++kb) {
#pragma unroll
                for (int s = 0; s < 3; ++s) {
                    __builtin_amdgcn_s_setprio(1);
#pragma unroll
                    for (int qb = 0; qb < 2; ++qb) st[kb][qb] = __builtin_amdgcn_mfma_f32_16x16x32_bf16(kf[kb & 1][s], qf[qb][s], s == 0 ? (f32x4_t){0.f, 0.f, 0.f, 0.f} : st[kb][qb], 0, 0, 0);
                    __builtin_amdgcn_s_setprio(0);
                    if (4 * hf + kb + 2 < 8) kf[kb & 1][s] = A16_KF(4 * hf + kb + 2, s);
                    if (kb > 0 && s == 0) A16_EXPQ(kb - 1, 0);
                    if (kb > 0 && s == 1) A16_EXPQ(kb - 1, 1);
                    if (kb == 1 && s == 2) A16_VLD(vf0, hf, 0);
                    if (kb == 2 && s == 2) A16_CVT(pa0, 0);
                    if (kb == 3 && s == 2) A16_VLD(vf1, hf, 1);
                    A16_SB();
                }
            }
            A16_PV(pa0, vf0, 0); A16_EXPQ(3, 0); A16_SB();
            A16_PV(pa0, vf0, 1); A16_EXPQ(3, 1); A16_SB();
            A16_PV(pa0, vf0, 2); A16_CVT(pa1, 1); A16_SB();
            A16_PV(pa0, vf0, 3); A16_PL(pa0); A16_SB();
#pragma unroll
            for (int dvb = 0; dvb < 4; ++dvb) A16_PV(pa1, vf1, dvb);
            A16_PL(pa1);
            A16_SB();
        }
        if (t + 1 < nt) { A16_WRITE((t + 1) & 1); if (t + 2 < nt) A16_LOAD(t + 2); }
        A16_BAR();
    }
#undef A16_KF
#undef A16_VLD
#undef A16_EXPQ
#undef A16_CVT
#undef A16_PV
#undef A16_PL
#undef A16_SB
#pragma unroll
    for (int qb = 0; qb < 2; ++qb)
#pragma unroll
        for (int r = 0; r < 4; ++r) { const int q = qb * 16 + 4 * g + r; const float rl = 1.0f / ol[qb][r];
            bf16_t* op = O + (size_t)(qrow0 + wave * 32 + q) * 512 + h * 64 + i16;
#pragma unroll
            for (int dvb = 0; dvb < 4; ++dvb) op[dvb * 16] = (bf16_t)f2bf(o[qb][dvb][r] * rl); }
#undef A16_LOAD
#undef A16_WRITE
}
__device__ __forceinline__ void attn_unit64(LAS unsigned char* lds, const bf16_t* __restrict__ Q, const bf16_t* __restrict__ K, const bf16_t* __restrict__ V, bf16_t* __restrict__ O,
                                            int h, int qrow0, int kr0, int kn0, int kr1, int kn1, int tid) {
    const int lane = tid & 63, wave = __builtin_amdgcn_readfirstlane(tid >> 6), i16 = lane & 15, g = lane >> 4;
    const int nt = kn0 + kn1;
    unsigned koff[4], voff[3];
#pragma unroll
    for (int n = 0; n < 4; ++n) { const int row = 16 * wave + 4 * n + (lane >> 4); int c = (lane & 15) ^ (row & 15); if (c >= 12) c -= 4; koff[n] = row * 768 + c * 8; }
#pragma unroll
    for (int k = 0; k < 3; ++k) { const int q = 64 * (wave + 8 * k) + lane; const int row = q / 10; int ch = q - row * 10; if (ch >= 8) ch -= 8; voff[k] = row * 512 + ch * 8; }
#define A64_DMA(t, buf) do { const int _t = (t); const int _row = _t < kn0 ? kr0 + KT * _t : kr1 + KT * (_t - kn0); const bf16_t* _kb = K + (size_t)_row * 768 + h * 96; const bf16_t* _vb = V + (size_t)_row * 512 + h * 64; \
        LAS unsigned char* _b = lds + (buf) * STAGE; \
        _Pragma("unroll") for (int _n = 0; _n < 4; ++_n) __builtin_amdgcn_global_load_lds((const unsigned*)(_kb + koff[_n]), (LAS unsigned*)(_b + (wave * 4 + _n) * 1024), 16, 0, 0); \
        _Pragma("unroll") for (int _k = 0; _k < 2; ++_k) __builtin_amdgcn_global_load_lds((const unsigned*)(_vb + voff[_k]), (LAS unsigned*)(_b + KBUF + (wave + 8 * _k) * 1024), 16, 0, 0); \
        if (wave < 4) __builtin_amdgcn_global_load_lds((const unsigned*)(_vb + voff[2]), (LAS unsigned*)(_b + KBUF + (wave + 16) * 1024), 16, 0, 0); } while (0)
    A64_DMA(0, 0);
    bf16x8 qf[4][3];
#pragma unroll
    for (int qb = 0; qb < 4; ++qb) { const bf16_t* qp = Q + (size_t)(qrow0 + wave * 64 + qb * 16 + i16) * 768 + h * 96 + g * 8;
#pragma unroll
        for (int s = 0; s < 3; ++s) qf[qb][s] = *(const bf16x8*)(qp + s * 32); }
    asm volatile("s_waitcnt vmcnt(0)" ::: "memory");
    A16_BAR();
    f32x4_t o[4][4] = {}, ol[4] = {};
    const bf16x8 ones = {(short)0x3F80, (short)0x3F80, (short)0x3F80, (short)0x3F80, (short)0x3F80, (short)0x3F80, (short)0x3F80, (short)0x3F80};
    unsigned kroff[3];
#pragma unroll
    for (int s2 = 0; s2 < 3; ++s2) kroff[s2] = i16 * KSTR + (((4 * s2 + g) ^ i16) << 4);
    const unsigned vroff = KBUF + (4 * g + (i16 >> 2)) * VSTR + (i16 & 3) * 8;
    for (int t = 0; t < nt; ++t) {
        const LAS unsigned char* sb = lds + (t & 1) * STAGE;
        if (t + 1 < nt) A64_DMA(t + 1, (t + 1) & 1);
        constexpr int KPD = 2;
#define A64_KF(idx) (*(const LAS bf16x8*)(sb + kroff[(idx) % 3] + (16 * ((idx) / 3)) * KSTR))
        bf16x8 kfr[KPD + 1];
#pragma unroll
        for (int i = 0; i < KPD; ++i) kfr[i] = A64_KF(i);
#pragma unroll
        for (int j = 0; j < 4; ++j) {
            f32x4_t st[2][4];
#pragma unroll
            for (int kb = 0; kb < 2; ++kb)
#pragma unroll
                for (int s = 0; s < 3; ++s) { const int idx = 3 * (2 * j + kb) + s;
                    if (idx + KPD < 24) kfr[(idx + KPD) % (KPD + 1)] = A64_KF(idx + KPD);
                    __builtin_amdgcn_s_setprio(1);
#pragma unroll
                    for (int qb = 0; qb < 4; ++qb) st[kb][qb] = __builtin_amdgcn_mfma_f32_16x16x32_bf16(kfr[idx % (KPD + 1)], qf[qb][s], s == 0 ? (f32x4_t){0.f, 0.f, 0.f, 0.f} : st[kb][qb], 0, 0, 0);
                    __builtin_amdgcn_s_setprio(0); }
            bf16x8 vf[4];
#pragma unroll
            for (int dvb = 0; dvb < 4; ++dvb) { const LAS unsigned char* vp = sb + vroff + (32 * j) * VSTR + dvb * 32;
                const s16x4 lo = vtr(vp), hh = vtr(vp + 16 * VSTR); vf[dvb] = (bf16x8){lo[0], lo[1], lo[2], lo[3], hh[0], hh[1], hh[2], hh[3]}; }
            bf16x8 pa[4];
#pragma unroll
            for (int qb = 0; qb < 4; ++qb) { f32x4_t a = st[0][qb], b = st[1][qb];
#pragma unroll
                for (int r = 0; r < 4; ++r) { a[r] = __builtin_amdgcn_exp2f(a[r]); b[r] = __builtin_amdgcn_exp2f(b[r]); }
                pa[qb] = __builtin_bit_cast(bf16x8, (g8::u32x4){g8::cvtpk(a[0], a[1]), g8::cvtpk(a[2], a[3]), g8::cvtpk(b[0], b[1]), g8::cvtpk(b[2], b[3])}); }
            __builtin_amdgcn_s_setprio(1);
#pragma unroll
            for (int dvb = 0; dvb < 4; ++dvb)
#pragma unroll
                for (int qb = 0; qb < 4; ++qb) o[qb][dvb] = __builtin_amdgcn_mfma_f32_16x16x32_bf16(pa[qb], vf[dvb], o[qb][dvb], 0, 0, 0);
#pragma unroll
            for (int qb = 0; qb < 4; ++qb) ol[qb] = __builtin_amdgcn_mfma_f32_16x16x32_bf16(pa[qb], ones, ol[qb], 0, 0, 0);
            __builtin_amdgcn_s_setprio(0);
        }
        asm volatile("s_waitcnt vmcnt(0)" ::: "memory");
        A16_BAR();
    }
#pragma unroll
    for (int qb = 0; qb < 4; ++qb)
#pragma unroll
        for (int r = 0; r < 4; ++r) { const int q = qb * 16 + 4 * g + r; const float rl = 1.0f / ol[qb][r];
            bf16_t* op = O + (size_t)(qrow0 + wave * 64 + q) * 512 + h * 64 + i16;
#pragma unroll
            for (int dvb = 0; dvb < 4; ++dvb) op[dvb * 16] = (bf16_t)f2bf(o[qb][dvb][r] * rl); }
#undef A64_DMA
#undef A64_KF
}
#undef A16_BAR
}

namespace rt {
using at::bf16x8; using at::s16x4; using at::f32x16; using at::crow; using at::vtr;
constexpr int TSTR = 320;
constexpr int KSTR2 = 272;
constexpr size_t SLOT = 32768;
__device__ __forceinline__ bf16_t* slot_ptr(bf16_t* ST, int dir, int bh, int c) { return ST + ((size_t)((dir * 16 + bh) * 66 + c)) * 16384; }
__device__ __forceinline__ float log2_decay(const float* dec, int l, int h) { const float x = dec[l * 4 + h]; return -log1pf(expf(-x)) * 1.4426950408889634f; }
#define RT_BAR() do { asm volatile("s_waitcnt vmcnt(0) lgkmcnt(0)" ::: "memory"); __builtin_amdgcn_s_barrier(); asm volatile("" ::: "memory"); } while (0)
__device__ __forceinline__ g8::u32x4 scale8(const g8::u32x4& w, float s) { g8::f32x4 a, b; g8::unpack8(w, a, b); return g8::pack8(a * s, b * s); }
__device__ __forceinline__ bf16x8 tr_frag(const LAS unsigned char* tile, int k0, int cb, int lane) {
    const int hi = lane >> 5, q = (lane & 15) >> 2, p = lane & 3, g1 = (lane >> 4) & 1;
    const LAS unsigned char* a = tile + (k0 + 8 * hi + q) * TSTR + (cb * 32 + 16 * g1 + 4 * p) * 2;
    const s16x4 lo = vtr(a), hh = vtr(a + 4 * TSTR);
    return (bf16x8){lo[0], lo[1], lo[2], lo[3], hh[0], hh[1], hh[2], hh[3]};
}
__device__ __forceinline__ bf16x8 tr_frag_perm(const LAS unsigned char* tile, int k0, int cb, int lane) {
    const int hi = lane >> 5, q = (lane & 15) >> 2, p = lane & 3, g1 = (lane >> 4) & 1;
    const LAS unsigned char* a = tile + (k0 + 4 * hi + q) * TSTR + (cb * 32 + 16 * g1 + 4 * p) * 2;
    const s16x4 lo = vtr(a), hh = vtr(a + 8 * TSTR);
    return (bf16x8){lo[0], lo[1], lo[2], lo[3], hh[0], hh[1], hh[2], hh[3]};
}
__device__ __forceinline__ void chunk_kv_unit(LAS unsigned char* lds, const bf16_t* RET, bf16_t* ST, float lf, float lb, int bh, int c, int tid) {
    const int lane = tid & 63, wave = __builtin_amdgcn_readfirstlane(tid >> 6), b = bh >> 2, h = bh & 3;
    const int r0 = c < 2 ? ML + b * CTX + c * 128 : b * SEQ + (c - 2) * 128;
    LAS unsigned char* Kf = lds; LAS unsigned char* Kb = lds + 128 * TSTR; LAS unsigned char* Vt = lds + 2 * 128 * TSTR;
#pragma unroll
    for (int i = 0; i < 4; ++i) { const int ch = tid + i * 512, row = ch >> 4, cc = ch & 15;
        const g8::u32x4 kv = *(const g8::u32x4*)(RET + (size_t)(r0 + row) * 2048 + 512 + h * 128 + cc * 8), vv = *(const g8::u32x4*)(RET + (size_t)(r0 + row) * 2048 + 1024 + h * 128 + cc * 8);
        *(LAS g8::u32x4*)(Kf + row * TSTR + cc * 16) = scale8(kv, __builtin_amdgcn_exp2f(lf * (float)(127 - row)));
        *(LAS g8::u32x4*)(Kb + row * TSTR + cc * 16) = scale8(kv, __builtin_amdgcn_exp2f(lb * (float)row));
        *(LAS g8::u32x4*)(Vt + row * TSTR + cc * 16) = vv; }
    RT_BAR();
    const int dir = wave >> 2, db = wave & 3; const LAS unsigned char* Kt = dir ? Kb : Kf;
    f32x16 acc[4] = {};
#pragma unroll
    for (int s = 0; s < 8; ++s) { const bf16x8 a = tr_frag(Kt, 16 * s, db, lane);
#pragma unroll
        for (int vb = 0; vb < 4; ++vb) acc[vb] = __builtin_amdgcn_mfma_f32_32x32x16_bf16(a, tr_frag(Vt, 16 * s, vb, lane), acc[vb], 0, 0, 0); }
    bf16_t* dst = slot_ptr(ST, dir, bh, c) + (lane & 31);
#pragma unroll
    for (int vb = 0; vb < 4; ++vb)
#pragma unroll
        for (int r = 0; r < 16; ++r) dst[(size_t)(32 * db + crow(r, lane >> 5)) * 128 + vb * 32] = (bf16_t)f2bf(acc[vb][r]);
    RT_BAR();
}
__device__ __forceinline__ void scan_states(bf16_t* ST, const float* decf, const float* decb, int l, int gtid, int gsize) {
    for (int v = gtid; v < 2 * 16 * 2048; v += gsize) {
        const int dir = v >> 15, bh = (v >> 11) & 15, e = v & 2047, h = bh & 3;
        const float cdec = __builtin_amdgcn_exp2f(128.0f * log2_decay(dir ? decb : decf, l, h));
        g8::u32x4* base = (g8::u32x4*)slot_ptr(ST, dir, bh, 0) + e;
        g8::f32x4 s0, s1, a0, a1, b0, b1;
        g8::unpack8(base[0], a0, a1); g8::unpack8(base[2048], b0, b1);
        if (dir == 0) { s0 = a0 * cdec + b0; s1 = a1 * cdec + b1; } else { s0 = a0 + b0 * cdec; s1 = a1 + b1 * cdec; }
        const int start = dir ? 65 : 2, step = dir ? -1 : 1;
        for (int n0 = 0; n0 < 64; n0 += 16) { g8::u32x4 kv[16];
#pragma unroll
            for (int j = 0; j < 16; ++j) kv[j] = base[(size_t)(start + (n0 + j) * step) * 2048];
#pragma unroll
            for (int j = 0; j < 16; ++j) { g8::u32x4* p = base + (size_t)(start + (n0 + j) * step) * 2048; g8::f32x4 k0, k1; g8::unpack8(kv[j], k0, k1);
                *p = g8::pack8(s0, s1); s0 = s0 * cdec + k0; s1 = s1 * cdec + k1; } }
    }
}
__device__ __forceinline__ void chunk_out_unit(LAS unsigned char* lds, bf16_t* RET, const bf16_t* ST, const float* gng, const float* gnb, float lf, float lb, int bh, int c, int tid, bool dry = false) {
    const int lane = tid & 63, wave = __builtin_amdgcn_readfirstlane(tid >> 6), r32 = lane & 31, hi = lane >> 5, b = bh >> 2, h = bh & 3;
    const int r0 = c < 2 ? ML + b * CTX + c * 128 : b * SEQ + (c - 2) * 128;
    const int qb = wave & 3, dvh = wave >> 2;
    LAS unsigned char* Kt = lds; LAS unsigned char* Vt = lds + 128 * KSTR2; LAS unsigned char* St = Vt + 128 * TSTR;
    const bool has_f = (c != 0), has_b = (c != 1);
    const bf16_t* sf = slot_ptr((bf16_t*)ST, 0, bh, c == 1 ? 0 : c); const bf16_t* sb = slot_ptr((bf16_t*)ST, 1, bh, c == 0 ? 1 : c);
#pragma unroll
    for (int i = 0; i < 4; ++i) { const int ch = tid + i * 512, row = ch >> 4, cc = ch & 15;
        *(LAS g8::u32x4*)(Kt + row * KSTR2 + cc * 16) = *(const g8::u32x4*)(RET + (size_t)(r0 + row) * 2048 + 512 + h * 128 + cc * 8);
        *(LAS g8::u32x4*)(Vt + row * TSTR + cc * 16) = *(const g8::u32x4*)(RET + (size_t)(r0 + row) * 2048 + 1024 + h * 128 + cc * 8);
        if (has_f) *(LAS g8::u32x4*)(St + row * TSTR + cc * 16) = *(const g8::u32x4*)(sf + (size_t)row * 128 + cc * 8); }
    g8::u32x4 sbr[4];
    if (has_b) {
#pragma unroll
        for (int i = 0; i < 4; ++i) { const int ch = tid + i * 512, row = ch >> 4, cc = ch & 15; sbr[i] = *(const g8::u32x4*)(sb + (size_t)row * 128 + cc * 8); } }
    bf16x8 qf[8];
    { const bf16_t* qp = RET + (size_t)(r0 + qb * 32 + r32) * 2048 + h * 128 + hi * 8;
#pragma unroll
      for (int d0 = 0; d0 < 8; ++d0) qf[d0] = *(const bf16x8*)(qp + d0 * 16); }
    RT_BAR();
    f32x16 o[2] = {}, af[2] = {}, ab[2] = {};
    const int iq = qb * 32 + r32;
#pragma unroll
    for (int kt = 0; kt < 2; ++kt) {
        f32x16 p0 = {}, p1 = {};
#pragma unroll
        for (int d0 = 0; d0 < 8; ++d0) {
            const bf16x8 a0 = *(const LAS bf16x8*)(Kt + (64 * kt + r32) * KSTR2 + d0 * 32 + hi * 16), a1 = *(const LAS bf16x8*)(Kt + (64 * kt + 32 + r32) * KSTR2 + d0 * 32 + hi * 16);
            p0 = __builtin_amdgcn_mfma_f32_32x32x16_bf16(a0, qf[d0], p0, 0, 0, 0);
            p1 = __builtin_amdgcn_mfma_f32_32x32x16_bf16(a1, qf[d0], p1, 0, 0, 0);
        }
#pragma unroll
        for (int r = 0; r < 16; ++r) { const int j0 = 64 * kt + crow(r, hi), d0_ = iq - j0, d1_ = d0_ - 32;
            p0[r] *= __builtin_amdgcn_exp2f(d0_ >= 0 ? lf * (float)d0_ : lb * (float)(-d0_));
            p1[r] *= __builtin_amdgcn_exp2f(d1_ >= 0 ? lf * (float)d1_ : lb * (float)(-d1_)); }
        bf16x8 pa[4];
#pragma unroll
        for (int ks = 0; ks < 4; ++ks) { unsigned w[4];
#pragma unroll
            for (int j = 0; j < 4; ++j) { const int r = 8 * (ks & 1) + 2 * j; w[j] = (ks < 2) ? g8::cvtpk(p0[r], p0[r + 1]) : g8::cvtpk(p1[r], p1[r + 1]); }
            pa[ks] = __builtin_bit_cast(bf16x8, (g8::u32x4){w[0], w[1], w[2], w[3]}); }
#pragma unroll
        for (int ks = 0; ks < 4; ++ks)
#pragma unroll
            for (int d0 = 0; d0 < 2; ++d0) o[d0] = __builtin_amdgcn_mfma_f32_32x32x16_bf16(pa[ks], tr_frag_perm(Vt, 64 * kt + 16 * ks, dvh * 2 + d0, lane), o[d0], 0, 0, 0);
    }
    if (has_f) {
#pragma unroll
        for (int s = 0; s < 8; ++s)
#pragma unroll
            for (int d0 = 0; d0 < 2; ++d0) af[d0] = __builtin_amdgcn_mfma_f32_32x32x16_bf16(qf[s], tr_frag(St, 16 * s, dvh * 2 + d0, lane), af[d0], 0, 0, 0);
    }
    RT_BAR();
    if (has_b) {
#pragma unroll
        for (int i = 0; i < 4; ++i) { const int ch = tid + i * 512, row = ch >> 4, cc = ch & 15;
            *(LAS g8::u32x4*)(St + row * TSTR + cc * 16) = sbr[i]; }
    }
    RT_BAR();
    if (has_b) {
#pragma unroll
        for (int s = 0; s < 8; ++s)
#pragma unroll
            for (int d0 = 0; d0 < 2; ++d0) ab[d0] = __builtin_amdgcn_mfma_f32_32x32x16_bf16(qf[s], tr_frag(St, 16 * s, dvh * 2 + d0, lane), ab[d0], 0, 0, 0);
    }
    LAS float* Ot = (LAS float*)lds;
#pragma unroll
    for (int r = 0; r < 16; ++r) { const int i = qb * 32 + crow(r, hi); const float qdf = __builtin_amdgcn_exp2f(lf * (float)(i + 1)), qdb = __builtin_amdgcn_exp2f(lb * (float)(128 - i));
#pragma unroll
        for (int d0 = 0; d0 < 2; ++d0) Ot[i * 132 + dvh * 64 + d0 * 32 + r32] = o[d0][r] + qdf * af[d0][r] + qdb * ab[d0][r]; }
    RT_BAR();
    { const int row = tid >> 2, qt = tid & 3; const LAS float* op = Ot + row * 132 + qt * 32; float v[32]; float s = 0.f;
#pragma unroll
      for (int j = 0; j < 32; ++j) { v[j] = op[j]; s += v[j]; }
      s += dppx<0xB1>(s); s += dppx<0x4E>(s); const float mu = s * (1.0f / 128.f); float q = 0.f;
#pragma unroll
      for (int j = 0; j < 32; ++j) { v[j] -= mu; q += v[j] * v[j]; }
      q += dppx<0xB1>(q); q += dppx<0x4E>(q); const float rstd = 1.0f / sqrtf(q * (1.0f / 128.f) + EPS);
      bf16_t* rowp = RET + (size_t)(r0 + row) * 2048 + h * 128 + qt * 32; const float* gg = gng + h * 128 + qt * 32; const float* gb = gnb + h * 128 + qt * 32;
#pragma unroll
      for (int j8 = 0; j8 < 4; ++j8) { g8::f32x4 g0, g1; g8::unpack8(*(const g8::u32x4*)(rowp + 1536 + j8 * 8), g0, g1); g8::f32x4 y0, y1;
#pragma unroll
          for (int j = 0; j < 4; ++j) { const float ga = g0[j], gb_ = g1[j];
              y0[j] = ga * g8::fsigmoid(ga) * (v[j8 * 8 + j] * rstd * gg[j8 * 8 + j] + gb[j8 * 8 + j]);
              y1[j] = gb_ * g8::fsigmoid(gb_) * (v[j8 * 8 + 4 + j] * rstd * gg[j8 * 8 + 4 + j] + gb[j8 * 8 + 4 + j]); }
          if (!dry) *(g8::u32x4*)(rowp + j8 * 8) = g8::pack8(y0, y1); } }
    RT_BAR();
}
__device__ __forceinline__ void gmlp_unit(LAS unsigned char* lds, bf16_t* UV, const float* ws, const float* bs, const float* PARTV, const float* lng, const float* lnb, int cidx, int g, int tid, bool dry = false) {
    const int lane = tid & 63, wave = __builtin_amdgcn_readfirstlane(tid >> 6), r32 = lane & 31, hi = lane >> 5, r0 = cidx * 128;
    LAS unsigned char* Wt = lds; LAS unsigned char* Vt = lds + 128 * KSTR2;
    LAS float* st = (LAS float*)(lds + 128 * KSTR2 + 128 * TSTR);
    if (tid < 128) { const float* pp = PARTV + (size_t)(r0 + tid) * 32; float s1 = 0.f, s2 = 0.f;
#pragma unroll
        for (int q = 0; q < 8; ++q) { const g8::f32x4 a = *(const g8::f32x4*)(pp + 4 * q); s1 += a[0] + a[2]; s2 += a[1] + a[3]; }
        const float mu = s1 * (1.0f / 512.f), var = s2 * (1.0f / 512.f) - mu * mu; st[tid * 2] = mu; st[tid * 2 + 1] = 1.0f / sqrtf((var > 0.f ? var : 0.f) + EPS); }
#pragma unroll
    for (int i = 0; i < 4; ++i) { const int ch = tid + i * 512, row = ch >> 4, cc = ch & 15;
        const g8::f32x4 w0 = *(const g8::f32x4*)(ws + row * 128 + cc * 8), w1 = *(const g8::f32x4*)(ws + row * 128 + cc * 8 + 4);
        *(LAS g8::u32x4*)(Wt + row * KSTR2 + cc * 16) = g8::pack8(w0, w1); }
    g8::u32x4 vraw[4];
#pragma unroll
    for (int i = 0; i < 4; ++i) { const int ch = tid + i * 512, row = ch >> 4, cc = ch & 15; vraw[i] = *(const g8::u32x4*)(UV + (size_t)(r0 + row) * 1024 + 512 + g * 128 + cc * 8); }
    RT_BAR();
#pragma unroll
    for (int i = 0; i < 4; ++i) { const int ch = tid + i * 512, row = ch >> 4, cc = ch & 15; g8::f32x4 x0, x1;
        g8::unpack8(vraw[i], x0, x1);
        const float mu = st[row * 2], rstd = st[row * 2 + 1]; const float* gg = lng + g * 128 + cc * 8; const float* gb = lnb + g * 128 + cc * 8;
        const g8::f32x4 g0 = *(const g8::f32x4*)gg, g1 = *(const g8::f32x4*)(gg + 4), b0 = *(const g8::f32x4*)gb, b1 = *(const g8::f32x4*)(gb + 4);
        *(LAS g8::u32x4*)(Vt + row * TSTR + cc * 16) = g8::pack8((x0 - mu) * rstd * g0 + b0, (x1 - mu) * rstd * g1 + b1); }
    RT_BAR();
    const int ib = wave & 3, cb0 = (wave >> 2) * 2;
    f32x16 acc[2] = {};
#pragma unroll
    for (int s = 0; s < 8; ++s) { const bf16x8 a = *(const LAS bf16x8*)(Wt + (32 * ib + r32) * KSTR2 + s * 32 + hi * 16);
#pragma unroll
        for (int d0 = 0; d0 < 2; ++d0) acc[d0] = __builtin_amdgcn_mfma_f32_32x32x16_bf16(a, tr_frag(Vt, 16 * s, cb0 + d0, lane), acc[d0], 0, 0, 0); }
#pragma unroll
    for (int r = 0; r < 16; ++r) { const int i = 32 * ib + crow(r, hi); const float bi = bs[i];
#pragma unroll
        for (int d0 = 0; d0 < 2; ++d0) { bf16_t* up = UV + (size_t)(r0 + i) * 1024 + g * 128 + (cb0 + d0) * 32 + r32; const bf16_t nv = (bf16_t)f2bf(bf2f(*up) * (acc[d0][r] + bi)); if (!dry) *up = nv; } }
    RT_BAR();
}
#undef RT_BAR
}

__device__ __forceinline__ float grp_sum(float v, int width) {
#pragma unroll
    for (int o = 1; o < 64; o <<= 1) if (o < width) v += __shfl_xor(v, o);
    return v;
}
__device__ __forceinline__ void p_rowpass_a_vec(Frame& F, int l) {
    const int gw = F.bid * NWAVES + F.wave, NGW = F.G * NWAVES, lane = F.lane;
    const float* qag = FIN(I_QAG) + l * 384; const float* kvag = FIN(I_KVAG) + l * 256; const float* krg = FIN(I_KRG) + l * 32;
    const float* lng = FIN(I_LNG) + l * 512; const float* lnb = FIN(I_LNB) + l * 512;
    for (int r = gw; r < M; r += NGW) {
        g8::u32x4* pq = (g8::u32x4*)(F_CQ + (size_t)r * 384) + lane; g8::u32x4* pk = (g8::u32x4*)(F_CKV + (size_t)r * 256) + lane;
        g8::u32x4* pr = (g8::u32x4*)(F_KR + (size_t)r * 32) + lane; g8::u32x4* pv = (g8::u32x4*)(F_UV + (size_t)r * 1024 + 512) + lane;
        g8::u32x4 wq = {0u, 0u, 0u, 0u}, wk = wq, wr = wq; if (lane < 48) wq = *pq; if (lane < 32) wk = *pk; if (lane < 4) wr = *pr; const g8::u32x4 wv = *pv;
        g8::f32x4 q0, q1, k0, k1, r0, r1, v0, v1; g8::unpack8(wq, q0, q1); g8::unpack8(wk, k0, k1); g8::unpack8(wr, r0, r1); g8::unpack8(wv, v0, v1);
        const float rsq = 1.0f / sqrtf(wave_sum(sumsq8(q0, q1)) * (1.0f / 384.f) + EPS), rsk = 1.0f / sqrtf(wave_sum(sumsq8(k0, k1)) * (1.0f / 256.f) + EPS);
        const float rsr = 1.0f / sqrtf(wave_sum(sumsq8(r0, r1)) * (1.0f / 32.f) + EPS);
        const float mu = wave_sum((v0[0] + v0[1]) + (v0[2] + v0[3]) + (v1[0] + v1[1]) + (v1[2] + v1[3])) * (1.0f / 512.f);
        v0 = v0 - mu; v1 = v1 - mu; const float rsv = 1.0f / sqrtf(wave_sum(sumsq8(v0, v1)) * (1.0f / 512.f) + EPS);
        if (lane < 48) { const g8::f32x4 g0 = *(const g8::f32x4*)(qag + lane * 8), g1 = *(const g8::f32x4*)(qag + lane * 8 + 4); *pq = g8::pack8(q0 * rsq * g0, q1 * rsq * g1); }
        if (lane < 32) { const g8::f32x4 g0 = *(const g8::f32x4*)(kvag + lane * 8), g1 = *(const g8::f32x4*)(kvag + lane * 8 + 4); *pk = g8::pack8(k0 * rsk * g0, k1 * rsk * g1); }
        { const int vi = lane & 3; const g8::f32x4 g0 = *(const g8::f32x4*)(krg + vi * 8), g1 = *(const g8::f32x4*)(krg + vi * 8 + 4);
          g8::f32x4 y0 = r0 * rsr * g0, y1 = r1 * rsr * g1, p0, p1;
#pragma unroll
          for (int i = 0; i < 4; ++i) { p0[i] = dppx<0xB1>(y0[i]); p1[i] = dppx<0xB1>(y1[i]); }
          if (r < ML) rope8(y0, y1, p0, p1, F_ROPE + (size_t)(r & (SEQ - 1)) * 32, vi);
          if (lane < 4) *pr = g8::pack8(y0, y1); }
        { const g8::f32x4 g0 = *(const g8::f32x4*)(lng + lane * 8), g1 = *(const g8::f32x4*)(lng + lane * 8 + 4), b0 = *(const g8::f32x4*)(lnb + lane * 8), b1 = *(const g8::f32x4*)(lnb + lane * 8 + 4);
          *pv = g8::pack8(v0 * rsv * g0 + b0, v1 * rsv * g1 + b1); }
    }
}
__device__ __forceinline__ void p_rowpass_b_vec(Frame& F, int l) {
    const int gw = F.bid * NWAVES + F.wave, NGW = F.G * NWAVES, lane = F.lane, grp = lane >> 4, i = lane & 15;
    const float* qng = FIN(I_QNG) + l * 96; const float* kng = FIN(I_KNG) + l * 64;
    g8::f32x4 gq0 = {0.f, 0.f, 0.f, 0.f}, gq1 = gq0, gk0 = gq0, gk1 = gq0;
    if (i < 12) { gq0 = *(const g8::f32x4*)(qng + i * 8); gq1 = *(const g8::f32x4*)(qng + i * 8 + 4); }
    if (i < 8) { gk0 = *(const g8::f32x4*)(kng + i * 8); gk1 = *(const g8::f32x4*)(kng + i * 8 + 4); }
    for (int r = gw; r < M; r += NGW) {
        const float* tab = F_ROPE + (size_t)(r & (SEQ - 1)) * 32;
#pragma unroll
        for (int it = 0; it < 2; ++it) { const int h = it * 4 + grp;
            g8::u32x4* qp = (g8::u32x4*)(F_Q + (size_t)r * 768 + h * 96) + i;
            g8::u32x4 wq = {0u, 0u, 0u, 0u}; if (i < 12) wq = *qp;
            const g8::u32x4 wkv = *((const g8::u32x4*)(F_KVR + (size_t)r * 1024 + h * 128) + i);
            g8::u32x4 wkr = {0u, 0u, 0u, 0u}; if (i >= 8 && i < 12) wkr = *((const g8::u32x4*)(F_KR + (size_t)r * 32) + (i - 8));
            g8::f32x4 q0, q1, k0, k1; g8::unpack8(wq, q0, q1); g8::unpack8(wkv, k0, k1);
            const float rq = 1.0f / sqrtf(row16_sum(sumsq8(q0, q1)) * (1.0f / 96.f) + EPS);
            const float rk = 1.0f / sqrtf(row16_sum(i < 8 ? sumsq8(k0, k1) : 0.f) * (1.0f / 64.f) + EPS);
            g8::f32x4 y0 = q0 * rq * gq0, y1 = q1 * rq * gq1, p0, p1;
#pragma unroll
            for (int j = 0; j < 4; ++j) { p0[j] = dppx<0xB1>(y0[j]); p1[j] = dppx<0xB1>(y1[j]); }
            if (r < ML && i >= 8 && i < 12) rope8(y0, y1, p0, p1, tab, i - 8);
            if (i < 12) *qp = g8::pack8(y0 * QSCALE, y1 * QSCALE);
            g8::u32x4* kp = (g8::u32x4*)(F_K + (size_t)r * 768 + h * 96) + i;
            if (i < 8) *kp = g8::pack8(k0 * rk * gk0, k1 * rk * gk1);
            else if (i < 12) *kp = wkr;
            if (i >= 8) *((g8::u32x4*)(F_V + (size_t)r * 512 + h * 64) + (i - 8)) = wkv;
        }
    }
}

constexpr int LDS_TT = 131072;
__device__ __forceinline__ const char* smw(const Frame& F, int l, size_t off) { return (const char*)(ws_(F.A) + WS_WSM + (size_t)l * SMW_L + off); }
__device__ __forceinline__ void p_router_fast(Frame& F, int l, int ntok) {
    using at::bf16x8; using at::f32x16; using at::crow;
    LAS int* hist = (LAS int*)((LAS unsigned char*)F.lds);
    const int lane = F.lane, r32 = lane & 31, hi = lane >> 5;
    __syncthreads();
    if (F.tid < 64) hist[F.tid] = 0;
    __syncthreads();
    const bf16_t* Rh = (const bf16_t*)smw(F, l, SMW_RT); const bf16_t* Rl = Rh + 64 * 1024;
    const float* bias = FIN(I_MBIAS) + l * NEXP;
    LAS float* part = (LAS float*)((LAS unsigned char*)F.lds + 1024);
    LAS unsigned char* wb = (LAS unsigned char*)F.lds + 36864;
    constexpr int WBUF = 128 * 272;
    const int pair = F.wave & 3, half = F.wave >> 2, ntask = (ntok + 31) >> 5;
    const bf16_t* wsrc = Rh + (size_t)(F.tid >> 4) * 1024 + (F.tid & 15) * 8;
    const unsigned wdst = (unsigned)(F.tid >> 4) * 272u + (unsigned)(F.tid & 15) * 16u;
    for (int it = 0; (it * F.G) * 4 < ntask; ++it) {
        const int w = (it * F.G + F.bid) * 4 + pair; const bool live = w < ntask;
        const int tok = (live ? w : 0) * 32 + r32;
        const bf16_t* hp = F_H + (size_t)tok * D + hi * 8 + half * 64;
        g8::u32x4 wr[4]; bf16x8 hq[4], hn[4];
#pragma unroll
        for (int i = 0; i < 4; ++i) wr[i] = *(const g8::u32x4*)(wsrc + (size_t)i * 32 * 1024);
#pragma unroll
        for (int s2 = 0; s2 < 4; ++s2) hq[s2] = *(const bf16x8*)(hp + s2 * 16);
        __syncthreads();
#pragma unroll
        for (int i = 0; i < 4; ++i) *(LAS g8::u32x4*)(wb + wdst + i * 32 * 272) = wr[i];
        __syncthreads();
        f32x16 acc0 = {}, acc1 = {};
        for (int c = 0; c < 8; ++c) {
            const LAS unsigned char* ap = wb + (c & 1) * WBUF + r32 * 272 + (half * 64 + hi * 8) * 2;
            if (c + 1 < 8) {
#pragma unroll
                for (int i = 0; i < 4; ++i) wr[i] = *(const g8::u32x4*)(wsrc + (c + 1) * 128 + (size_t)i * 32 * 1024);
#pragma unroll
                for (int s2 = 0; s2 < 4; ++s2) hn[s2] = *(const bf16x8*)(hp + (c + 1) * 128 + s2 * 16); }
#pragma unroll
            for (int s2 = 0; s2 < 4; ++s2) {
                acc0 = __builtin_amdgcn_mfma_f32_32x32x16_bf16(*(const LAS bf16x8*)(ap + s2 * 32), hq[s2], acc0, 0, 0, 0);
                acc1 = __builtin_amdgcn_mfma_f32_32x32x16_bf16(*(const LAS bf16x8*)(ap + 32 * 272 + s2 * 32), hq[s2], acc1, 0, 0, 0);
                acc0 = __builtin_amdgcn_mfma_f32_32x32x16_bf16(*(const LAS bf16x8*)(ap + 64 * 272 + s2 * 32), hq[s2], acc0, 0, 0, 0);
                acc1 = __builtin_amdgcn_mfma_f32_32x32x16_bf16(*(const LAS bf16x8*)(ap + 96 * 272 + s2 * 32), hq[s2], acc1, 0, 0, 0); }
            if (c + 1 < 8) {
#pragma unroll
                for (int i = 0; i < 4; ++i) *(LAS g8::u32x4*)(wb + ((c + 1) & 1) * WBUF + wdst + i * 32 * 272) = wr[i];
#pragma unroll
                for (int s2 = 0; s2 < 4; ++s2) hq[s2] = hn[s2]; }
            __syncthreads();
        }
        if (half == 1) {
#pragma unroll
            for (int r = 0; r < 16; ++r) { part[(pair * 32 + r) * 64 + lane] = acc0[r]; part[(pair * 32 + 16 + r) * 64 + lane] = acc1[r]; } }
        __syncthreads();
        if (half == 0) {
#pragma unroll
            for (int r = 0; r < 16; ++r) { acc0[r] += part[(pair * 32 + r) * 64 + lane]; acc1[r] += part[(pair * 32 + 16 + r) * 64 + lane]; } }
        __syncthreads();
        if (half == 1 || !live) continue;
        float sel[32];
#pragma unroll
        for (int r = 0; r < 16; ++r) { const int e0 = crow(r, hi), e1 = 32 + e0;
            sel[r] = 1.0f / (1.0f + expf(-acc0[r])) + bias[e0]; sel[16 + r] = 1.0f / (1.0f + expf(-acc1[r])) + bias[e1]; }
        float wk[TOPK]; int ek[TOPK]; float wsum = 0.f;
#pragma unroll
        for (int k = 0; k < TOPK; ++k) {
            float bv = -INFINITY; int bi = 0;
#pragma unroll
            for (int j = 0; j < 32; ++j) { const int e = (j >> 4) * 32 + crow(j & 15, hi); if (sel[j] > bv || (sel[j] == bv && e < bi)) { bv = sel[j]; bi = e; } }
            const float ov = xlane32(bv, lane); const int oi = xlane32i(bi, lane);
            if (ov > bv || (ov == bv && oi < bi)) { bv = ov; bi = oi; }
#pragma unroll
            for (int j = 0; j < 32; ++j) { const int e = (j >> 4) * 32 + crow(j & 15, hi); sel[j] = (e == bi) ? -INFINITY : sel[j]; }
            ek[k] = bi; wk[k] = bv - bias[bi]; wsum += wk[k];
        }
        if (hi == 0) {
            const float sc = 2.5f / wsum;
#pragma unroll
            for (int k = 0; k < TOPK; ++k) { F_IDX[tok * TOPK + k] = ek[k]; F_WTS[tok * TOPK + k] = wk[k] * sc; F_SLOT[tok * TOPK + k] = atomicAdd((int*)&hist[ek[k]], 1) | (F.bid << 20); }
        }
    }
    __syncthreads();
    if (F.tid < 64) F_BLKBASE[(l * 256 + F.bid) * 64 + F.tid] = (int)atomicAdd(F_ctl + CW_CNT + l * 64 + F.tid, (unsigned)hist[F.tid]);
    for (int i = F.bid * NTHR + F.tid; i < APAD; i += F.G * NTHR) F_ROWTOK[i] = 0;
}

__device__ __forceinline__ void p_inproj_fast(Frame& F, int l) {
    SchedInproj S{(const char*)F_H, smw(F, l, SMW_WIN), F.G, F.bid}; EpiInproj E{F_RET, F_CQ, F_CKV, F_KR, F_UV, FWS(float, WS_PART), FWS(float, WS_PARTV), FIN(I_KRG) + l * 32, F_ROPE};
    g8::gemm_phase<false>((LAS unsigned char*)F.lds, S, E, F.tid);
}
__device__ __forceinline__ void p_mlaup_fast(Frame& F, int l, int pm0 = 0, int nM = M / 256, int Gs = 0) {
    SchedMlaUp S{(const char*)F_CQ, (const char*)F_CKV, smw(F, l, SMW_WUQ), smw(F, l, SMW_WUKV), Gs > 0 ? Gs : F.G, F.bid, pm0, nM}; EpiMlaFused E{F_Q, F_K, F_V, F_KR, FIN(I_QNG) + l * 96, FIN(I_KNG) + l * 64, F_ROPE, FWS(float, WS_RS) + (size_t)l * M * 2, (LAS float*)((LAS unsigned char*)F.lds + LDS_TT)};
    g8::gemm_phase<false>((LAS unsigned char*)F.lds, S, E, F.tid);
}
__device__ __forceinline__ void p_rowscale(Frame& F, int l, int r0, int r1, int first, int stride) {
    const float* PART = FWS(float, WS_PART); float* RS = FWS(float, WS_RS) + (size_t)l * M * 2;
    for (int r = r0 + first; r < r1; r += stride) { const g8::f32x4* pp = (const g8::f32x4*)(PART + (size_t)r * 24);
        const g8::f32x4 a = pp[0], b = pp[1], c = pp[2], d = pp[3], e = pp[4];
        const float sq = ((a[0] + a[1]) + (a[2] + a[3])) + ((b[0] + b[1]) + (b[2] + b[3])) + ((c[0] + c[1]) + (c[2] + c[3])), sk = ((d[0] + d[1]) + (d[2] + d[3])) + ((e[0] + e[1]) + (e[2] + e[3]));
        RS[(size_t)r * 2] = 1.0f / sqrtf(sq * (1.0f / 384.f) + EPS); RS[(size_t)r * 2 + 1] = 1.0f / sqrtf(sk * (1.0f / 256.f) + EPS); }
}
template <int BR> __device__ __forceinline__ void p_merge_br(Frame& F, int l, int nrows) {
    const char* abr = BR == 0 ? (const char*)F_RET : (BR == 1 ? (const char*)F_AO : (const char*)F_UV);
    SchedMerge S{(const char*)F_H, smw(F, l, SMW_WG) + (size_t)BR * 1024 * 2048, abr, smw(F, l, SMW_WBR) + (size_t)BR * 1024 * 1024, BR == 0 ? 4096u : (BR == 1 ? 1024u : 2048u), F.G, F.bid, nrows / 256, BR};
    EpiMerge<BR> E{F_Y, (u32x4*)(ws_(F.A) + WS_SCR + (size_t)F.bid * 131072), F_ctl + CW_MFLAG + l * 256};
    g8::gemm_phase<false>((LAS unsigned char*)F.lds, S, E, F.tid);
}
__device__ __forceinline__ void p_merge_fast(Frame& F, int l, int nrows) {
    p_merge_br<0>(F, l, nrows); asm volatile("" : "+v"(F.tid));
    p_merge_br<1>(F, l, nrows); asm volatile("" : "+v"(F.tid));
    p_merge_br<2>(F, l, nrows);
}
__device__ __forceinline__ void p_out_fast(Frame& F, int l, int nrows) {
    SchedOut S{(const char*)F_Y, smw(F, l, SMW_WOUT), F.G, F.bid, nrows / 256};
    EpiResid E{FIN(I_X), FIN(I_CTX), F_X16, F_MOD + (size_t)l * 5 * 6144 + 2 * D, l};
    g8::gemm_phase<false>((LAS unsigned char*)F.lds, S, E, F.tid);
}
__device__ __forceinline__ void p_gateup_fast(Frame& F, int l, int ntok) {
    LAS int* tt = (LAS int*)((LAS unsigned char*)F.lds + LDS_TT); moe_tiles(F, l, tt);
    SchedGateUp S{(const char*)F_H, (const char*)(ws_(F.A) + WS_MOEW), smw(F, l, SMW_SHGU), F_ROWTOK, tt, F.G, F.bid, ntok / 256}; EpiGateUp E{F_HB, F_HBS};
    g8::gemm_phase<true>((LAS unsigned char*)F.lds, S, E, F.tid);
}
__device__ __forceinline__ void p_down_fast(Frame& F, int l, int ntok, bool routed_only = false) {
    LAS int* tt = (LAS int*)((LAS unsigned char*)F.lds + LDS_TT); moe_tiles(F, l, tt);
    SchedDown S{(const char*)F_HB, (const char*)F_HBS, (const char*)(ws_(F.A) + WS_MOEW), smw(F, l, SMW_SHD), tt, F.G, F.bid, routed_only ? 0 : ntok / 256};
    EpiDown E{(unsigned char*)F_OUT, FWS(bf16_t, WS_SCR)};
    g8::gemm_phase<false>((LAS unsigned char*)F.lds, S, E, F.tid);
}
#ifndef FAST_INPROJ
#define FAST_INPROJ 1
#endif
#ifndef FAST_MLAUP
#define FAST_MLAUP 1
#endif
#ifndef FAST_MERGE
#define FAST_MERGE 1
#endif
#ifndef FAST_OUT
#define FAST_OUT 1
#endif
#ifndef FAST_MOE
#define FAST_MOE 1
#endif
#ifndef FAST_ATTN
#define FAST_ATTN 1
#endif
#ifndef FAST_RET
#define FAST_RET 1
#endif
#ifndef FAST_ROWPASS
#define FAST_ROWPASS 1
#endif

constexpr int NPL = 14;
constexpr int NPH = 1 + DEPTH * NPL;
#define REFRESH() do { int ln_; asm volatile("v_mbcnt_lo_u32_b32 %0, -1, 0\n\tv_mbcnt_hi_u32_b32 %0, -1, %0" : "=v"(ln_)); F.lane = ln_; F.tid = F.wave * 64 + ln_; } while (0)
#define IN(k) (lo <= (k) && (k) < hi)
#ifdef PROBE_A
#define STAMP(k) do { if (F.bid == 0 && F.tid == 0) ((unsigned long long*)(ws_(F.A) + WS_CTL + 262144))[(k)] = __builtin_amdgcn_s_memrealtime(); } while (0)
#else
#define STAMP(k) do {} while (0)
#endif
#ifndef REP_BAR
#define REP_BAR 1
#endif
#define SEAM(k) do { if (lo <= (k) && (k) + 1 < hi) { for (int rb_ = 0; rb_ < REP_BAR; ++rb_) xcd_barrier(bar, F.tid); } STAMP((k) + 1); REFRESH(); } while (0)


template <int L> __device__ __forceinline__ void layer_body(Frame& F, int& lo, int& hi, const XcdBarrier& bar) {
    constexpr int l = L;
    constexpr int NCTXU = ((M - ML) / 256) * 8;
    const bool MLA_SPLIT = FAST_MLAUP && FAST_RET && F.G >= 4 * NCTXU;
    {
        asm volatile("" : "+s"(lo), "+s"(hi));
        const int pb = 1 + l * NPL;
        const int nrows_mix = (l == 0) ? M : ML;
        if (l == 0) { if (IN(pb + 0)) { p_norm(F, l, 0, M); } SEAM(pb + 0); }
        if (IN(pb + 1)) { for (int rep = 0; rep < REP_INPROJ; ++rep) { if (FAST_INPROJ) p_inproj_fast(F, l); else p_inproj_naive(F, l); asm volatile("" : "+v"(F.tid)); } } SEAM(pb + 1);
        if (IN(pb + 2)) {
#if FAST_RET
            REFRESH();
            if (MLA_SPLIT && F.bid < NCTXU) { p_rowscale(F, l, ML, M, F.tid, NTHR); asm volatile("s_waitcnt vmcnt(0)" ::: "memory"); __syncthreads();
                p_mlaup_fast(F, l, ML / 256, (M - ML) / 256, NCTXU); REFRESH(); }
            else { if (MLA_SPLIT) p_rowscale(F, l, 0, ML, (F.bid - NCTXU) * NTHR + F.tid, (F.G - NCTXU) * NTHR); else p_rowscale(F, l, 0, M, F.bid * NTHR + F.tid, F.G * NTHR);
              const float* decf = FIN(I_DECF); const float* decb = FIN(I_DECB); const int u0 = MLA_SPLIT ? F.bid - NCTXU : F.bid, ust = MLA_SPLIT ? F.G - NCTXU : F.G;
              for (int rep = 0; rep < REP_R1; ++rep)
              for (int u = u0; u < 16 * 66; u += ust) { const int bh = u / 66, c = u % 66;
                  rt::chunk_kv_unit((LAS unsigned char*)F.lds, F_RET, F_ST, rt::log2_decay(decf, l, bh & 3), rt::log2_decay(decb, l, bh & 3), bh, c, F.tid); } }
#endif
        } SEAM(pb + 2);
        if (IN(pb + 3)) {
#if FAST_RET
            if (F.tid < 256) rt::scan_states(F_ST, FIN(I_DECF), FIN(I_DECB), l, F.bid * 256 + F.tid, F.G * 256);
            __syncthreads();
            REFRESH();
#endif
            for (int rep = 0; rep < REP_MLAUP; ++rep) { if (FAST_MLAUP) { if (MLA_SPLIT) p_mlaup_fast(F, l, 0, ML / 256, 0); else p_mlaup_fast(F, l); } else p_mlaup_naive(F, l); asm volatile("" : "+v"(F.tid)); } } SEAM(pb + 3);
        STAMP(pb + 5);
        if (IN(pb + 5)) {
#if FAST_ATTN
            {
                const int vcu = (F.G % 8 == 0) ? (F.bid % 8) * (F.G / 8) + F.bid / 8 : F.bid;
                for (int rep = 0; rep < REP_ATTN; ++rep)
                for (int u = vcu; u < NB * 8 * 16; u += F.G) {
                    const int bh = u >> 4, qb = u & 15, b = bh >> 3, h = bh & 7;
                    at16::attn_unit64((LAS unsigned char*)F.lds, F_Q, F_K, F_V, F_AO, h, b * SEQ + qb * 512, ML + b * CTX, CTX / at::KT, b * SEQ, SEQ / at::KT, F.tid); }
                if (l == 0 && F.bid < NB * 8) { const int b = F.bid >> 3, h = F.bid & 7;
                    ATTN_NS::attn_unit((LAS unsigned char*)F.lds, F_Q, F_K, F_V, F_AO, h, ML + b * CTX, ML + b * CTX, CTX / at::KT, 0, 0, F.tid); }
            }
#else
            const int nu_att = NB * 8 * 256 + (l == 0 ? NB * 8 * 8 : 0);
            for (int u = F.bid; u < nu_att; u += F.G) {
                if (u < NB * 8 * 256) { const int qt = u & 255, h = (u >> 8) & 7, b = u >> 11; attn_unit_naive(F, h, b * SEQ + qt * 32, ML + b * CTX, CTX, b * SEQ, SEQ); }
                else { const int v = u - NB * 8 * 256; const int qt = v & 7, h = (v >> 3) & 7, b = v >> 6; attn_unit_naive(F, h, ML + b * CTX + qt * 32, ML + b * CTX, CTX, 0, 0); }
            }
#endif
#if FAST_RET
            REFRESH();
            { const float* decf = FIN(I_DECF); const float* decb = FIN(I_DECB); const float* gng = FIN(I_GNG) + l * 512; const float* gnb = FIN(I_GNB) + l * 512;
              const int ncr = (l == 0) ? 66 : 64, c0r = (l == 0) ? 0 : 2;
              for (int rep = REP_R3 - 1; rep >= 0; --rep)
              for (int u = (F.bid + F.G - 32) % F.G; u < 16 * ncr; u += F.G) { const int bh = u / ncr, c = c0r + u % ncr;
                  rt::chunk_out_unit((LAS unsigned char*)F.lds, F_RET, F_ST, gng, gnb, rt::log2_decay(decf, l, bh & 3), rt::log2_decay(decb, l, bh & 3), bh, c, F.tid, rep > 0); }
              REFRESH();
              const int nch = nrows_mix / 128;
              for (int rep = REP_GMLP - 1; rep >= 0; --rep)
              for (int u = (F.bid + F.G - 64) % F.G; u < nch * 4; u += F.G) { const int g = u & 3; rt::gmlp_unit((LAS unsigned char*)F.lds, F_UV, FIN(I_GWS) + ((size_t)l * 4 + g) * 128 * 128, FIN(I_GBS) + (l * 4 + g) * 128, FWS(float, WS_PARTV), FIN(I_LNG) + l * 512, FIN(I_LNB) + l * 512, u >> 2, g, F.tid, rep > 0); } }
#else
            const int nu_ret = NB * 4 * 256 + (l == 0 ? NB * 4 * 8 : 0);
            for (int u = F.bid; u < nu_ret; u += F.G) {
                if (u < NB * 4 * 256) { const int qt = u & 255, h = (u >> 8) & 3, b = u >> 10; ret_unit_naive(F, l, b, h, qt * 32, false); }
                else { const int v = u - NB * 4 * 256; const int qt = v & 7, h = (v >> 3) & 3, b = v >> 5; ret_unit_naive(F, l, b, h, qt * 32, true); }
            }
            const int nch = nrows_mix / 128;
            for (int u = F.bid; u < nch * 4; u += F.G) gmlp_unit_naive(F, l, u >> 2, u & 3);
#endif
        } SEAM(pb + 5);
        if (IN(pb + 6)) { for (int rep = 0; rep < REP_MERGE; ++rep) { if (FAST_MERGE) p_merge_fast(F, l, nrows_mix); else p_merge_naive(F, l, nrows_mix); asm volatile("" : "+v"(F.tid)); } } SEAM(pb + 6);
        if (IN(pb + 7)) { if (FAST_OUT) p_out_fast(F, l, nrows_mix); else p_out_naive(F, l, nrows_mix); REFRESH(); if (FAST_MOE) for (int rep = 0; rep < REP_CVTMOE; ++rep) { const int nt_out = (nrows_mix / 256) * 4, rem_out = nt_out % F.G; p_cvt_moe(F, l, (FAST_OUT && rem_out * 4 <= F.G) ? rem_out : 0); } }
        if (IN(pb + 8)) { for (int rep = 0; rep < REP_NORM2; ++rep) { p_norm2(F, l, nrows_mix); asm volatile("" : "+v"(F.tid)); } } SEAM(pb + 8);
        if (IN(pb + 9)) { for (int rep = 0; rep < REP_ROUTER; ++rep) { if (FAST_ROUTER) p_router_fast(F, l, nrows_mix); else p_router(F, l, nrows_mix); asm volatile("" : "+v"(F.tid)); __syncthreads(); } } SEAM(pb + 9);
        if (IN(pb + 10)) { p_scatter(F, l, nrows_mix); } SEAM(pb + 10);
        if (IN(pb + 11)) { for (int rep = 0; rep < REP_GATEUP; ++rep) { if (FAST_MOE) p_gateup_fast(F, l, nrows_mix); else p_moe_gateup_naive(F, l, nrows_mix); asm volatile("" : "+v"(F.tid)); } } SEAM(pb + 11);
        if (IN(pb + 12)) { for (int rep = REP_DOWN1 - 1; rep >= 0; --rep) { p_down_fast(F, l, nrows_mix, rep > 0); asm volatile("" : "+v"(F.tid)); } } SEAM(pb + 12);
        if (IN(pb + 13)) { if (l + 1 < DEPTH) p_combine<true>(F, l, nrows_mix); else p_combine<false>(F, l, nrows_mix); } SEAM(pb + 13);
    }
}

__global__ void __launch_bounds__(NTHR, 2) fwd_kernel(Args args) {
    extern __shared__ __attribute__((aligned(16))) unsigned char lds[];
    Frame F;
    F.lds = lds; F.tid = threadIdx.x; F.lane = F.tid & 63; F.wave = __builtin_amdgcn_readfirstlane(F.tid >> 6); F.G = gridDim.x; F.bid = blockIdx.x;
    F.A = &args;
    volatile LAS unsigned* MISC = (volatile LAS unsigned*)((LAS unsigned char*)lds + MISC_OFF);
    if (F.tid < 32) MISC[F.tid] = 0u;
    __syncthreads();
    int lo = args.ph_lo, hi = args.ph_hi;
    XcdBarrier bar; bar.bar = F_ctl + CW_BAR; bar.x = 0; bar.st = nullptr;
    if (hi - lo > 1) bar = xcd_barrier_post(F_ctl + CW_BAR, MISC + 8);
    STAMP(0);
    if (IN(0)) { for (int rep = 0; rep < REP_PRO; ++rep) { p_prologue(F); p_cvt_small(F); __syncthreads(); } } SEAM(0);
    static_assert(DEPTH == 2, "two explicit layer bodies");
    layer_body<0>(F, lo, hi, bar); layer_body<1>(F, lo, hi, bar);
#ifdef PROBE_A
    xcd_barrier(bar, F.tid);
    { const unsigned long long* ts = (const unsigned long long*)(ws_(F.A) + WS_CTL + 262144);
      float r = 1.0f; if (PROBE_A >= 0) { const float tus = (float)(ts[PROBE_A + 1] - ts[PROBE_A]) * 0.01f;
          const float q = exp2f(rintf(log2f(tus > 1.0f ? tus : 1.0f) * 3.1062837f) * (1.0f / 3.1062837f)); r = q / (float)(PROBE_TMAX); r = r > 1.0f ? 1.0f : r; }
      const float eps = 0.08f * r; float4* o = (float4*)F_out;
      for (int i = F.bid * NTHR + F.tid; i < ML * D / 4; i += F.G * NTHR) { float4 v = o[i]; v.x += eps; v.y += eps; v.z += eps; v.w += eps; o[i] = v; } }
#endif
#undef IN
#undef SEAM
}

#ifndef MK_PER_PHASE
#define MK_PER_PHASE 0
#endif
extern "C" void kernel_launch(void* const* d_in, const int* in_sizes, int n_in, void* d_out, int out_size, void* d_ws, size_t ws_size, hipStream_t stream) {
    static int grid = 0;
    if (grid == 0) {
        if (n_in != 36 || out_size != ML * D || ws_size < WS_END) { fprintf(stderr, "kernel_launch: unexpected problem (n_in %d out %d ws %zu)\n", n_in, out_size, ws_size); grid = -1; return; }
        int dev = 0, cus = 0;
        if (hipGetDevice(&dev) != hipSuccess || hipDeviceGetAttribute(&cus, hipDeviceAttributeMultiprocessorCount, dev) != hipSuccess) { grid = -1; return; }
        if (hipFuncSetAttribute((const void*)fwd_kernel, hipFuncAttributeMaxDynamicSharedMemorySize, LDS_BYTES) != hipSuccess) { fprintf(stderr, "kernel_launch: hipFuncSetAttribute failed\n"); grid = -1; return; }
        int per_cu = 0;
        if (hipOccupancyMaxActiveBlocksPerMultiprocessor(&per_cu, (const void*)fwd_kernel, NTHR, LDS_BYTES) != hipSuccess || per_cu < 1) fprintf(stderr, "kernel_launch: occupancy query says %d\n", per_cu);
        (void)hipGetLastError();
        grid = cus > 256 ? 256 : cus;
    }
    if (grid < 0) return;
    (void)hipMemsetAsync((char*)d_ws + WS_CTL, 0, CTL_ZERO_BYTES, stream);
    Args a{};
    for (int i = 0; i < 36; ++i) a.in[i] = (const float*)d_in[i];
    a.out = (float*)d_out; a.ws = (unsigned char*)d_ws;
#if MK_PER_PHASE
    for (int p = 0; p < NPH; ++p) { a.ph_lo = p; a.ph_hi = p + 1; hipLaunchKernelGGL(fwd_kernel, dim3(grid), dim3(NTHR), LDS_BYTES, stream, a); }
#else
    a.ph_lo = 0; a.ph_hi = NPH; hipLaunchKernelGGL(fwd_kernel, dim3(grid), dim3(NTHR), LDS_BYTES, stream, a);
#endif
}
```
